# Optimizing an MI355X kernel written in HIP

```python
import math
import jax, jax.numpy as jnp
from jax import lax
import numpy as np

D_MODEL = 1024
BATCH = 8
SEQ = 4096
DEPTH = 2

HEAD_DIM = 64
A_HEADS = 6
A_KV_HEADS = 2
A_WINDOW = 128
B_HEADS = 4
NSA_CMP_LEN = 32
NSA_CMP_STRIDE = 16
NSA_SLC_LEN = 64
NSA_SLC_TOPK = 16
NSA_WINDOW = 512
C_HEADS = 6
N_HEADS = A_HEADS + B_HEADS + C_HEADS
MIX_WIDTH = N_HEADS * HEAD_DIM
BLOCK = 128
REL_BUCKETS = 32
REL_MAX_DIST = 128
N_EXPERTS = 256
TOP_K = 8
N_GROUPS = 8
TOPK_GROUPS = 4
EXPERT_DIM = 256
SHARED_DIM = 256
ROUTED_SCALE = 2.5
MOE_ROW_BLOCK = 128
LN_EPS = 1e-5
ADA_INIT = 0.1
NEG = -1e30
FORCE_SCORE = 1e4

SPLIT_SIZES = (
    A_HEADS * HEAD_DIM, A_KV_HEADS * HEAD_DIM, A_KV_HEADS * HEAD_DIM,
    B_HEADS * HEAD_DIM, HEAD_DIM, HEAD_DIM, HEAD_DIM, HEAD_DIM, HEAD_DIM, HEAD_DIM,
    3 * B_HEADS,
    C_HEADS * HEAD_DIM, C_HEADS * HEAD_DIM, C_HEADS * HEAD_DIM, C_HEADS,
)
D_IN = sum(SPLIT_SIZES)

kernel_name = "hymba_style_swa_nsa_fox_moe_block"


def layer_norm(x, g, b):
    xf = x.astype(jnp.float32)
    mu = jnp.mean(xf, -1, keepdims=True)
    var = jnp.mean(jnp.square(xf - mu), -1, keepdims=True)
    return ((xf - mu) * lax.rsqrt(var + LN_EPS)).astype(x.dtype) * g + b


def t5_bucket(rel):
    n = jnp.maximum(rel, 0)
    max_exact = REL_BUCKETS // 2
    nf = jnp.maximum(n, 1).astype(jnp.float32)
    large = max_exact + (jnp.log(nf / max_exact) / math.log(REL_MAX_DIST / max_exact)
                         * (REL_BUCKETS - max_exact)).astype(jnp.int32)
    large = jnp.minimum(large, REL_BUCKETS - 1)
    return jnp.where(n < max_exact, n, large)


def banded_attention(q, k, v, window, table, sinks):
    bsz, t, h, d = q.shape
    kvh = k.shape[2]
    g = h // kvh
    nb = t // BLOCK
    n_prev = -(-(window - 1) // BLOCK)
    w = (n_prev + 1) * BLOCK
    qb = q.reshape(bsz, nb, BLOCK, kvh, g, d)

    def windows(a):
        ab = jnp.pad(a.reshape(bsz, nb, BLOCK, kvh, d), ((0, 0), (n_prev, 0), (0, 0), (0, 0), (0, 0)))
        return jnp.concatenate([ab[:, j:j + nb] for j in range(n_prev + 1)], axis=2)

    kw, vw = windows(k), windows(v)
    s = jnp.einsum('bnqkgd,bnskd->bnkgqs', qb, kw, preferred_element_type=jnp.float32) * HEAD_DIM ** -0.5
    rel = n_prev * BLOCK + jnp.arange(BLOCK)[:, None] - jnp.arange(w)[None, :]
    bias = jnp.transpose(table[t5_bucket(rel)], (2, 0, 1)).reshape(kvh, g, BLOCK, w).astype(jnp.float32)
    kpos = (jnp.arange(nb)[:, None] - n_prev) * BLOCK + jnp.arange(w)[None, :]
    mask = ((rel >= 0) & (rel < window))[None] & (kpos >= 0)[:, None, :]
    s = jnp.where(mask[None, :, None, None], s + bias, NEG)
    if sinks is None:
        p = jax.nn.softmax(s, axis=-1)
    else:
        sk = sinks.astype(jnp.float32).reshape(kvh, g)[None, None, :, :, None, None]
        m = jnp.maximum(jnp.max(s, -1, keepdims=True), sk)
        e = jnp.exp(s - m)
        p = e / (jnp.sum(e, -1, keepdims=True) + jnp.exp(sk - m))
    o = jnp.einsum('bnkgqs,bnskd->bnqkgd', p.astype(v.dtype), vw)
    return o.reshape(bsz, t, h, d)


def nsa_compress(x, pos, w):
    t = x.shape[1]
    n_cmp = (t - NSA_CMP_LEN) // NSA_CMP_STRIDE + 1
    idx = jnp.arange(n_cmp)[:, None] * NSA_CMP_STRIDE + jnp.arange(NSA_CMP_LEN)[None, :]
    blocks = x[:, idx] + pos
    return blocks.reshape(x.shape[0], n_cmp, -1) @ w


def selected_block_attention(q, k, v, sel, table):
    bsz, t, h, d = q.shape
    n_sel = sel.shape[-1]
    nq = t // BLOCK
    kb = k.reshape(bsz, t // NSA_SLC_LEN, NSA_SLC_LEN, d)
    vb = v.reshape(bsz, t // NSA_SLC_LEN, NSA_SLC_LEN, d)
    qs = q.reshape(bsz, nq, BLOCK, h, d).transpose(1, 0, 2, 3, 4)
    ss = sel.reshape(bsz, nq, BLOCK, n_sel).transpose(1, 0, 2, 3)
    take = jax.vmap(lambda blocks, ids: blocks[ids])

    def step(args):
        qb, sb, i = args
        kg = take(kb, sb).reshape(bsz, BLOCK, n_sel * NSA_SLC_LEN, d)
        vg = take(vb, sb).reshape(bsz, BLOCK, n_sel * NSA_SLC_LEN, d)
        tpos = i * BLOCK + jnp.arange(BLOCK)
        spos = (sb[..., None] * NSA_SLC_LEN + jnp.arange(NSA_SLC_LEN)).reshape(bsz, BLOCK, n_sel * NSA_SLC_LEN)
        rel = tpos[None, :, None] - spos
        bias = jnp.transpose(table[t5_bucket(rel)], (0, 3, 1, 2)).astype(jnp.float32)
        s = jnp.einsum('bqhd,bqkd->bhqk', qb, kg, preferred_element_type=jnp.float32) * HEAD_DIM ** -0.5
        s = jnp.where((rel >= 0)[:, None], s + bias, NEG)
        p = jax.nn.softmax(s, axis=-1)
        return jnp.einsum('bhqk,bqkd->bqhd', p.astype(v.dtype), vg)

    o = lax.map(step, (qs, ss, jnp.arange(nq)))
    return o.transpose(1, 0, 2, 3, 4).reshape(bsz, t, h, d)


def native_sparse_attention(q, kc, vc, ks, vs, kw, vw, gate_logits, pos_k, w_k, pos_v, w_v, table):
    bsz, t, h, d = q.shape
    k_cmp = nsa_compress(kc, pos_k, w_k)
    v_cmp = nsa_compress(vc, pos_v, w_v)
    n_cmp = k_cmp.shape[1]
    tpos = jnp.arange(t)
    c_start = jnp.arange(n_cmp) * NSA_CMP_STRIDE
    rel = tpos[:, None] - (c_start + NSA_CMP_LEN - 1)[None, :]
    valid = rel >= 0
    s = jnp.einsum('bthd,bnd->bhtn', q, k_cmp, preferred_element_type=jnp.float32) * HEAD_DIM ** -0.5
    s = jnp.where(valid, s + jnp.transpose(table[t5_bucket(rel)], (2, 0, 1)).astype(jnp.float32), NEG)
    p_cmp = jax.nn.softmax(s, axis=-1) * jnp.any(valid, -1)[:, None]
    o_cmp = jnp.einsum('bhtn,bnd->bthd', p_cmp.astype(vc.dtype), v_cmp)
    n_slc = t // NSA_SLC_LEN
    s_start = jnp.arange(n_slc) * NSA_SLC_LEN
    overlap = jnp.clip(jnp.minimum(c_start[:, None] + NSA_CMP_LEN, s_start[None, :] + NSA_SLC_LEN)
                       - jnp.maximum(c_start[:, None], s_start[None, :]), 0).astype(jnp.float32) / NSA_CMP_LEN
    imp = jnp.einsum('bhtn,ns->bts', p_cmp, overlap)
    cur = (tpos // NSA_SLC_LEN)[:, None]
    j = jnp.arange(n_slc)[None, :]
    forced = (j == 0) | (j == cur) | (j == cur - 1)
    imp = jnp.where(forced, FORCE_SCORE, jnp.where(j > cur, -1.0, imp))
    _, sel = lax.top_k(imp, min(NSA_SLC_TOPK, n_slc))
    o_slc = selected_block_attention(q, ks, vs, sel, table)
    o_win = banded_attention(q, kw[:, :, None], vw[:, :, None], NSA_WINDOW, table, None)
    g = jax.nn.sigmoid(gate_logits.astype(jnp.float32)).reshape(bsz, t, 3, h)[..., None].astype(q.dtype)
    return g[:, :, 0] * o_cmp + g[:, :, 1] * o_slc + g[:, :, 2] * o_win


def forgetting_attention(q, k, v, log_f):
    bsz, t, h, d = q.shape
    nq = t // BLOCK
    dcum = jnp.cumsum(log_f.astype(jnp.float32), axis=1)
    d_k = jnp.transpose(dcum, (0, 2, 1))
    qs = q.reshape(bsz, nq, BLOCK, h, d).transpose(1, 0, 2, 3, 4)
    ds = dcum.reshape(bsz, nq, BLOCK, h).transpose(1, 0, 3, 2)
    spos = jnp.arange(t)

    def step(args):
        qb, dq, i = args
        tpos = i * BLOCK + jnp.arange(BLOCK)
        s = (jnp.einsum('bqhd,bshd->bhqs', qb, k, preferred_element_type=jnp.float32) * HEAD_DIM ** -0.5
             + dq[..., None] - d_k[:, :, None, :])
        s = jnp.where(spos[None, :] <= tpos[:, None], s, NEG)
        p = jax.nn.softmax(s, axis=-1)
        return jnp.einsum('bhqs,bshd->bqhd', p.astype(v.dtype), v)

    o = lax.map(step, (qs, ds, jnp.arange(nq)))
    return o.transpose(1, 0, 2, 3, 4).reshape(bsz, t, h, d)


def hybrid_mixer(h, w_in, w_o, sinks, pos_k, w_k, pos_v, w_v, f_bias, table):
    bsz, t, _ = h.shape
    cuts = np.cumsum(SPLIT_SIZES)[:-1].tolist()
    (aq, ak, av, bq, bkc, bvc, bks, bvs, bkw, bvw, bg, cq, ck, cv, cf) = jnp.split(h @ w_in, cuts, axis=-1)
    heads = lambda a, n: a.reshape(bsz, t, n, HEAD_DIM)
    o_a = banded_attention(heads(aq, A_HEADS), heads(ak, A_KV_HEADS), heads(av, A_KV_HEADS),
                           A_WINDOW, table[:, :A_HEADS], sinks)
    o_b = native_sparse_attention(heads(bq, B_HEADS), bkc, bvc, bks, bvs, bkw, bvw, bg,
                                  pos_k, w_k, pos_v, w_v, table[:, A_HEADS:])
    o_c = forgetting_attention(heads(cq, C_HEADS), heads(ck, C_HEADS), heads(cv, C_HEADS),
                               jax.nn.log_sigmoid((cf + f_bias).astype(jnp.float32)))
    o = jnp.concatenate([o_a, o_b, o_c], axis=2).reshape(bsz, t, MIX_WIDTH)
    return o @ w_o


def swiglu(x, wg, wu, wd):
    return (jax.nn.silu(x @ wg) * (x @ wu)) @ wd


def route(h, w_router, router_bias):
    scores = jax.nn.sigmoid((h @ w_router).astype(jnp.float32))
    choice = scores + router_bias.astype(jnp.float32)
    grouped = choice.reshape(-1, N_GROUPS, N_EXPERTS // N_GROUPS)
    gscore = jnp.sum(lax.top_k(grouped, 2)[0], axis=-1)
    _, gidx = lax.top_k(gscore, TOPK_GROUPS)
    gmask = jnp.sum(jax.nn.one_hot(gidx, N_GROUPS, dtype=jnp.float32), axis=-2) > 0
    masked = jnp.where(gmask[:, :, None], grouped, NEG).reshape(-1, N_EXPERTS)
    _, idx = lax.top_k(masked, TOP_K)
    w = jnp.take_along_axis(scores, idx, axis=-1)
    w = w / jnp.sum(w, -1, keepdims=True) * ROUTED_SCALE
    return idx, w


def moe_routed(h, idx, gw, w_gate, w_up, w_down):
    n, d = h.shape
    a = n * TOP_K
    flat_e = idx.reshape(-1)
    flat_tok = jnp.arange(a) // TOP_K
    flat_g = gw.reshape(-1)
    order = jnp.argsort(flat_e)
    se, stok, sg = flat_e[order], flat_tok[order], flat_g[order]
    counts = jnp.bincount(flat_e, length=N_EXPERTS)
    starts = jnp.cumsum(counts) - counts
    padded = (counts + MOE_ROW_BLOCK - 1) // MOE_ROW_BLOCK * MOE_ROW_BLOCK
    pends = jnp.cumsum(padded)
    pstarts = pends - padded
    dest = pstarts[se] + (jnp.arange(a) - starts[se])
    n_blocks = -(-a // MOE_ROW_BLOCK) + N_EXPERTS
    rows = n_blocks * MOE_ROW_BLOCK
    row_tok = jnp.full((rows,), n, jnp.int32).at[dest].set(stok)
    row_g = jnp.zeros((rows,), h.dtype).at[dest].set(sg)
    block_e = jnp.clip(jnp.searchsorted(pends, jnp.arange(n_blocks) * MOE_ROW_BLOCK, side='right'),
                       0, N_EXPERTS - 1)
    h_ext = jnp.concatenate([h, jnp.zeros((1, d), h.dtype)], axis=0)

    def step(out, xs):
        tok, g, e = xs
        y = swiglu(h_ext[tok], w_gate[e], w_up[e], w_down[e])
        return out.at[tok].add(y * g[:, None]), None

    out, _ = lax.scan(step, jnp.zeros((n + 1, d), h.dtype),
                      (row_tok.reshape(n_blocks, MOE_ROW_BLOCK), row_g.reshape(n_blocks, MOE_ROW_BLOCK), block_e))
    return out[:n]


def setup_inputs(seed: int = 0) -> dict:
    key = jax.random.key(seed)
    ks = jax.random.split(key, 26)
    nrm = lambda k, shape: jax.random.normal(k, shape, jnp.float32)
    beta = (8.0 * DEPTH) ** -0.25
    D, L, Dh, E, F, Fs = D_MODEL, NSA_CMP_LEN, HEAD_DIM, N_EXPERTS, EXPERT_DIM, SHARED_DIM
    return {
        'x': nrm(ks[0], (BATCH, SEQ, D)),
        'c': nrm(ks[1], (BATCH, D)),
        'w_in': nrm(ks[2], (DEPTH, D, D_IN)) * D ** -0.5,
        'w_o': nrm(ks[3], (DEPTH, MIX_WIDTH, D)) * MIX_WIDTH ** -0.5 * beta,
        'a_sinks': nrm(ks[4], (DEPTH, A_HEADS)),
        'nsa_pos_k': 0.02 * nrm(ks[5], (DEPTH, L, Dh)),
        'nsa_w_k': nrm(ks[6], (DEPTH, L * Dh, Dh)) * (L * Dh) ** -0.5,
        'nsa_pos_v': 0.02 * nrm(ks[7], (DEPTH, L, Dh)),
        'nsa_w_v': nrm(ks[8], (DEPTH, L * Dh, Dh)) * (L * Dh) ** -0.5,
        'fox_f_bias': 3.0 + 0.5 * nrm(ks[9], (DEPTH, C_HEADS)),
        'rel_bias': 0.5 * nrm(ks[10], (REL_BUCKETS, A_HEADS + B_HEADS)),
        'w_ada': nrm(ks[11], (DEPTH, D, 6 * D)) * ADA_INIT * D ** -0.5,
        'b_ada': 0.01 * nrm(ks[12], (DEPTH, 6 * D)),
        'ln1_g': 1.0 + 0.01 * nrm(ks[13], (DEPTH, D)),
        'ln1_b': 0.01 * nrm(ks[14], (DEPTH, D)),
        'ln2_g': 1.0 + 0.01 * nrm(ks[15], (DEPTH, D)),
        'ln2_b': 0.01 * nrm(ks[16], (DEPTH, D)),
        'w_router': nrm(ks[17], (DEPTH, D, E)) * D ** -0.5,
        'router_bias': 0.01 * nrm(ks[18], (DEPTH, E)),
        'w_exp_gate': nrm(ks[19], (DEPTH, E, D, F)) * D ** -0.5,
        'w_exp_up': nrm(ks[20], (DEPTH, E, D, F)) * D ** -0.5,
        'w_exp_down': nrm(ks[21], (DEPTH, E, F, D)) * F ** -0.5 * beta,
        'w_sh_gate': nrm(ks[22], (DEPTH, D, Fs)) * D ** -0.5,
        'w_sh_up': nrm(ks[23], (DEPTH, D, Fs)) * D ** -0.5,
        'w_sh_down': nrm(ks[24], (DEPTH, Fs, D)) * Fs ** -0.5 * beta,
    }


def reference(x, c, w_in, w_o, a_sinks, nsa_pos_k, nsa_w_k, nsa_pos_v, nsa_w_v, fox_f_bias, rel_bias,
              w_ada, b_ada, ln1_g, ln1_b, ln2_g, ln2_b, w_router, router_bias,
              w_exp_gate, w_exp_up, w_exp_down, w_sh_gate, w_sh_up, w_sh_down):
    alpha = (2.0 * DEPTH) ** 0.25
    bsz, t, d = x.shape
    cond = jax.nn.silu(c)
    for l in range(DEPTH):
        ada = cond @ w_ada[l] + b_ada[l]
        sh1, sc1, g1, sh2, sc2, g2 = [a[:, None, :] for a in jnp.split(ada, 6, axis=-1)]
        h = x * (1 + sc1) + sh1
        y = hybrid_mixer(h, w_in[l], w_o[l], a_sinks[l], nsa_pos_k[l], nsa_w_k[l], nsa_pos_v[l], nsa_w_v[l],
                         fox_f_bias[l], rel_bias)
        x = layer_norm(alpha * x + (1 + g1) * y, ln1_g[l], ln1_b[l])
        h = (x * (1 + sc2) + sh2).reshape(bsz * t, d)
        idx, gw = route(h, w_router[l], router_bias[l])
        y = (swiglu(h, w_sh_gate[l], w_sh_up[l], w_sh_down[l])
             + moe_routed(h, idx, gw.astype(h.dtype), w_exp_gate[l], w_exp_up[l], w_exp_down[l]))
        x = layer_norm(alpha * x + (1 + g2) * y.reshape(bsz, t, d), ln2_g[l], ln2_b[l])
    return x
```

```cpp
#include <hip/hip_runtime.h>
#include <cstdio>
#include <cstdint>

#define DI __device__ __forceinline__
#define LAS __attribute__((address_space(3)))
#define GAS __attribute__((address_space(1)))
typedef unsigned short bf16_t;
typedef short bf16x8 __attribute__((ext_vector_type(8)));
typedef short s16x4 __attribute__((ext_vector_type(4)));
typedef float f32x2 __attribute__((ext_vector_type(2)));
typedef float f32x4 __attribute__((ext_vector_type(4)));
typedef float f32x16 __attribute__((ext_vector_type(16)));
typedef unsigned u32x2 __attribute__((ext_vector_type(2)));
typedef unsigned u32x4 __attribute__((ext_vector_type(4)));

constexpr int DM = 1024, NB = 8, SEQ = 4096, NTOK = NB * SEQ, DEPTH = 2;
constexpr int D_IN = 2450, QKV_N = 2560;
constexpr int NEXP = 256, TOPK = 8, EDIM = 256;
constexpr float LOG2E = 1.4426950408889634f;
constexpr float C2 = 0.125f * LOG2E;
constexpr float ALPHA = 1.4142135623730951f;
constexpr float LN_EPS = 1e-5f;
constexpr int C_AQ = 0, C_AK = 384, C_AV = 512, C_BQ = 640, C_BKC = 896, C_BVC = 960, C_BKS = 1024, C_BVS = 1088, C_BKW = 1152, C_BVW = 1216,
              C_CQ = 1280, C_CK = 1664, C_CV = 2048, C_SM = 2432;
constexpr int O_A = 0, O_B = 384, O_C = 640;

constexpr size_t MiB = 1u << 20;
constexpr size_t WS_CTL = 0, CTL_BYTES = 1 * MiB;
constexpr size_t WS_ADA = 1 * MiB;
constexpr size_t WS_CPOS = WS_ADA + 512 * 1024;
constexpr size_t WS_KCMP = 2 * MiB;
constexpr size_t WS_VCMP = WS_KCMP + 256 * 1024;
constexpr size_t WS_DC = 3 * MiB;
constexpr size_t WS_WCT = 4 * MiB;
constexpr size_t WS_WIN = 8 * MiB;
constexpr size_t WS_WO = 18 * MiB;
constexpr size_t WS_WSH = 22 * MiB;
constexpr size_t WS_WSD = 25 * MiB;
constexpr size_t WS_WGU = 32 * MiB;
constexpr size_t WS_WD = 544 * MiB;
constexpr size_t WS_H = 800 * MiB;
constexpr size_t WS_X1 = 864 * MiB;
constexpr size_t WS_LOG = 992 * MiB;
constexpr size_t WS_ACTSH = 1024 * MiB;
constexpr size_t WS_YSH = 1040 * MiB;
constexpr size_t WS_DST = 1104 * MiB;
constexpr size_t WS_WL = 1136 * MiB;
constexpr size_t WS_SMALL = 1168 * MiB;
constexpr size_t WS_ACT = 1172 * MiB;
constexpr size_t WS_R1 = 1332 * MiB;
constexpr size_t WS_QKV = WS_R1;
constexpr size_t WS_O = WS_R1 + 160 * MiB;
constexpr size_t WS_V = WS_R1 + 224 * MiB;
constexpr size_t WS_YB = WS_R1;
constexpr size_t WS_END = 1844 * MiB;

constexpr int CW_BAR = 4096;
constexpr int CW_Q = 16384;
constexpr int CW_CNT = 32768;

constexpr int RING_BYTES = 131072;
constexpr int L_MISC = RING_BYTES;
constexpr int L_LUT = L_MISC + 256;
constexpr int L_TP = L_LUT + 5120;
constexpr int L_CNT = L_TP + 1040;
constexpr int L_PT = L_CNT + 1024;
constexpr int LDS_BYTES = 147456;
static_assert(L_PT + 256 <= LDS_BYTES, "LDS map");

DI unsigned cvtpk(float lo, float hi) { typedef __bf16 b2 __attribute__((ext_vector_type(2))); f32x2 v = {lo, hi}; b2 b = __builtin_convertvector(v, b2); return __builtin_bit_cast(unsigned, b); }
DI float bf2f(bf16_t v) { return __uint_as_float((unsigned)v << 16); }
DI float fast_exp2(float x) { return __builtin_amdgcn_exp2f(x); }
DI float sigmoidf_(float x) { return 1.f / (1.f + __expf(-x)); }
DI float siluf_(float x) { return x / (1.f + __expf(-x)); }

#define XB_TMO      128
#define XB_XCNT(j)  (256  + 64 * (j))
#define XB_XSUB(j)  (1280 + 64 * (j))
#define XB_XGEN(j)  (2304 + 64 * (j))
#define XB_TOP      3328
#define XB_TOPGEN   3392
#define XCD_BAR_WORDS 3456
#define XB_SPIN_CAP (1u << 22)

__device__ __forceinline__ unsigned xb_ld(unsigned* p)              { return __hip_atomic_load(p, __ATOMIC_RELAXED, __HIP_MEMORY_SCOPE_AGENT); }
__device__ __forceinline__ unsigned xb_add(unsigned* p, unsigned v) { return __hip_atomic_fetch_add(p, v, __ATOMIC_RELAXED, __HIP_MEMORY_SCOPE_AGENT); }
__device__ __forceinline__ unsigned xb_xcc_id() { return (unsigned)__builtin_amdgcn_s_getreg((3 << 11) | 20) & 0xFu; }
#define XB_SPIN(cond, bar) do { unsigned _sp = 0; while (cond) { __builtin_amdgcn_s_sleep(1); \
    if ((++_sp & 255u) == 0u) { if (xb_ld(&(bar)[XB_TMO])) break; if (_sp > XB_SPIN_CAP) { atomicAdd(&(bar)[XB_TMO], 1u); break; } } } } while (0)

struct XcdBarrier { unsigned* bar; unsigned x; volatile LAS unsigned* st; };

__device__ __forceinline__ XcdBarrier xcd_barrier_post(unsigned* bar, volatile LAS unsigned* st) {
    XcdBarrier b; b.bar = bar; b.x = xb_xcc_id(); b.st = st;
    if (threadIdx.x == 0) (void)xb_add(&bar[XB_XCNT(b.x)], 1u);
    return b;
}
__device__ __forceinline__ void xcd_barrier_complete(unsigned* bar, unsigned x, unsigned& nloc, unsigned& nx) {
    const unsigned G = gridDim.x * gridDim.y * gridDim.z;
    unsigned sum, cnt, mine, sp = 0u;
    for (;;) {
        sum = 0u; cnt = 0u; mine = 0u;
#pragma unroll
        for (unsigned j = 0; j < 16; ++j) { const unsigned c = xb_ld(&bar[XB_XCNT(j)]); sum += c; cnt += (c > 0u) ? 1u : 0u; mine = (j == x) ? c : mine; }
        if (sum == G) break;
        __builtin_amdgcn_s_sleep(1);
        if ((++sp & 255u) == 0u) { if (xb_ld(&bar[XB_TMO])) break; if (sp > XB_SPIN_CAP) { atomicAdd(&bar[XB_TMO], 1u); break; } }
    }
    nloc = mine > 0u ? mine : 1u; nx = cnt > 0u ? cnt : 1u;
}
__device__ __forceinline__ void xcd_barrier(const XcdBarrier& b, bool leader_thread) {
    asm volatile("s_waitcnt vmcnt(0)" ::: "memory");
    __syncthreads();
    if (leader_thread) {
        unsigned* bar = b.bar;
        __builtin_amdgcn_s_waitcnt(0);
        unsigned nloc = b.st[0], nx = b.st[1];
        if (nloc == 0u) { xcd_barrier_complete(bar, b.x, nloc, nx); b.st[0] = nloc; b.st[1] = nx; }
        const unsigned old = xb_add(&bar[XB_XSUB(b.x)], 1u);
        const unsigned gen = old / nloc;
        if (old + 1u == (gen + 1u) * nloc) {
            __builtin_amdgcn_fence(__ATOMIC_RELEASE, "agent");
            asm volatile("s_waitcnt vmcnt(0)" ::: "memory");
            const unsigned og = xb_add(&bar[XB_TOP], 1u);
            const unsigned tg = og / nx;
            if (og + 1u == (tg + 1u) * nx) xb_add(&bar[XB_TOPGEN], 1u);
            else XB_SPIN(xb_ld(&bar[XB_TOPGEN]) == tg, bar);
            __builtin_amdgcn_fence(__ATOMIC_ACQUIRE, "agent");
            xb_add(&bar[XB_XGEN(b.x)], 1u);
            asm volatile("s_waitcnt vmcnt(0)" ::: "memory");
        } else {
            XB_SPIN(xb_ld(&bar[XB_XGEN(b.x)]) == gen, bar);
            __builtin_amdgcn_fence(__ATOMIC_ACQUIRE, "agent");
            asm volatile("s_waitcnt vmcnt(0)" ::: "memory");
        }
    }
    __syncthreads();
}

namespace pg8 {
constexpr int BM = 256, BK = 64, HALF = 128, HTB = HALF * BK * 2, STAGE_BYTES = 8 * HTB, NXCD = 8, WGM = 8;
__host__ __device__ __forceinline__ int lds_byte(int r, int c) { const int st = (r >> 4) * 2 + (c >> 5), rr = r & 15, cc = c & 31, ob = rr * 64 + cc * 2; return st * 1024 + (ob ^ (((ob >> 9) & 1) << 5)); }
__host__ __device__ __forceinline__ void stage_rc(int b, int& R, int& C) { const int st = b / 1024, sb = b % 1024, swz = sb ^ (((sb >> 9) & 1) << 5); R = (st >> 1) * 16 + swz / 64; C = (st & 1) * 32 + (swz % 64) / 2; }
__host__ __device__ __forceinline__ int perm32(int rho) { const int n = rho >> 4, i = rho & 15; return 8 * (i >> 2) + 4 * n + (i & 3); }

struct Unit { int pm, pn, e, lrow0, cnt; };
struct Gemm { const bf16_t* A; const bf16_t* Bt; int K; };

struct StaticOrder {
    int nM, nN, nwg, G, c;
    DI void init(int M, int N, int G_, int c_) { nM = M / BM; nN = N / BM; nwg = nM * nN; G = G_; c = c_; }
    DI bool next(int i, Unit& u) const {
        const long L = (long)i * G + c; if (L >= nwg) return false;
        int wgid = (int)L; { const int q = nwg / NXCD, r = nwg % NXCD, xcd = wgid % NXCD, off = wgid / NXCD; wgid = (xcd < r ? xcd * (q + 1) : r * (q + 1) + (xcd - r) * q) + off; }
        const int nig = WGM * nN, gid = wgid / nig, fm = gid * WGM, gsz = (nM - fm) < WGM ? (nM - fm) : WGM;
        u.pm = fm + ((wgid % nig) % gsz); u.pn = (wgid % nig) / gsz; u.e = 0; u.lrow0 = 0; u.cnt = 0; return true;
    }
    static constexpr bool GATHER = false;
    DI unsigned tokpair(const Unit&, int, int) const { return 0u; }
};
template <bool GATHER_> struct GroupedOrder {
    static constexpr bool GATHER = GATHER_;
    const LAS int* TP; const LAS int* CNT; int NT, G, c; const int* list;
    DI bool next(int i, Unit& u) const {
        const int total = TP[256] * NT; const int L = i * G + c; if (L >= total) return false;
        const int mt = L / NT, nt = L - mt * NT;
        int lo = 0, hi = 255;
        while (lo < hi) { const int mid = (lo + hi + 1) >> 1; if (TP[mid] <= mt) lo = mid; else hi = mid - 1; }
        u.pm = __builtin_amdgcn_readfirstlane(mt); u.pn = __builtin_amdgcn_readfirstlane(lo * NT + nt); u.e = __builtin_amdgcn_readfirstlane(lo);
        u.lrow0 = __builtin_amdgcn_readfirstlane((mt - TP[lo]) * BM); u.cnt = __builtin_amdgcn_readfirstlane(CNT[lo]); return true;
    }
    DI unsigned tokpair(const Unit& u, int R0, int) const {
        int l0 = u.lrow0 + R0, l1 = l0 + HALF; l0 = l0 < u.cnt ? l0 : u.cnt - 1; l1 = l1 < u.cnt ? l1 : u.cnt - 1;
        const unsigned t0 = (unsigned)(list[u.e * NTOK + l0] >> 3), t1 = (unsigned)(list[u.e * NTOK + l1] >> 3); return t0 | (t1 << 16);
    }
};

template <class Epi, class Sched>
__device__ __forceinline__ void gemm_phase(LAS unsigned char* lds, const Gemm g, const Sched& S, const Epi& E, int wid_) {
    int lane; asm volatile("v_mbcnt_lo_u32_b32 %0, -1, 0\n\tv_mbcnt_hi_u32_b32 %0, -1, %0" : "=v"(lane));
    int wid = wid_; asm volatile("" : "+s"(wid)); const int tid = wid * 64 + lane, wr = wid >> 2, wc = wid & 3, fr = lane & 15, fq = lane >> 4;
    const int K = g.K, nt = K / BK;
    constexpr bool GA = Sched::GATHER;
    unsigned voffA[2], voffB[2]; int RA[2];
#pragma unroll
    for (int i = 0; i < 2; ++i) { int R, C; stage_rc(tid * 16 + i * 8192, R, C); const int Rb = Epi::PERM ? ((R & ~31) + perm32(R & 31)) : R;
        RA[i] = R; voffA[i] = GA ? (unsigned)(C * 2) : (unsigned)(R * K + C) * 2u; voffB[i] = (unsigned)(Rb * K + C) * 2u; }
    const size_t kstep = (size_t)(BK * 2);
    const size_t hstep = (size_t)HALF * K * 2;
    const size_t tstep = 2 * hstep;
    const unsigned ldsw = (unsigned)wid * 1024u;
    const int aoff = lds_byte(wr * 64 + fr, fq * 8), boff = lds_byte(wc * 32 + fr, fq * 8);
#define PG8_SA(b, h) (((b) * 2 + (h)) * HTB)
#define PG8_SB(b, h) ((4 + (b) * 2 + (h)) * HTB)
#define PG8_STAGE(bufoff, gbase, voff) do { _Pragma("unroll") for (int _i = 0; _i < 2; ++_i) \
        __builtin_amdgcn_global_load_lds((const unsigned*)((const char*)(gbase) + (voff)[_i]), (LAS unsigned*)(lds + (bufoff) + ldsw + _i * 8192), 16, 0, 0); } while (0)
#define PG8_STAGEA(bufoff, ubase, tp, hh, kb) do { _Pragma("unroll") for (int _i = 0; _i < 2; ++_i) { \
        const char* _p = GA ? ((const char*)g.A + (size_t)(kb) + (size_t)((((tp)[_i] >> (16 * (hh))) & 0xffffu) * (unsigned)(K * 2)) + voffA[_i]) : ((ubase) + (size_t)(hh) * hstep + (size_t)(kb) + voffA[_i]); \
        __builtin_amdgcn_global_load_lds((const unsigned*)_p, (LAS unsigned*)(lds + (bufoff) + ldsw + _i * 8192), 16, 0, 0); } } while (0)
#define PG8_LDA(dst, b, h) do { _Pragma("unroll") for (int m = 0; m < 4; ++m) _Pragma("unroll") for (int k = 0; k < 2; ++k) dst[m][k] = *(const LAS bf16x8*)(lds + PG8_SA(b, h) + aoff + m * 2048 + k * 1024); } while (0)
#define PG8_LDB(dst, b, h) do { _Pragma("unroll") for (int n = 0; n < 2; ++n) _Pragma("unroll") for (int k = 0; k < 2; ++k) dst[n][k] = *(const LAS bf16x8*)(lds + PG8_SB(b, h) + boff + n * 2048 + k * 1024); } while (0)
#define PG8_MMA(ai, bj, At, Bt) do { __builtin_amdgcn_s_setprio(1); _Pragma("unroll") for (int m = 0; m < 4; ++m) _Pragma("unroll") for (int n = 0; n < 2; ++n) _Pragma("unroll") for (int k = 0; k < 2; ++k) \
        acc[ai][bj][m][n] = __builtin_amdgcn_mfma_f32_16x16x32_bf16(Bt[n][k], At[m][k], acc[ai][bj][m][n], 0, 0, 0); __builtin_amdgcn_s_setprio(0); } while (0)
#define PG8_WAIT_V(n) asm volatile("s_waitcnt vmcnt(" #n ")" ::: "memory")
#define PG8_WAIT_L(n) asm volatile("s_waitcnt lgkmcnt(" #n ")" ::: "memory")
#define PG8_BAR __builtin_amdgcn_s_barrier()
#define PG8_SCHED __builtin_amdgcn_sched_barrier(0)
    Unit cur, nxt; int ui = 0;
    if (!S.next(0, cur)) return;
    f32x4 acc[2][2][4][2];
#pragma unroll
    for (int a = 0; a < 2; ++a)
#pragma unroll
        for (int b = 0; b < 2; ++b)
#pragma unroll
            for (int m = 0; m < 4; ++m)
#pragma unroll
                for (int n = 0; n < 2; ++n) acc[a][b][m][n] = (f32x4){0.f, 0.f, 0.f, 0.f};
    bf16x8 At[4][2], B0[2][2], B1[2][2];
    unsigned tpc[2] = {0u, 0u}, tpn[2] = {0u, 0u};
    if (GA) {
#pragma unroll
        for (int i = 0; i < 2; ++i) tpc[i] = S.tokpair(cur, RA[i], 0); }
#define PG8_FRESH_R(i, Rv) int Rv; { int l2_; asm volatile("v_mbcnt_lo_u32_b32 %0, -1, 0\n\tv_mbcnt_hi_u32_b32 %0, -1, %0" : "=v"(l2_)); int C2_; stage_rc((wid * 64 + l2_) * 16 + (i) * 8192, Rv, C2_); }
    const char* cA = GA ? (const char*)g.A : (const char*)g.A + (size_t)cur.pm * tstep; const char* cB = (const char*)g.Bt + (size_t)cur.pn * tstep;
    {
        PG8_STAGE(PG8_SB(0, 0), cB, voffB); PG8_STAGE(PG8_SB(0, 1), cB + hstep, voffB); PG8_STAGEA(PG8_SA(0, 0), cA, tpc, 0, 0); PG8_STAGEA(PG8_SA(0, 1), cA, tpc, 1, 0);
        if (wr == 1) PG8_BAR;
        PG8_WAIT_V(2); PG8_BAR;
        PG8_STAGE(PG8_SB(1, 0), cB + kstep, voffB); PG8_STAGEA(PG8_SA(1, 0), cA, tpc, 0, kstep); PG8_STAGE(PG8_SB(1, 1), cB + hstep + kstep, voffB);
        PG8_WAIT_V(6); PG8_BAR;
    }
    for (;;) {
        const bool has_next = S.next(ui + 1, nxt);
        const char* nA = GA ? cA : (has_next ? (const char*)g.A + (size_t)nxt.pm * tstep : cA); const char* nB = has_next ? (const char*)g.Bt + (size_t)nxt.pn * tstep : cB;
        if (GA) {
#pragma unroll
            for (int i = 0; i < 2; ++i) { if (has_next) { PG8_FRESH_R(i, Rn_); tpn[i] = S.tokpair(nxt, Rn_, 0); } else tpn[i] = tpc[i]; } }
#pragma unroll 1
        for (int t = 0; t < nt; t += 2) {
            const bool last = (t == nt - 2);
            const size_t k1 = (size_t)(t + 1) * kstep;
            const size_t k2 = last ? 0 : (size_t)(t + 2) * kstep; const size_t k3 = k2 + kstep;
            const char* a2 = last ? nA : cA;
            unsigned tp2[2];
#pragma unroll
            for (int i = 0; i < 2; ++i) tp2[i] = last ? tpn[i] : tpc[i];
            const char* b2 = last ? nB : cB + (size_t)(t + 2) * kstep;
            const char* b3 = b2 + kstep;
            PG8_LDB(B0, 0, 0); PG8_LDB(B1, 0, 1); PG8_SCHED; PG8_LDA(At, 0, 0); PG8_STAGEA(PG8_SA(1, 1), cA, tpc, 1, k1);
            PG8_WAIT_V(8); PG8_WAIT_L(0); PG8_BAR; PG8_MMA(0, 0, At, B0); PG8_MMA(0, 1, At, B1); PG8_BAR; PG8_SCHED;
            PG8_LDA(At, 0, 1); PG8_STAGE(PG8_SB(0, 0), b2, voffB); PG8_STAGE(PG8_SB(0, 1), b2 + hstep, voffB); PG8_STAGEA(PG8_SA(0, 0), a2, tp2, 0, k2);
            PG8_WAIT_V(8); PG8_WAIT_L(0); PG8_BAR; PG8_MMA(1, 0, At, B0); PG8_MMA(1, 1, At, B1); PG8_BAR; PG8_SCHED;
            PG8_LDB(B0, 1, 0); PG8_LDB(B1, 1, 1); PG8_SCHED; PG8_LDA(At, 1, 0); PG8_STAGEA(PG8_SA(0, 1), a2, tp2, 1, k2);
            PG8_WAIT_V(8); PG8_WAIT_L(0); PG8_BAR; PG8_MMA(0, 0, At, B0); PG8_MMA(0, 1, At, B1); PG8_BAR; PG8_SCHED;
            PG8_LDA(At, 1, 1); PG8_STAGE(PG8_SB(1, 0), b3, voffB); PG8_STAGE(PG8_SB(1, 1), b3 + hstep, voffB); PG8_STAGEA(PG8_SA(1, 0), a2, tp2, 0, k3);
            PG8_WAIT_V(8); PG8_WAIT_L(0); PG8_BAR; PG8_MMA(1, 0, At, B0); PG8_MMA(1, 1, At, B1); PG8_BAR; PG8_SCHED;
        }
        if (wr == 0) PG8_BAR;
        E(acc, cur, wr, wc, fr, fq);
        if (!has_next) break;
#pragma unroll
        for (int a = 0; a < 2; ++a)
#pragma unroll
            for (int b = 0; b < 2; ++b)
#pragma unroll
                for (int m = 0; m < 4; ++m)
#pragma unroll
                    for (int n = 0; n < 2; ++n) acc[a][b][m][n] = (f32x4){0.f, 0.f, 0.f, 0.f};
        cur = nxt; cA = nA; cB = nB; ++ui;
#pragma unroll
        for (int i = 0; i < 2; ++i) tpc[i] = tpn[i];
        if (wr == 1) PG8_BAR;
    }
    PG8_WAIT_V(0);
    PG8_BAR;
#undef PG8_SA
#undef PG8_SB
#undef PG8_STAGE
#undef PG8_STAGEA
#undef PG8_FRESH_R
#undef PG8_LDA
#undef PG8_LDB
#undef PG8_MMA
#undef PG8_WAIT_V
#undef PG8_WAIT_L
#undef PG8_BAR
#undef PG8_SCHED
}

DI u32x4 pack8(const f32x4& v0, const f32x4& v1) { u32x4 w; w.x = cvtpk(v0[0], v0[1]); w.y = cvtpk(v0[2], v0[3]); w.z = cvtpk(v1[0], v1[1]); w.w = cvtpk(v1[2], v1[3]); return w; }

struct EpiQKV { static constexpr bool PERM = true;
    bf16_t* O; float* SM;
    DI void operator()(const f32x4 (&acc)[2][2][4][2], const Unit& u, int wr, int wc, int fr, int fq) const {
        const int row0 = u.pm * BM + wr * 64 + fr, colt = u.pn * BM + wc * 32 + 8 * fq;
#pragma unroll
        for (int bj = 0; bj < 2; ++bj) { const int col = colt + bj * HALF;
            const bool isq = (col < C_AK) || (col >= C_BQ && col < C_BKC) || (col >= C_CQ && col < C_CK);
            const float sc = isq ? C2 : 1.f; const bool sm = (col >= C_SM && col < C_SM + 32);
#pragma unroll
            for (int ai = 0; ai < 2; ++ai)
#pragma unroll
                for (int m = 0; m < 4; ++m) { const int row = row0 + ai * HALF + m * 16;
                    const f32x4 v0 = acc[ai][bj][m][0] * sc, v1 = acc[ai][bj][m][1] * sc;
                    *(u32x4*)(O + (size_t)row * QKV_N + col) = pack8(v0, v1);
                    if (sm) { float* sp = SM + (size_t)row * 32 + (col - C_SM); *(f32x4*)sp = v0; *(f32x4*)(sp + 4) = v1; } } }
    }
};
struct EpiWO { static constexpr bool PERM = false;
    const float* xin; float* V; const float* g1;
    DI void operator()(const f32x4 (&acc)[2][2][4][2], const Unit& u, int wr, int wc, int fr, int fq) const {
        const int row0 = u.pm * BM + wr * 64 + fr, col0 = u.pn * BM + wc * 32 + 4 * fq; const int b = (u.pm * BM) >> 12;
#pragma unroll
        for (int bj = 0; bj < 2; ++bj)
#pragma unroll
            for (int n = 0; n < 2; ++n) { const int col = col0 + bj * HALF + n * 16; const f32x4 gg = *(const f32x4*)(g1 + (size_t)b * 6144 + col) + 1.f;
#pragma unroll
                for (int ai = 0; ai < 2; ++ai)
#pragma unroll
                    for (int m = 0; m < 4; ++m) { const size_t off = (size_t)(row0 + ai * HALF + m * 16) * DM + col;
                        const f32x4 xv = *(const f32x4*)(xin + off); *(f32x4*)(V + off) = xv * ALPHA + gg * acc[ai][bj][m][n]; } }
    }
};
DI f32x4 swiglu4(const f32x4& g, const f32x4& u) { f32x4 r; r[0] = siluf_(g[0]) * u[0]; r[1] = siluf_(g[1]) * u[1]; r[2] = siluf_(g[2]) * u[2]; r[3] = siluf_(g[3]) * u[3]; return r; }
struct EpiSH { static constexpr bool PERM = true;
    float* LOG; bf16_t* ACT;
    DI void operator()(const f32x4 (&acc)[2][2][4][2], const Unit& u, int wr, int wc, int fr, int fq) const {
        const int row0 = u.pm * BM + wr * 64 + fr, c8 = wc * 32 + 8 * fq;
        if (u.pn == 0) {
#pragma unroll
            for (int bj = 0; bj < 2; ++bj)
#pragma unroll
                for (int ai = 0; ai < 2; ++ai)
#pragma unroll
                    for (int m = 0; m < 4; ++m) { float* p = LOG + (size_t)(row0 + ai * HALF + m * 16) * 256 + bj * HALF + c8; *(f32x4*)p = acc[ai][bj][m][0]; *(f32x4*)(p + 4) = acc[ai][bj][m][1]; }
        } else {
            const int cb = (u.pn - 1) * HALF + c8;
#pragma unroll
            for (int ai = 0; ai < 2; ++ai)
#pragma unroll
                for (int m = 0; m < 4; ++m) { const f32x4 a0 = swiglu4(acc[ai][0][m][0], acc[ai][1][m][0]), a1 = swiglu4(acc[ai][0][m][1], acc[ai][1][m][1]);
                    *(u32x4*)(ACT + (size_t)(row0 + ai * HALF + m * 16) * 256 + cb) = pack8(a0, a1); }
        }
    }
};
struct EpiGU { static constexpr bool PERM = true;
    bf16_t* ACT;
    DI void operator()(const f32x4 (&acc)[2][2][4][2], const Unit& u, int wr, int wc, int fr, int fq) const {
        const int rin0 = wr * 64 + fr, cb = (u.pn & 1) * HALF + wc * 32 + 8 * fq;
#pragma unroll
        for (int ai = 0; ai < 2; ++ai)
#pragma unroll
            for (int m = 0; m < 4; ++m) { const int rin = rin0 + ai * HALF + m * 16;
                if (u.lrow0 + rin < u.cnt) { const f32x4 a0 = swiglu4(acc[ai][0][m][0], acc[ai][1][m][0]), a1 = swiglu4(acc[ai][0][m][1], acc[ai][1][m][1]);
                    *(u32x4*)(ACT + (size_t)(u.pm * BM + rin) * 256 + cb) = pack8(a0, a1); } }
    }
};
struct EpiDown { static constexpr bool PERM = true;
    bf16_t* YB; const int* DST; const float* WL;
    DI void operator()(const f32x4 (&acc)[2][2][4][2], const Unit& u, int wr, int wc, int fr, int fq) const {
        const int rin0 = wr * 64 + fr, cb = (u.pn & 3) * BM + wc * 32 + 8 * fq;
#pragma unroll
        for (int ai = 0; ai < 2; ++ai)
#pragma unroll
            for (int m = 0; m < 4; ++m) { const int local = u.lrow0 + rin0 + ai * HALF + m * 16;
                if (local < u.cnt) { const int dst = DST[(size_t)u.e * NTOK + local]; const float w = WL[(size_t)u.e * NTOK + local];
#pragma unroll
                    for (int bj = 0; bj < 2; ++bj) *(u32x4*)(YB + (size_t)dst * DM + cb + bj * HALF) = pack8(acc[ai][bj][m][0] * w, acc[ai][bj][m][1] * w); } }
    }
};
struct EpiShDown { static constexpr bool PERM = true;
    bf16_t* Y;
    DI void operator()(const f32x4 (&acc)[2][2][4][2], const Unit& u, int wr, int wc, int fr, int fq) const {
        const int row0 = u.pm * BM + wr * 64 + fr, cb = u.pn * BM + wc * 32 + 8 * fq;
#pragma unroll
        for (int ai = 0; ai < 2; ++ai)
#pragma unroll
            for (int m = 0; m < 4; ++m)
#pragma unroll
                for (int bj = 0; bj < 2; ++bj) *(u32x4*)(Y + (size_t)(row0 + ai * HALF + m * 16) * DM + cb + bj * HALF) = pack8(acc[ai][bj][m][0], acc[ai][bj][m][1]);
    }
};
}

namespace att {
#define MFMA32(a, b, c) __builtin_amdgcn_mfma_f32_32x32x16_bf16((a), (b), (c), 0, 0, 0)
constexpr int A_KB = 0, A_VB = 16384, A_IMP = 32768, A_SEL = A_IMP + 4 * 64 * 65 * 4  , A_END = A_SEL + 512;
static_assert(A_END <= RING_BYTES, "attention LDS");
constexpr float NEGINF = -__builtin_inff();
enum { M_BAND = 0, M_SLC = 1, M_FOX = 2, M_CMP1 = 3, M_CMP2 = 4 };
typedef short v4i16_t __attribute__((ext_vector_type(4)));
DI s16x4 vtr(LAS const char* p) { return __builtin_bit_cast(s16x4, __builtin_amdgcn_ds_read_tr16_b64_v4i16((LAS v4i16_t*)p)); }
DI int cofs(int i) { return (i & 3) + 8 * (i >> 2); }

struct Acc { f32x16 o0, o1; float m, l; };
struct PassArgs {
    const bf16_t* Kg; const bf16_t* Vg; int pitch;
    int jfirst, ntiles, step;
    int tq0;
    const LAS float* lut;
    unsigned long long sel;
    float dq; const float* dkg;
    float fm, frl;
    LAS float* imp;
};

DI void qk_tile(f32x16& p0, f32x16& p1, LAS const char* kb, const bf16x8 (&qr)[4], int r, int h) {
#pragma unroll
    for (int i = 0; i < 16; ++i) { p0[i] = 0.f; p1[i] = 0.f; }
    LAS const char* rp = kb + r * 128;
#pragma unroll
    for (int s = 0; s < 4; ++s) { const int o = 16 * ((2 * s + h) ^ (r & 7));
        const bf16x8 a0 = *(const LAS bf16x8*)(rp + o), a1 = *(const LAS bf16x8*)(rp + 4096 + o);
        p0 = MFMA32(a0, qr[s], p0); p1 = MFMA32(a1, qr[s], p1); }
}
DI bf16x8 pack_step(const f32x16& x, int s) { u32x4 p; p.x = cvtpk(x[8 * s], x[8 * s + 1]); p.y = cvtpk(x[8 * s + 2], x[8 * s + 3]); p.z = cvtpk(x[8 * s + 4], x[8 * s + 5]); p.w = cvtpk(x[8 * s + 6], x[8 * s + 7]); return __builtin_bit_cast(bf16x8, p); }
DI void pv_tile(f32x16& o0, f32x16& o1, const f32x16& p0, const f32x16& p1, LAS const char* va0, LAS const char* va1) {
#pragma unroll
    for (int blk = 0; blk < 2; ++blk)
#pragma unroll
        for (int s = 0; s < 2; ++s) { const bf16x8 xs = pack_step(blk ? p1 : p0, s); const int ro = (32 * blk + 16 * s) * 128;
            { const s16x4 lo = vtr(va0 + ro), hi = vtr(va0 + ro + 1024); const bf16x8 vf = __builtin_shufflevector(lo, hi, 0, 1, 2, 3, 4, 5, 6, 7); o0 = MFMA32(vf, xs, o0); }
            { const s16x4 lo = vtr(va1 + ro), hi = vtr(va1 + ro + 1024); const bf16x8 vf = __builtin_shufflevector(lo, hi, 0, 1, 2, 3, 4, 5, 6, 7); o1 = MFMA32(vf, xs, o1); } }
}

template <int MODE, int W>
DI void attn_pass(LAS char* lds, const PassArgs& P, const bf16x8 (&qr)[4], Acc& a, int tid_, int lane_) {
    int lane; asm volatile("v_mbcnt_lo_u32_b32 %0, -1, 0\n\tv_mbcnt_hi_u32_b32 %0, -1, %0" : "=v"(lane)); const int tid = (tid_ & ~63) | lane; (void)lane_;
    const int r = lane & 31, h = lane >> 5;
    const int lrow = tid >> 3, lch = tid & 7;
    const size_t goff = (size_t)lrow * P.pitch + lch * 8;
    const int kdst = lrow * 128 + 16 * (lch ^ (lrow & 7)), vdst = lrow * 128 + 16 * (lch ^ (((lrow >> 1) & 1) << 2));
    const int q4 = (lane & 15) >> 2, p4 = lane & 3, g1 = (lane >> 4) & 1, swb = (q4 >> 1) & 1;
    const int vofs0 = (4 * h + q4) * 128 + 16 * (4 * (0 ^ swb) + 2 * g1 + (p4 >> 1)) + 8 * (p4 & 1);
    const int vofs1 = (4 * h + q4) * 128 + 16 * (4 * (1 ^ swb) + 2 * g1 + (p4 >> 1)) + 8 * (p4 & 1);
    const int tq = P.tq0 + r;
    u32x4 kr, vr;
    { const size_t t0 = (size_t)P.jfirst * 64 * P.pitch + goff; kr = *(const u32x4*)(P.Kg + t0); vr = *(const u32x4*)(P.Vg + t0); }
    *(LAS u32x4*)(lds + A_KB + kdst) = kr; *(LAS u32x4*)(lds + A_VB + vdst) = vr;
    __syncthreads();
    float carry = 0.f;
    for (int it = 0; it < P.ntiles; ++it) {
        const int j = P.jfirst + it * P.step, buf = it & 1;
        const bool more = (it + 1 < P.ntiles);
        if (more) { const size_t t0 = (size_t)(j + P.step) * 64 * P.pitch + goff; kr = *(const u32x4*)(P.Kg + t0); vr = *(const u32x4*)(P.Vg + t0); }
        const int kv0 = 64 * j;
        bool skip;
        if (MODE == M_BAND) skip = (kv0 > P.tq0 + 31) || (kv0 + 63 < P.tq0 - (W - 1));
        else if (MODE == M_SLC) skip = (kv0 > P.tq0 + 31) || (__ballot((P.sel >> j) & 1ull) == 0ull);
        else if (MODE == M_FOX) skip = (kv0 > P.tq0 + 31);
        else skip = (1024 * j > P.tq0);
        if (!skip) {
            LAS const char* kb = lds + A_KB + buf * 8192; LAS const char* vb = lds + A_VB + buf * 8192;
            f32x16 p0, p1; qk_tile(p0, p1, kb, qr, r, h);
            if (MODE == M_BAND || MODE == M_SLC) {
                const bool far = (P.tq0 - (kv0 + 63) >= 127) && (MODE == M_SLC || (P.tq0 + 31 - kv0 < W));
                if (far) { const float c = P.lut[127];
#pragma unroll
                    for (int i = 0; i < 16; ++i) { p0[i] += c; p1[i] += c; }
                } else { const int base = tq - kv0 - 4 * h;
#pragma unroll
                    for (int i = 0; i < 16; ++i) {
                        { const int rel = base - cofs(i); const bool ok = (MODE == M_SLC) ? (rel >= 0) : ((unsigned)rel < (unsigned)W); int ix = rel < 127 ? rel : 127; ix = ix > 0 ? ix : 0; p0[i] = ok ? p0[i] + P.lut[ix] : NEGINF; }
                        { const int rel = base - 32 - cofs(i); const bool ok = (MODE == M_SLC) ? (rel >= 0) : ((unsigned)rel < (unsigned)W); int ix = rel < 127 ? rel : 127; ix = ix > 0 ? ix : 0; p1[i] = ok ? p1[i] + P.lut[ix] : NEGINF; } }
                }
                if (MODE == M_SLC) { if (!((P.sel >> j) & 1ull)) {
#pragma unroll
                    for (int i = 0; i < 16; ++i) { p0[i] = NEGINF; p1[i] = NEGINF; } } }
            } else if (MODE == M_FOX) {
                const bool full = (kv0 + 63 <= P.tq0); const int base = tq - kv0 - 4 * h;
#pragma unroll
                for (int k = 0; k < 4; ++k) { const f32x4 d0 = *(const f32x4*)(P.dkg + kv0 + 8 * k + 4 * h), d1 = *(const f32x4*)(P.dkg + kv0 + 32 + 8 * k + 4 * h);
#pragma unroll
                    for (int e = 0; e < 4; ++e) { const int i = 4 * k + e; const int rel = base - cofs(i);
                        const float v0 = p0[i] + (P.dq - d0[e]), v1 = p1[i] + (P.dq - d1[e]);
                        p0[i] = (full || rel >= 0) ? v0 : NEGINF; p1[i] = (full || rel - 32 >= 0) ? v1 : NEGINF; } }
            } else {
                const int base = tq - 31 - 16 * (64 * j + 4 * h);
#pragma unroll
                for (int i = 0; i < 16; ++i) {
                    { const int rel = base - 16 * cofs(i); const bool ok = rel >= 0; int ix = rel < 127 ? rel : 127; ix = ix > 0 ? ix : 0; p0[i] = ok ? p0[i] + P.lut[ix] : NEGINF; }
                    { const int rel = base - 512 - 16 * cofs(i); const bool ok = rel >= 0; int ix = rel < 127 ? rel : 127; ix = ix > 0 ? ix : 0; p1[i] = ok ? p1[i] + P.lut[ix] : NEGINF; } }
            }
            if (MODE != M_CMP2) {
                float tm = fmaxf(p0[0], p1[0]);
#pragma unroll
                for (int i = 1; i < 16; ++i) tm = fmaxf(tm, fmaxf(p0[i], p1[i]));
                tm = fmaxf(tm, __shfl_xor(tm, 32));
                const float mn = fmaxf(a.m, tm);
                const float alpha = fast_exp2(a.m - mn);
                a.m = mn;
                if (__any(alpha != 1.f)) { a.l *= alpha;
                    if (MODE != M_CMP1) {
#pragma unroll
                        for (int i = 0; i < 16; ++i) { a.o0[i] *= alpha; a.o1[i] *= alpha; } } }
                float s = 0.f;
#pragma unroll
                for (int i = 0; i < 16; ++i) { p0[i] = fast_exp2(p0[i] - mn); p1[i] = fast_exp2(p1[i] - mn); s += p0[i] + p1[i]; }
                a.l += s;
                if (MODE != M_CMP1) pv_tile(a.o0, a.o1, p0, p1, vb + vofs0, vb + vofs1);
            } else {
#pragma unroll
                for (int i = 0; i < 16; ++i) { p0[i] = fast_exp2(p0[i] - P.fm) * P.frl; p1[i] = fast_exp2(p1[i] - P.fm) * P.frl; }
                float a8[8], b8[8];
#pragma unroll
                for (int k = 0; k < 4; ++k) { a8[k] = p0[4 * k] + p0[4 * k + 1] + p0[4 * k + 2] + 0.5f * p0[4 * k + 3]; b8[k] = 0.5f * p0[4 * k + 3];
                    a8[4 + k] = p1[4 * k] + p1[4 * k + 1] + p1[4 * k + 2] + 0.5f * p1[4 * k + 3]; b8[4 + k] = 0.5f * p1[4 * k + 3]; }
                float bs[8];
#pragma unroll
                for (int k = 0; k < 8; ++k) bs[k] = __shfl_xor(b8[k], 32);
#pragma unroll
                for (int k = 0; k < 8; ++k) { const float prev = (k == 0) ? carry : bs[k > 0 ? k - 1 : 0]; P.imp[16 * j + 2 * k + h] = a8[k] + (h ? bs[k] : prev); }
                carry = bs[7];
                pv_tile(a.o0, a.o1, p0, p1, vb + vofs0, vb + vofs1);
            }
        } else if (MODE == M_CMP2) {
            if (h == 0) P.imp[16 * j] = carry;
            carry = 0.f;
        }
        if (more) { *(LAS u32x4*)(lds + A_KB + (buf ^ 1) * 8192 + kdst) = kr; *(LAS u32x4*)(lds + A_VB + (buf ^ 1) * 8192 + vdst) = vr; }
        __syncthreads();
    }
}
DI void acc_init(Acc& a, float m0, float l0) {
#pragma unroll
    for (int i = 0; i < 16; ++i) { a.o0[i] = 0.f; a.o1[i] = 0.f; }
    a.m = m0; a.l = l0;
}
DI void load_q(bf16x8 (&qr)[4], const bf16_t* Qrow  , int lane) {
    const bf16_t* p = Qrow + (size_t)(lane & 31) * QKV_N + 8 * (lane >> 5);
#pragma unroll
    for (int s = 0; s < 4; ++s) qr[s] = *(const bf16x8*)(p + 16 * s);
}
DI void store_ot(bf16_t* O, const f32x16& y0, const f32x16& y1, float sc, int lane) {
    bf16_t* rowp = O + (size_t)(lane & 31) * DM + 4 * (lane >> 5);
#pragma unroll
    for (int g = 0; g < 4; ++g) {
        u32x2 a; a.x = cvtpk(y0[4 * g] * sc, y0[4 * g + 1] * sc); a.y = cvtpk(y0[4 * g + 2] * sc, y0[4 * g + 3] * sc); *(u32x2*)(rowp + 8 * g) = a;
        u32x2 b; b.x = cvtpk(y1[4 * g] * sc, y1[4 * g + 1] * sc); b.y = cvtpk(y1[4 * g + 2] * sc, y1[4 * g + 3] * sc); *(u32x2*)(rowp + 32 + 8 * g) = b; }
}
}

#ifndef PH_MASK
#define PH_MASK 0xFFFF
#endif
#define PH(k) ((PH_MASK >> (k)) & 1)
struct Args { const float* in[25]; float* out; unsigned char* ws; };

DI float wave_sum(float v) {
#pragma unroll
    for (int o = 1; o < 64; o <<= 1) v += __shfl_xor(v, o);
    return v;
}
DI unsigned f2bf(float f) { unsigned u = __builtin_bit_cast(unsigned, f); return (u + 0x7fffu + ((u >> 16) & 1u)) >> 16; }
DI unsigned pk2(float lo, float hi) { return f2bf(lo) | (f2bf(hi) << 16); }

enum { MAP_ID = 0, MAP_WIN = 1, MAP_GU_G = 2, MAP_GU_U = 3 };
DI int map_row(int kind, int c) {
    if (kind == MAP_WIN) { if (c < 1280) return c; if (c < 1292) return C_SM + (c - 1280); if (c < 2444) return c - 12; return c; }
    if (kind == MAP_GU_G) return (c >> 7) * 256 + (c & 127);
    if (kind == MAP_GU_U) return (c >> 7) * 256 + 128 + (c & 127);
    return c;
}
DI void cvt_item(const float* W, int K, int N, bf16_t* WT, int kind, int row_off, LAS float* scr, int item, int lane) {
    const int nblk = (N + 31) / 32, kb = item / nblk, nb = item % nblk, k0 = 64 * kb, n0 = 32 * nb;
    const int cn = n0 + (lane & 31); const bool cok = cn < N;
#pragma unroll 8
    for (int i = 0; i < 32; ++i) { const int kk = 2 * i + (lane >> 5); scr[kk * 33 + (lane & 31)] = cok ? W[(size_t)(k0 + kk) * N + cn] : 0.f; }
    asm volatile("s_waitcnt lgkmcnt(0)" ::: "memory");
    const int c = lane & 7;
#pragma unroll
    for (int j = 0; j < 4; ++j) { const int n = (lane >> 3) + 8 * j; const LAS float* s = scr + (8 * c) * 33 + n;
        u32x4 o; o.x = pk2(s[0 * 33], s[1 * 33]); o.y = pk2(s[2 * 33], s[3 * 33]); o.z = pk2(s[4 * 33], s[5 * 33]); o.w = pk2(s[6 * 33], s[7 * 33]);
        if (n0 + n < N) *(u32x4*)(WT + (size_t)(row_off + map_row(kind, n0 + n)) * K + k0 + 8 * c) = o; }
    asm volatile("s_waitcnt lgkmcnt(0)" ::: "memory");
}

DI unsigned long long ldp(volatile LAS unsigned long long* PT, int k) { int ko = k; asm volatile("" : "+v"(ko)); const unsigned long long v = PT[ko];
    const unsigned lo = __builtin_amdgcn_readfirstlane((unsigned)v), hi = __builtin_amdgcn_readfirstlane((unsigned)(v >> 32)); return ((unsigned long long)hi << 32) | lo; }
#define INP(k) ((const float*)ldp(PT, (k)))
#define WSP(off) ((unsigned char*)ldp(PT, 26) + (off))
#define OUTP ((float*)ldp(PT, 25))

__global__ void __launch_bounds__(512, 2) mega_fwd(Args args) {
    extern __shared__ __attribute__((aligned(16))) unsigned char lds_raw[];
    LAS unsigned char* lds = (LAS unsigned char*)lds_raw;
    volatile LAS unsigned* MISC = (volatile LAS unsigned*)(lds + L_MISC);
    LAS float* LUT = (LAS float*)(lds + L_LUT);
    LAS int* TP = (LAS int*)(lds + L_TP);
    LAS int* CNTL = (LAS int*)(lds + L_CNT);
    const int wid0 = __builtin_amdgcn_readfirstlane((int)threadIdx.x >> 6);
#define LAUNDER_TID int lane; asm volatile("v_mbcnt_lo_u32_b32 %0, -1, 0\n\tv_mbcnt_hi_u32_b32 %0, -1, %0" : "=v"(lane)); int wid = wid0; asm volatile("" : "+s"(wid)); const int tid = wid * 64 + lane; (void)tid;
    const int G = gridDim.x, bx = blockIdx.x;
    volatile LAS unsigned long long* PT = (volatile LAS unsigned long long*)(lds + L_PT);
    { LAUNDER_TID
    if (tid == 0) {
        PT[0] = (unsigned long long)args.in[0]; PT[1] = (unsigned long long)args.in[1]; PT[2] = (unsigned long long)args.in[2]; PT[3] = (unsigned long long)args.in[3];
        PT[4] = (unsigned long long)args.in[4]; PT[5] = (unsigned long long)args.in[5]; PT[6] = (unsigned long long)args.in[6]; PT[7] = (unsigned long long)args.in[7];
        PT[8] = (unsigned long long)args.in[8]; PT[9] = (unsigned long long)args.in[9]; PT[10] = (unsigned long long)args.in[10]; PT[11] = (unsigned long long)args.in[11];
        PT[12] = (unsigned long long)args.in[12]; PT[13] = (unsigned long long)args.in[13]; PT[14] = (unsigned long long)args.in[14]; PT[15] = (unsigned long long)args.in[15];
        PT[16] = (unsigned long long)args.in[16]; PT[17] = (unsigned long long)args.in[17]; PT[18] = (unsigned long long)args.in[18]; PT[19] = (unsigned long long)args.in[19];
        PT[20] = (unsigned long long)args.in[20]; PT[21] = (unsigned long long)args.in[21]; PT[22] = (unsigned long long)args.in[22]; PT[23] = (unsigned long long)args.in[23];
        PT[24] = (unsigned long long)args.in[24]; PT[25] = (unsigned long long)args.out; PT[26] = (unsigned long long)args.ws;
    }
    for (int u = tid; u < 64; u += 512) MISC[u] = 0u;
    for (int u = tid; u < 1280; u += 512) { const int hh = u >> 7, rel = u & 127; int bk = rel;
        if (rel >= 16) { bk = 16; const int th[15] = {19, 21, 24, 27, 31, 35, 40, 46, 52, 59, 67, 77, 87, 99, 113};
#pragma unroll
            for (int q = 0; q < 15; ++q) bk += (rel >= th[q]) ? 1 : 0; }
        LUT[u] = args.in[10][bk * 10 + hh] * LOG2E; }
    }
    __syncthreads();
    XcdBarrier bar = xcd_barrier_post((unsigned*)WSP(WS_CTL) + CW_BAR, MISC);
#define GRID_BAR() do { XcdBarrier b2_ = bar; b2_.bar = (unsigned*)WSP(WS_CTL) + CW_BAR; asm volatile("" : "+s"(b2_.x)); int ln_; asm volatile("v_mbcnt_lo_u32_b32 %0, -1, 0\n\tv_mbcnt_hi_u32_b32 %0, -1, %0" : "=v"(ln_)); xcd_barrier(b2_, (wid0 == 0) && (ln_ == 0)); } while (0)
#define QNEXT(ctr, dstvar) do { if (tid == 0) MISC[8] = atomicAdd((ctr), 1u); __syncthreads(); dstvar = (int)__builtin_amdgcn_readfirstlane(MISC[8]); __syncthreads(); } while (0)

    if (PH(0)) { LAUNDER_TID
            float* ADA = (float*)WSP(WS_ADA); float* CPOS = (float*)WSP(WS_CPOS); bf16_t* WIN = (bf16_t*)WSP(WS_WIN); bf16_t* WO = (bf16_t*)WSP(WS_WO); bf16_t* WSH = (bf16_t*)WSP(WS_WSH); bf16_t* WSD = (bf16_t*)WSP(WS_WSD); bf16_t* WCT = (bf16_t*)WSP(WS_WCT); bf16_t* WGU = (bf16_t*)WSP(WS_WGU); bf16_t* WD = (bf16_t*)WSP(WS_WD);
        if (bx < 192) {
            LAS float* cond = (LAS float*)lds;
            LAS float* red = (LAS float*)(lds + 32768);
            for (int u = tid; u < 8192; u += 512) cond[u] = siluf_(INP(1)[u]);
            __syncthreads();
            const int l = bx / 96, j0 = (bx % 96) * 64;
            const float* wa = INP(11) + (size_t)l * DM * 6144 + j0 + lane;
            float accb[8];
#pragma unroll
            for (int b = 0; b < 8; ++b) accb[b] = 0.f;
#pragma unroll 8
            for (int kk = 0; kk < 128; ++kk) { const int k = wid * 128 + kk; const float w = wa[(size_t)k * 6144];
#pragma unroll
                for (int b = 0; b < 8; ++b) accb[b] += cond[b * 1024 + k] * w; }
#pragma unroll
            for (int b = 0; b < 8; ++b) red[(wid * 8 + b) * 64 + lane] = accb[b];
            __syncthreads();
            { const int b = tid >> 6; float s = INP(12)[l * 6144 + j0 + lane];
#pragma unroll
                for (int w = 0; w < 8; ++w) s += red[(w * 8 + b) * 64 + lane];
                ADA[((size_t)l * 8 + b) * 6144 + j0 + lane] = s; }
            __syncthreads();
        } else if (bx < 196 && wid == 0) {
            const int l = (bx - 192) >> 1, which = (bx - 192) & 1;
            const float* pos = INP(which ? 7 : 5) + (size_t)l * 2048; const float* w = INP(which ? 8 : 6) + (size_t)l * 2048 * 64;
            float s = 0.f;
#pragma unroll 8
            for (int k = 0; k < 2048; ++k) s += pos[k] * w[(size_t)k * 64 + lane];
            CPOS[(l * 2 + which) * 64 + lane] = s;
        }
        { const int gt = bx * 512 + tid; const int per = (QKV_N - D_IN) * DM / 8;
            for (int u = gt; u < 2 * per; u += G * 512) { const int l = u / per, r = u % per; *(u32x4*)(WIN + ((size_t)l * QKV_N + D_IN) * DM + (size_t)r * 8) = (u32x4){0u, 0u, 0u, 0u}; } }
        LAS float* scr = (LAS float*)(lds + wid * 16384);
        const int gw = bx * 8 + wid, NGW = G * 8;
        constexpr int I_SMALL = 2384, I_EXP = 384;
        const int NITEMS = DEPTH * I_SMALL + DEPTH * NEXP * I_EXP;
        for (int it = gw; it < NITEMS; it += NGW) {
            if (it < DEPTH * I_SMALL) { const int l = it / I_SMALL; int r = it % I_SMALL;
                if (r < 1232) { cvt_item(INP(2) + (size_t)l * DM * D_IN, DM, D_IN, WIN + (size_t)l * QKV_N * DM, MAP_WIN, 0, scr, r, lane); continue; } r -= 1232;
                if (r < 512) { cvt_item(INP(3) + (size_t)l * DM * DM, DM, DM, WO + (size_t)l * DM * DM, MAP_ID, 0, scr, r, lane); continue; } r -= 512;
                if (r < 128) { cvt_item(INP(17) + (size_t)l * DM * 256, DM, 256, WSH + (size_t)l * 768 * DM, MAP_ID, 0, scr, r, lane); continue; } r -= 128;
                if (r < 128) { cvt_item(INP(22) + (size_t)l * DM * 256, DM, 256, WSH + (size_t)l * 768 * DM, MAP_GU_G, 256, scr, r, lane); continue; } r -= 128;
                if (r < 128) { cvt_item(INP(23) + (size_t)l * DM * 256, DM, 256, WSH + (size_t)l * 768 * DM, MAP_GU_U, 256, scr, r, lane); continue; } r -= 128;
                if (r < 128) { cvt_item(INP(24) + (size_t)l * 256 * DM, 256, DM, WSD + (size_t)l * DM * 256, MAP_ID, 0, scr, r, lane); continue; } r -= 128;
                if (r < 64) { cvt_item(INP(6) + (size_t)l * 2048 * 64, 2048, 64, WCT + (size_t)(l * 2 + 0) * 64 * 2048, MAP_ID, 0, scr, r, lane); continue; } r -= 64;
                cvt_item(INP(8) + (size_t)l * 2048 * 64, 2048, 64, WCT + (size_t)(l * 2 + 1) * 64 * 2048, MAP_ID, 0, scr, r, lane);
            } else { const int r0 = it - DEPTH * I_SMALL; const int le = r0 / I_EXP, r = r0 % I_EXP;
                if (r < 128) cvt_item(INP(19) + (size_t)le * DM * EDIM, DM, EDIM, WGU + (size_t)le * 512 * DM, MAP_GU_G, 0, scr, r, lane);
                else if (r < 256) cvt_item(INP(20) + (size_t)le * DM * EDIM, DM, EDIM, WGU + (size_t)le * 512 * DM, MAP_GU_U, 0, scr, r - 128, lane);
                else cvt_item(INP(21) + (size_t)le * EDIM * DM, EDIM, DM, WD + (size_t)le * DM * EDIM, MAP_ID, 0, scr, r - 256, lane);
            }
        }
    }
    GRID_BAR();
    if (PH(1)) { LAUNDER_TID
            float* ADA = (float*)WSP(WS_ADA); bf16_t* H = (bf16_t*)WSP(WS_H);
        const int gw = bx * 8 + wid, NGW = G * 8;
        for (int m = gw; m < NTOK; m += NGW) { const int b = m >> 12; const float* ad = ADA + (size_t)b * 6144;
            const f32x4* xr = (const f32x4*)(INP(0) + (size_t)m * DM) + lane; unsigned long long* o8 = (unsigned long long*)(H + (size_t)m * DM) + lane;
#pragma unroll
            for (int j = 0; j < 4; ++j) { const f32x4 v = xr[64 * j]; const f32x4 sh = *((const f32x4*)(ad) + 64 * j + lane), sc = *((const f32x4*)(ad + 1024) + 64 * j + lane);
                const f32x4 hv = v * (sc + 1.f) + sh; o8[64 * j] = (unsigned long long)cvtpk(hv[0], hv[1]) | ((unsigned long long)cvtpk(hv[2], hv[3]) << 32); } }
    }
    GRID_BAR();

    for (int l = 0; l < DEPTH; ++l) {
        if (PH(2)) { LAUNDER_TID
            bf16_t* H = (bf16_t*)WSP(WS_H); bf16_t* WIN = (bf16_t*)WSP(WS_WIN); bf16_t* QKV = (bf16_t*)WSP(WS_QKV); float* SMALL = (float*)WSP(WS_SMALL);
            pg8::Gemm g{H, WIN + (size_t)l * QKV_N * DM, DM}; pg8::StaticOrder S; S.init(NTOK, QKV_N, G, bx);
            pg8::EpiQKV E{QKV, SMALL};
            pg8::gemm_phase<pg8::EpiQKV, pg8::StaticOrder>(lds, g, S, E, wid);
        }
        GRID_BAR();
        if (PH(3)) { LAUNDER_TID
            unsigned* ctl = (unsigned*)WSP(WS_CTL); bf16_t* QKV = (bf16_t*)WSP(WS_QKV); bf16_t* WCT = (bf16_t*)WSP(WS_WCT); float* CPOS = (float*)WSP(WS_CPOS); bf16_t* KCMP = (bf16_t*)WSP(WS_KCMP); bf16_t* VCMP = (bf16_t*)WSP(WS_VCMP); float* SMALL = (float*)WSP(WS_SMALL); float* DC = (float*)WSP(WS_DC); bf16_t* OB = (bf16_t*)WSP(WS_O);
            unsigned* qctr = ctl + CW_Q + 64 * (l * 4 + 0);
            for (;;) {
                int u; QNEXT(qctr, u);
                if (u >= 32 + 48 + 768) break;
                if (u < 32) {
                    const int b = u >> 2, which = (u >> 1) & 1, cblk = u & 1, nblk = wid, r = lane & 31, h = lane >> 5;
                    int n = 32 * nblk + r; n = n < 254 ? n : 254;
                    const bf16_t* arow = QKV + ((size_t)b * SEQ + 16 * n) * QKV_N + (which ? C_BVC : C_BKC) + 8 * h;
                    const bf16_t* brow = WCT + ((size_t)(l * 2 + which) * 64 + 32 * cblk + r) * 2048 + 8 * h;
                    f32x16 acc;
#pragma unroll
                    for (int i = 0; i < 16; ++i) acc[i] = 0.f;
#pragma unroll 4
                    for (int s = 0; s < 128; ++s) { const int k = 16 * s; const bf16x8 af = *(const bf16x8*)(arow + (size_t)(k >> 6) * QKV_N + (k & 63)); const bf16x8 bf = *(const bf16x8*)(brow + k);
                        acc = MFMA32(af, bf, acc); }
                    const float cp = CPOS[(l * 2 + which) * 64 + 32 * cblk + r]; bf16_t* dst = (which ? VCMP : KCMP) + (size_t)b * 256 * 64 + 32 * cblk + r;
#pragma unroll
                    for (int i = 0; i < 16; ++i) { const int nn = 32 * nblk + (i & 3) + 8 * (i >> 2) + 4 * h; dst[(size_t)nn * 64] = (bf16_t)(nn < 255 ? f2bf(acc[i] + cp) : 0u); }
                } else if (u < 80) {
                    const int b = (u - 32) / 6, hh = (u - 32) % 6; const float fb = INP(9)[l * 6 + hh];
                    LAS float* wsum = (LAS float*)lds;
                    float v[8]; float run = 0.f;
#pragma unroll
                    for (int i = 0; i < 8; ++i) { const float x = SMALL[((size_t)b * SEQ + 8 * tid + i) * 32 + 12 + hh] + fb; const float lf = fminf(x, 0.f) - log1pf(__expf(-fabsf(x))); run += lf; v[i] = run; }
                    float incl = run;
#pragma unroll
                    for (int o = 1; o < 64; o <<= 1) { const float t = __shfl_up(incl, o); if (lane >= o) incl += t; }
                    if (lane == 63) wsum[wid] = incl;
                    __syncthreads();
                    float base = incl - run;
                    for (int w = 0; w < wid; ++w) base += wsum[w];
                    float* dst = DC + ((size_t)b * 6 + hh) * SEQ + 8 * tid;
#pragma unroll
                    for (int i = 0; i < 8; ++i) dst[i] = (base + v[i]) * LOG2E;
                    __syncthreads();
                } else {
                    const int ua = u - 80, qt = ua & 15, hq = (ua >> 4) % 6, b = ua / 96, kvh = hq / 3;
                    const size_t tok0 = (size_t)b * SEQ + 256 * qt + 32 * wid;
                    bf16x8 qr[4]; att::load_q(qr, QKV + tok0 * QKV_N + C_AQ + 64 * hq, lane);
                    att::Acc a; att::acc_init(a, INP(4)[l * 6 + hq] * LOG2E, (lane < 32) ? 1.f : 0.f);
                    att::PassArgs P; P.Kg = QKV + (size_t)b * SEQ * QKV_N + C_AK + 64 * kvh; P.Vg = QKV + (size_t)b * SEQ * QKV_N + C_AV + 64 * kvh; P.pitch = QKV_N;
                    P.jfirst = (4 * qt - 2) > 0 ? (4 * qt - 2) : 0; P.ntiles = 4 * qt + 3 - P.jfirst + 1; P.step = 1; P.tq0 = 256 * qt + 32 * wid;
                    P.lut = LUT + 128 * hq; P.sel = 0ull; P.dq = 0.f; P.dkg = nullptr; P.fm = 0.f; P.frl = 0.f; P.imp = nullptr;
                    att::attn_pass<att::M_BAND, 128>((LAS char*)lds, P, qr, a, tid, lane);
                    const float lt = a.l + __shfl_xor(a.l, 32);
                    att::store_ot(OB + tok0 * DM + O_A + 64 * hq, a.o0, a.o1, 1.f / lt, lane);
                }
            }
        }
        GRID_BAR();
        if (PH(4)) { LAUNDER_TID
            unsigned* ctl = (unsigned*)WSP(WS_CTL); bf16_t* QKV = (bf16_t*)WSP(WS_QKV); float* DC = (float*)WSP(WS_DC); bf16_t* KCMP = (bf16_t*)WSP(WS_KCMP); bf16_t* VCMP = (bf16_t*)WSP(WS_VCMP); float* SMALL = (float*)WSP(WS_SMALL); bf16_t* OB = (bf16_t*)WSP(WS_O);
            unsigned* qctr = ctl + CW_Q + 64 * (l * 4 + 1);
            for (;;) {
                int u; QNEXT(qctr, u);
                if (u >= 1280) break;
                const int grp = u / 80, rr = u % 80, L = 15 - grp;
                if (rr < 48) { if (PH(14)) {
                    const int b = rr / 6, hh = rr % 6, qt = L;
                    const size_t tok0 = (size_t)b * SEQ + 256 * qt + 32 * wid;
                    bf16x8 qr[4]; att::load_q(qr, QKV + tok0 * QKV_N + C_CQ + 64 * hh, lane);
                    att::Acc a; att::acc_init(a, -1e30f, 0.f);
                    att::PassArgs P; P.Kg = QKV + (size_t)b * SEQ * QKV_N + C_CK + 64 * hh; P.Vg = QKV + (size_t)b * SEQ * QKV_N + C_CV + 64 * hh; P.pitch = QKV_N;
                    P.jfirst = 4 * qt + 3; P.ntiles = 4 * qt + 4; P.step = -1; P.tq0 = 256 * qt + 32 * wid;
                    P.lut = LUT; P.sel = 0ull; P.dkg = DC + ((size_t)b * 6 + hh) * SEQ; P.dq = P.dkg[P.tq0 + (lane & 31)]; P.fm = 0.f; P.frl = 0.f; P.imp = nullptr;
                    att::attn_pass<att::M_FOX, 0>((LAS char*)lds, P, qr, a, tid, lane);
                    const float lt = a.l + __shfl_xor(a.l, 32);
                    att::store_ot(OB + tok0 * DM + O_C + 64 * hh, a.o0, a.o1, 1.f / lt, lane);
                } } else if (PH(15)) {
                    const int r2 = rr - 48, qt = 4 * L + 3 - (r2 >> 3), b = r2 & 7, head = wid >> 1, qh = wid & 1;
                    const size_t tok0 = (size_t)b * SEQ + 64 * qt + 32 * qh; const int tq0 = 64 * qt + 32 * qh;
                    const int r = lane & 31, h = lane >> 5;
                    LAS float* IMP = (LAS float*)(lds + att::A_IMP);
                    LAS unsigned long long* SELM = (LAS unsigned long long*)(lds + att::A_SEL);
                    for (int q = tid; q < 4 * 64 * 65; q += 512) IMP[q] = 0.f;
                    bf16x8 qr[4]; att::load_q(qr, QKV + tok0 * QKV_N + C_BQ + 64 * head, lane);
                    const float* gl = SMALL + (tok0 + r) * 32 + head;
                    const float g0 = sigmoidf_(gl[0]), g1 = sigmoidf_(gl[4]), g2 = sigmoidf_(gl[8]);
                    att::PassArgs P; P.pitch = 64; P.Kg = KCMP + (size_t)b * 256 * 64; P.Vg = VCMP + (size_t)b * 256 * 64;
                    P.jfirst = 0; P.ntiles = (qt >> 4) + 1; P.step = 1; P.tq0 = tq0; P.lut = LUT + 128 * (6 + head); P.sel = 0ull; P.dq = 0.f; P.dkg = nullptr;
                    P.fm = 0.f; P.frl = 0.f; P.imp = IMP + (head * 64 + 32 * qh + r) * 65;
                    att::Acc a; att::acc_init(a, -1e30f, 0.f);
                    att::attn_pass<att::M_CMP1, 0>((LAS char*)lds, P, qr, a, tid, lane);
                    { const float lt = a.l + __shfl_xor(a.l, 32); P.fm = a.m; P.frl = lt > 0.f ? 1.f / lt : 0.f; }
                    att::acc_init(a, 0.f, 0.f);
                    att::attn_pass<att::M_CMP2, 0>((LAS char*)lds, P, qr, a, tid, lane);
#pragma unroll
                    for (int i = 0; i < 16; ++i) { a.o0[i] *= g0; a.o1[i] *= g0; }
                    for (int qi = 0; qi < 8; ++qi) { const int q = 8 * wid + qi;
                        float v = IMP[(0 * 64 + q) * 65 + lane] + IMP[(1 * 64 + q) * 65 + lane] + IMP[(2 * 64 + q) * 65 + lane] + IMP[(3 * 64 + q) * 65 + lane];
                        if (lane == 0 || lane == qt || lane == qt - 1) v = 1e4f; else if (lane > qt) v = -1.f;
                        int rank = 0;
#pragma unroll
                        for (int jj = 0; jj < 64; ++jj) { const float vj = __uint_as_float(__builtin_amdgcn_readlane(__float_as_uint(v), jj)); rank += ((vj > v) || (vj == v && jj < lane)) ? 1 : 0; }
                        const unsigned long long mk = __ballot(rank < 16);
                        if (lane == 0) SELM[q] = mk; }
                    __syncthreads();
                    P.sel = SELM[32 * qh + r];
                    LAS float* FR = IMP + tid;
#pragma unroll
                    for (int i = 0; i < 16; ++i) { FR[512 * i] = a.o0[i]; FR[512 * (16 + i)] = a.o1[i]; }
                    P.pitch = QKV_N; P.Kg = QKV + (size_t)b * SEQ * QKV_N + C_BKS; P.Vg = QKV + (size_t)b * SEQ * QKV_N + C_BVS; P.jfirst = 0; P.ntiles = qt + 1; P.step = 1;
                    att::acc_init(a, -1e30f, 0.f);
                    att::attn_pass<att::M_SLC, 0>((LAS char*)lds, P, qr, a, tid, lane);
                    { const float lt = a.l + __shfl_xor(a.l, 32); const float sc = g1 / lt;
#pragma unroll
                        for (int i = 0; i < 16; ++i) { FR[512 * i] += sc * a.o0[i]; FR[512 * (16 + i)] += sc * a.o1[i]; } }
                    P.Kg = QKV + (size_t)b * SEQ * QKV_N + C_BKW; P.Vg = QKV + (size_t)b * SEQ * QKV_N + C_BVW; P.jfirst = (qt - 8) > 0 ? (qt - 8) : 0; P.ntiles = qt - P.jfirst + 1;
                    att::acc_init(a, -1e30f, 0.f);
                    att::attn_pass<att::M_BAND, 512>((LAS char*)lds, P, qr, a, tid, lane);
                    { const float lt = a.l + __shfl_xor(a.l, 32); const float sc = g2 / lt;
#pragma unroll
                        for (int i = 0; i < 16; ++i) { a.o0[i] = FR[512 * i] + sc * a.o0[i]; a.o1[i] = FR[512 * (16 + i)] + sc * a.o1[i]; } }
                    att::store_ot(OB + tok0 * DM + O_B + 64 * head, a.o0, a.o1, 1.f, lane);
                }
            }
        }
        GRID_BAR();
        if (PH(5)) { LAUNDER_TID
            bf16_t* OB = (bf16_t*)WSP(WS_O); bf16_t* WO = (bf16_t*)WSP(WS_WO); const float* xin = (l == 0) ? INP(0) : (const float*)OUTP; float* VB = (float*)WSP(WS_V); const float* ada_l = (const float*)WSP(WS_ADA) + (size_t)l * 8 * 6144;
            pg8::Gemm g{OB, WO + (size_t)l * DM * DM, DM}; pg8::StaticOrder S; S.init(NTOK, DM, G, bx);
            pg8::EpiWO E{xin, VB, ada_l + 2 * 1024};
            pg8::gemm_phase<pg8::EpiWO, pg8::StaticOrder>(lds, g, S, E, wid);
        }
        GRID_BAR();
        if (PH(6)) { LAUNDER_TID
            float* VB = (float*)WSP(WS_V); float* X1 = (float*)WSP(WS_X1); bf16_t* H = (bf16_t*)WSP(WS_H); const float* ada_l = (const float*)WSP(WS_ADA) + (size_t)l * 8 * 6144;
            const int gw = bx * 8 + wid, NGW = G * 8; const float* lg = INP(13) + l * DM; const float* lb = INP(14) + l * DM;
            for (int m = gw; m < NTOK; m += NGW) { const int b = m >> 12; const float* ad = ada_l + (size_t)b * 6144;
                const f32x4* xr = (const f32x4*)(VB + (size_t)m * DM) + lane; f32x4 v[4]; float s = 0.f;
#pragma unroll
                for (int j = 0; j < 4; ++j) { v[j] = xr[64 * j]; s += (v[j][0] + v[j][1]) + (v[j][2] + v[j][3]); }
                const float mean = wave_sum(s) * (1.f / DM); float s2 = 0.f;
#pragma unroll
                for (int j = 0; j < 4; ++j) { v[j] = v[j] - mean; s2 += (v[j][0] * v[j][0] + v[j][1] * v[j][1]) + (v[j][2] * v[j][2] + v[j][3] * v[j][3]); }
                const float rstd = 1.f / sqrtf(wave_sum(s2) * (1.f / DM) + LN_EPS);
                f32x4* xo = (f32x4*)(X1 + (size_t)m * DM) + lane; unsigned long long* o8 = (unsigned long long*)(H + (size_t)m * DM) + lane;
#pragma unroll
                for (int j = 0; j < 4; ++j) { const f32x4 gg = *((const f32x4*)lg + 64 * j + lane), bb = *((const f32x4*)lb + 64 * j + lane);
                    const f32x4 x1 = v[j] * rstd * gg + bb; xo[64 * j] = x1;
                    const f32x4 sh = *((const f32x4*)(ad + 3 * 1024) + 64 * j + lane), sc = *((const f32x4*)(ad + 4 * 1024) + 64 * j + lane);
                    const f32x4 hv = x1 * (sc + 1.f) + sh; o8[64 * j] = (unsigned long long)cvtpk(hv[0], hv[1]) | ((unsigned long long)cvtpk(hv[2], hv[3]) << 32); } }
        }
        GRID_BAR();
        if (PH(7)) { LAUNDER_TID
            bf16_t* H = (bf16_t*)WSP(WS_H); bf16_t* WSH = (bf16_t*)WSP(WS_WSH); float* LOG = (float*)WSP(WS_LOG); bf16_t* ACTSH = (bf16_t*)WSP(WS_ACTSH);
            pg8::Gemm g{H, WSH + (size_t)l * 768 * DM, DM}; pg8::StaticOrder S; S.init(NTOK, 768, G, bx);
            pg8::EpiSH E{LOG, ACTSH};
            pg8::gemm_phase<pg8::EpiSH, pg8::StaticOrder>(lds, g, S, E, wid);
        }
        GRID_BAR();
        if (PH(8)) { LAUNDER_TID
            unsigned* ctl = (unsigned*)WSP(WS_CTL); float* LOG = (float*)WSP(WS_LOG); int* DST = (int*)WSP(WS_DST); float* WL = (float*)WSP(WS_WL);
            unsigned* CNT = ctl + CW_CNT + l * 256;
            LAS int* hist = (LAS int*)lds;
            LAS int* basel = (LAS int*)(lds + 1024);
            LAS int* asg_e = (LAS int*)(lds + 2048);
            LAS int* asg_r = (LAS int*)(lds + 2048 + 4096);
            LAS float* asg_w = (LAS float*)(lds + 2048 + 8192);
            const float* rb = INP(18) + l * 256;
            for (int chunk = bx; chunk < NTOK / 128; chunk += G) {
                for (int u = tid; u < 256; u += 512) hist[u] = 0;
                __syncthreads();
                for (int ti = 0; ti < 16; ++ti) { const int tl = wid * 16 + ti, n = chunk * 128 + tl;
                    const f32x4 lg = *((const f32x4*)(LOG + (size_t)n * 256) + lane); const f32x4 rbv = *((const f32x4*)rb + lane);
                    float sc[4], ch[4];
#pragma unroll
                    for (int i = 0; i < 4; ++i) { sc[i] = sigmoidf_(lg[i]); ch[i] = sc[i] + rbv[i]; }
                    float m1 = fmaxf(ch[0], ch[1]), m2 = fminf(ch[0], ch[1]);
                    { const float a1 = fmaxf(ch[2], ch[3]), a2 = fminf(ch[2], ch[3]); const float n1 = fmaxf(m1, a1), n2 = fmaxf(fminf(m1, a1), fmaxf(m2, a2)); m1 = n1; m2 = n2; }
#pragma unroll
                    for (int o = 1; o < 8; o <<= 1) { const float b1 = __shfl_xor(m1, o), b2 = __shfl_xor(m2, o); const float n1 = fmaxf(m1, b1), n2 = fmaxf(fminf(m1, b1), fmaxf(m2, b2)); m1 = n1; m2 = n2; }
                    const float gs = m1 + m2; const int grp = lane >> 3; int grank = 0;
#pragma unroll
                    for (int jg = 0; jg < 8; ++jg) { const float o = __shfl(gs, 8 * jg); grank += ((o > gs) || (o == gs && jg < grp)) ? 1 : 0; }
                    const bool gsel = grank < 4;
                    float val[4];
#pragma unroll
                    for (int i = 0; i < 4; ++i) val[i] = gsel ? ch[i] : -1e30f;
                    float wsum_ = 0.f; int my_e = 0; float my_s = 0.f;
#pragma unroll
                    for (int k = 0; k < 8; ++k) {
                        float bv = val[0]; int bi = 4 * lane; float bsc = sc[0];
#pragma unroll
                        for (int i = 1; i < 4; ++i) if (val[i] > bv) { bv = val[i]; bi = 4 * lane + i; bsc = sc[i]; }
#pragma unroll
                        for (int o = 1; o < 64; o <<= 1) { const float ov = __shfl_xor(bv, o); const int oi = __shfl_xor(bi, o); const float os = __shfl_xor(bsc, o);
                            if (ov > bv || (ov == bv && oi < bi)) { bv = ov; bi = oi; bsc = os; } }
                        if ((bi >> 2) == lane) {
#pragma unroll
                            for (int i = 0; i < 4; ++i) if ((bi & 3) == i) val[i] = -3e38f; }
                        wsum_ += bsc; if (lane == k) { my_e = bi; my_s = bsc; }
                    }
                    if (lane < 8) { const int rk = __hip_atomic_fetch_add(&hist[my_e], 1, __ATOMIC_RELAXED, __HIP_MEMORY_SCOPE_WORKGROUP); asg_e[tl * 8 + lane] = my_e; asg_r[tl * 8 + lane] = rk; asg_w[tl * 8 + lane] = my_s / wsum_ * 2.5f; }
                }
                __syncthreads();
                if (tid < 256) { const int c = hist[tid]; basel[tid] = c ? (int)atomicAdd(&CNT[tid], (unsigned)c) : 0; }
                __syncthreads();
                for (int u = tid; u < 1024; u += 512) { const int e = asg_e[u]; const int pos = basel[e] + asg_r[u]; DST[(size_t)e * NTOK + pos] = (chunk * 128) * 8 + u; WL[(size_t)e * NTOK + pos] = asg_w[u]; }
                __syncthreads();
            }
        }
        GRID_BAR();
        if (PH(9)) { LAUNDER_TID
            unsigned* ctl = (unsigned*)WSP(WS_CTL); bf16_t* H = (bf16_t*)WSP(WS_H); bf16_t* WGU = (bf16_t*)WSP(WS_WGU); int* DST = (int*)WSP(WS_DST); bf16_t* ACT = (bf16_t*)WSP(WS_ACT);
            const unsigned* CNT = ctl + CW_CNT + l * 256;
            if (tid < 256) CNTL[tid] = (int)__hip_atomic_load(CNT + tid, __ATOMIC_RELAXED, __HIP_MEMORY_SCOPE_AGENT);
            __syncthreads();
            if (tid == 0) { int s = 0; for (int e = 0; e < 256; ++e) { TP[e] = s; s += (CNTL[e] + 255) >> 8; } TP[256] = s; }
            __syncthreads();
            pg8::Gemm g{H, WGU + (size_t)l * NEXP * 512 * DM, DM};
            pg8::GroupedOrder<true> S{TP, CNTL, 2, G, bx, DST};
            pg8::EpiGU E{ACT};
            pg8::gemm_phase<pg8::EpiGU, pg8::GroupedOrder<true>>(lds, g, S, E, wid);
        }
        GRID_BAR();
        if (PH(10)) { LAUNDER_TID
            bf16_t* ACTSH = (bf16_t*)WSP(WS_ACTSH); bf16_t* WSD = (bf16_t*)WSP(WS_WSD); bf16_t* YSH = (bf16_t*)WSP(WS_YSH); bf16_t* ACT = (bf16_t*)WSP(WS_ACT); bf16_t* WD = (bf16_t*)WSP(WS_WD); bf16_t* YB = (bf16_t*)WSP(WS_YB); int* DST = (int*)WSP(WS_DST); float* WL = (float*)WSP(WS_WL);
            if (PH(12)) { pg8::Gemm g{ACTSH, WSD + (size_t)l * DM * 256, 256}; pg8::StaticOrder S; S.init(NTOK, DM, G, bx);
              pg8::EpiShDown E{YSH};
              pg8::gemm_phase<pg8::EpiShDown, pg8::StaticOrder>(lds, g, S, E, wid); }
            if (PH(13)) { pg8::Gemm g{ACT, WD + (size_t)l * NEXP * DM * 256, 256};
              pg8::GroupedOrder<false> S{TP, CNTL, 4, G, bx, nullptr};
              pg8::EpiDown E{YB, DST, WL};
              pg8::gemm_phase<pg8::EpiDown, pg8::GroupedOrder<false>>(lds, g, S, E, wid); }
        }
        GRID_BAR();
        if (PH(11)) { LAUNDER_TID
            bf16_t* YSH = (bf16_t*)WSP(WS_YSH); bf16_t* YB = (bf16_t*)WSP(WS_YB); float* X1 = (float*)WSP(WS_X1); float* OUT = OUTP; bf16_t* H = (bf16_t*)WSP(WS_H); float* ADA = (float*)WSP(WS_ADA); const float* ada_l = (const float*)WSP(WS_ADA) + (size_t)l * 8 * 6144;
            const int gw = bx * 8 + wid, NGW = G * 8; const float* lg = INP(15) + l * DM; const float* lb = INP(16) + l * DM;
            for (int m = gw; m < NTOK; m += NGW) { const int b = m >> 12; const float* ad = ada_l + (size_t)b * 6144;
                f32x4 v[4]; float s = 0.f;
#pragma unroll
                for (int j = 0; j < 4; ++j) { const int c0 = 256 * j + 4 * lane;
                    f32x4 y; { const u32x2 t = *(const u32x2*)(YSH + (size_t)m * DM + c0); y[0] = __uint_as_float(t.x << 16); y[1] = __uint_as_float(t.x & 0xffff0000u); y[2] = __uint_as_float(t.y << 16); y[3] = __uint_as_float(t.y & 0xffff0000u); }
#pragma unroll
                    for (int k = 0; k < 8; ++k) { const u32x2 t = *(const u32x2*)(YB + ((size_t)m * 8 + k) * DM + c0);
                        y[0] += __uint_as_float(t.x << 16); y[1] += __uint_as_float(t.x & 0xffff0000u); y[2] += __uint_as_float(t.y << 16); y[3] += __uint_as_float(t.y & 0xffff0000u); }
                    const f32x4 x1 = *((const f32x4*)(X1 + (size_t)m * DM) + 64 * j + lane); const f32x4 g2 = *((const f32x4*)(ad + 5 * 1024) + 64 * j + lane);
                    v[j] = x1 * ALPHA + (g2 + 1.f) * y; s += (v[j][0] + v[j][1]) + (v[j][2] + v[j][3]); }
                const float mean = wave_sum(s) * (1.f / DM); float s2 = 0.f;
#pragma unroll
                for (int j = 0; j < 4; ++j) { v[j] = v[j] - mean; s2 += (v[j][0] * v[j][0] + v[j][1] * v[j][1]) + (v[j][2] * v[j][2] + v[j][3] * v[j][3]); }
                const float rstd = 1.f / sqrtf(wave_sum(s2) * (1.f / DM) + LN_EPS);
                f32x4* xo = (f32x4*)(OUT + (size_t)m * DM) + lane; unsigned long long* o8 = (unsigned long long*)(H + (size_t)m * DM) + lane;
                const float* adn = ADA + ((size_t)(l + 1) * 8 + b) * 6144;
#pragma unroll
                for (int j = 0; j < 4; ++j) { const f32x4 gg = *((const f32x4*)lg + 64 * j + lane), bb = *((const f32x4*)lb + 64 * j + lane);
                    const f32x4 xn = v[j] * rstd * gg + bb; xo[64 * j] = xn;
                    if (l + 1 < DEPTH) { const f32x4 sh = *((const f32x4*)(adn) + 64 * j + lane), sc = *((const f32x4*)(adn + 1024) + 64 * j + lane);
                        const f32x4 hv = xn * (sc + 1.f) + sh; o8[64 * j] = (unsigned long long)cvtpk(hv[0], hv[1]) | ((unsigned long long)cvtpk(hv[2], hv[3]) << 32); } } }
        }
        if (l + 1 < DEPTH) GRID_BAR();
    }
}

extern "C" void kernel_launch(void* const* d_in, const int* in_sizes, int n_in, void* d_out, int out_size, void* d_ws, size_t ws_size, hipStream_t stream) {
    static int grid = 0;
    if (grid == 0) {
        if (n_in != 25 || out_size != NTOK * DM || ws_size < WS_END) { fprintf(stderr, "kernel_launch: unexpected shapes (n_in %d, out %d, ws %zu)\n", n_in, out_size, ws_size); grid = -1; return; }
        int dev = 0, cus = 0;
        if (hipGetDevice(&dev) != hipSuccess || hipDeviceGetAttribute(&cus, hipDeviceAttributeMultiprocessorCount, dev) != hipSuccess) { grid = -1; return; }
        if (hipFuncSetAttribute((const void*)mega_fwd, hipFuncAttributeMaxDynamicSharedMemorySize, LDS_BYTES) != hipSuccess) { fprintf(stderr, "kernel_launch: hipFuncSetAttribute failed\n"); grid = -1; return; }
        int per_cu = 0;
        if (hipOccupancyMaxActiveBlocksPerMultiprocessor(&per_cu, (const void*)mega_fwd, 512, LDS_BYTES) != hipSuccess || per_cu < 1) fprintf(stderr, "kernel_launch: occupancy query says %d\n", per_cu);
        (void)hipGetLastError();
        grid = cus;
    }
    if (grid < 0) return;
    if (hipMemsetAsync((char*)d_ws + WS_CTL, 0, CTL_BYTES, stream) != hipSuccess) return;
    Args a{};
    for (int i = 0; i < 25; ++i) a.in[i] = (const float*)d_in[i];
    a.out = (float*)d_out; a.ws = (unsigned char*)d_ws;
    hipLaunchKernelGGL(mega_fwd, dim3(grid), dim3(512), LDS_BYTES, stream, a);
}
```

```cpp
#include <hip/hip_runtime.h>
#include <cstdio>
#include <cstdint>

#define DI __device__ __forceinline__
#define LAS __attribute__((address_space(3)))
#define GAS __attribute__((address_space(1)))
typedef unsigned short bf16_t;
typedef short bf16x8 __attribute__((ext_vector_type(8)));
typedef short s16x4 __attribute__((ext_vector_type(4)));
typedef float f32x2 __attribute__((ext_vector_type(2)));
typedef float f32x4 __attribute__((ext_vector_type(4)));
typedef float f32x16 __attribute__((ext_vector_type(16)));
typedef unsigned u32x2 __attribute__((ext_vector_type(2)));
typedef unsigned u32x4 __attribute__((ext_vector_type(4)));

constexpr int DM = 1024, NB = 8, SEQ = 4096, NTOK = NB * SEQ, DEPTH = 2;
constexpr int D_IN = 2450, QKV_N = 2560;
constexpr int NEXP = 256, TOPK = 8, EDIM = 256;
constexpr float LOG2E = 1.4426950408889634f;
constexpr float C2 = 0.125f * LOG2E;
constexpr float ALPHA = 1.4142135623730951f;
constexpr float LN_EPS = 1e-5f;
constexpr int C_AQ = 0, C_AK = 384, C_AV = 512, C_BQ = 640, C_BKC = 896, C_BVC = 960, C_BKS = 1024, C_BVS = 1088, C_BKW = 1152, C_BVW = 1216,
              C_CQ = 1280, C_CK = 1664, C_CV = 2048, C_SM = 2432;
constexpr int O_A = 0, O_B = 384, O_C = 640;

constexpr size_t MiB = 1u << 20;
constexpr size_t WS_CTL = 0, CTL_BYTES = 1 * MiB;
constexpr size_t WS_ADA = 1 * MiB;
constexpr size_t WS_CPOS = WS_ADA + 512 * 1024;
constexpr size_t WS_KCMP = 2 * MiB;
constexpr size_t WS_VCMP = WS_KCMP + 256 * 1024;
constexpr size_t WS_DC = 3 * MiB;
constexpr size_t WS_WCT = 4 * MiB;
constexpr size_t WS_WIN = 8 * MiB;
constexpr size_t WS_WO = 18 * MiB;
constexpr size_t WS_WSH = 22 * MiB;
constexpr size_t WS_WSD = 25 * MiB;
constexpr size_t WS_WGU = 32 * MiB;
constexpr size_t WS_WD = 544 * MiB;
constexpr size_t WS_H = 800 * MiB;
constexpr size_t WS_X1 = 864 * MiB;
constexpr size_t WS_LOG = 992 * MiB;
constexpr size_t WS_ACTSH = 1024 * MiB;
constexpr size_t WS_YSH = 1040 * MiB;
constexpr size_t WS_DST = 1104 * MiB;
constexpr size_t WS_WL = 1136 * MiB;
constexpr size_t WS_SMALL = 1168 * MiB;
constexpr size_t WS_ACT = 1172 * MiB;
constexpr size_t WS_R1 = 1332 * MiB;
constexpr size_t WS_QKV = WS_R1;
constexpr size_t WS_O = WS_R1 + 160 * MiB;
constexpr size_t WS_V = WS_R1 + 224 * MiB;
constexpr size_t WS_YB = WS_R1;
constexpr size_t WS_END = 1844 * MiB;

constexpr int CW_BAR = 4096;
constexpr int CW_Q = 16384;
constexpr int CW_CNT = 32768;

constexpr int RING_BYTES = 131072;
constexpr int L_MISC = RING_BYTES;
constexpr int L_LUT = L_MISC + 256;
constexpr int L_TP = L_LUT + 5120;
constexpr int L_CNT = L_TP + 1040;
constexpr int L_PT = L_CNT + 1024;
constexpr int LDS_BYTES = 147456;
static_assert(L_PT + 256 <= LDS_BYTES, "LDS map");

DI unsigned cvtpk(float lo, float hi) { typedef __bf16 b2 __attribute__((ext_vector_type(2))); f32x2 v = {lo, hi}; b2 b = __builtin_convertvector(v, b2); return __builtin_bit_cast(unsigned, b); }
DI float bf2f(bf16_t v) { return __uint_as_float((unsigned)v << 16); }
DI float fast_exp2(float x) { return __builtin_amdgcn_exp2f(x); }
DI float sigmoidf_(float x) { return 1.f / (1.f + __expf(-x)); }
DI float siluf_(float x) { return x / (1.f + __expf(-x)); }

#define XB_TMO      128
#define XB_XCNT(j)  (256  + 64 * (j))
#define XB_XSUB(j)  (1280 + 64 * (j))
#define XB_XGEN(j)  (2304 + 64 * (j))
#define XB_TOP      3328
#define XB_TOPGEN   3392
#define XCD_BAR_WORDS 3456
#define XB_SPIN_CAP (1u << 22)

__device__ __forceinline__ unsigned xb_ld(unsigned* p)              { return __hip_atomic_load(p, __ATOMIC_RELAXED, __HIP_MEMORY_SCOPE_AGENT); }
__device__ __forceinline__ unsigned xb_add(unsigned* p, unsigned v) { return __hip_atomic_fetch_add(p, v, __ATOMIC_RELAXED, __HIP_MEMORY_SCOPE_AGENT); }
__device__ __forceinline__ unsigned xb_xcc_id() { return (unsigned)__builtin_amdgcn_s_getreg((3 << 11) | 20) & 0xFu; }
#define XB_SPIN(cond, bar) do { unsigned _sp = 0; while (cond) { __builtin_amdgcn_s_sleep(1); \
    if ((++_sp & 255u) == 0u) { if (xb_ld(&(bar)[XB_TMO])) break; if (_sp > XB_SPIN_CAP) { atomicAdd(&(bar)[XB_TMO], 1u); break; } } } } while (0)

struct XcdBarrier { unsigned* bar; unsigned x; volatile LAS unsigned* st; };

__device__ __forceinline__ XcdBarrier xcd_barrier_post(unsigned* bar, volatile LAS unsigned* st) {
    XcdBarrier b; b.bar = bar; b.x = xb_xcc_id(); b.st = st;
    if (threadIdx.x == 0) (void)xb_add(&bar[XB_XCNT(b.x)], 1u);
    return b;
}
__device__ __forceinline__ void xcd_barrier_complete(unsigned* bar, unsigned x, unsigned& nloc, unsigned& nx) {
    const unsigned G = gridDim.x * gridDim.y * gridDim.z;
    unsigned sum, cnt, mine, sp = 0u;
    for (;;) {
        sum = 0u; cnt = 0u; mine = 0u;
#pragma unroll
        for (unsigned j = 0; j < 16; ++j) { const unsigned c = xb_ld(&bar[XB_XCNT(j)]); sum += c; cnt += (c > 0u) ? 1u : 0u; mine = (j == x) ? c : mine; }
        if (sum == G) break;
        __builtin_amdgcn_s_sleep(1);
        if ((++sp & 255u) == 0u) { if (xb_ld(&bar[XB_TMO])) break; if (sp > XB_SPIN_CAP) { atomicAdd(&bar[XB_TMO], 1u); break; } }
    }
    nloc = mine > 0u ? mine : 1u; nx = cnt > 0u ? cnt : 1u;
}
__device__ __forceinline__ void xcd_barrier(const XcdBarrier& b, bool leader_thread) {
    asm volatile("s_waitcnt vmcnt(0)" ::: "memory");
    __syncthreads();
    if (leader_thread) {
        unsigned* bar = b.bar;
        __builtin_amdgcn_s_waitcnt(0);
        unsigned nloc = b.st[0], nx = b.st[1];
        if (nloc == 0u) { xcd_barrier_complete(bar, b.x, nloc, nx); b.st[0] = nloc; b.st[1] = nx; }
        const unsigned old = xb_add(&bar[XB_XSUB(b.x)], 1u);
        const unsigned gen = old / nloc;
        if (old + 1u == (gen + 1u) * nloc) {
            __builtin_amdgcn_fence(__ATOMIC_RELEASE, "agent");
            asm volatile("s_waitcnt vmcnt(0)" ::: "memory");
            const unsigned og = xb_add(&bar[XB_TOP], 1u);
            const unsigned tg = og / nx;
            if (og + 1u == (tg + 1u) * nx) xb_add(&bar[XB_TOPGEN], 1u);
            else XB_SPIN(xb_ld(&bar[XB_TOPGEN]) == tg, bar);
            __builtin_amdgcn_fence(__ATOMIC_ACQUIRE, "agent");
            xb_add(&bar[XB_XGEN(b.x)], 1u);
            asm volatile("s_waitcnt vmcnt(0)" ::: "memory");
        } else {
            XB_SPIN(xb_ld(&bar[XB_XGEN(b.x)]) == gen, bar);
            __builtin_amdgcn_fence(__ATOMIC_ACQUIRE, "agent");
            asm volatile("s_waitcnt vmcnt(0)" ::: "memory");
        }
    }
    __syncthreads();
}

namespace pg8 {
constexpr int BM = 256, BK = 64, HALF = 128, HTB = HALF * BK * 2, STAGE_BYTES = 8 * HTB, NXCD = 8, WGM = 8;
__host__ __device__ __forceinline__ int lds_byte(int r, int c) { const int st = (r >> 4) * 2 + (c >> 5), rr = r & 15, cc = c & 31, ob = rr * 64 + cc * 2; return st * 1024 + (ob ^ (((ob >> 9) & 1) << 5)); }
__host__ __device__ __forceinline__ void stage_rc(int b, int& R, int& C) { const int st = b / 1024, sb = b % 1024, swz = sb ^ (((sb >> 9) & 1) << 5); R = (st >> 1) * 16 + swz / 64; C = (st & 1) * 32 + (swz % 64) / 2; }
__host__ __device__ __forceinline__ int perm32(int rho) { const int n = rho >> 4, i = rho & 15; return 8 * (i >> 2) + 4 * n + (i & 3); }

struct Unit { int pm, pn, e, lrow0, cnt; };
struct Gemm { const bf16_t* A; const bf16_t* Bt; int K; };

struct StaticOrder {
    int nM, nN, nwg, G, c;
    DI void init(int M, int N, int G_, int c_) { nM = M / BM; nN = N / BM; nwg = nM * nN; G = G_; c = c_; }
    DI bool next(int i, Unit& u) const {
        const long L = (long)i * G + c; if (L >= nwg) return false;
        int wgid = (int)L; { const int q = nwg / NXCD, r = nwg % NXCD, xcd = wgid % NXCD, off = wgid / NXCD; wgid = (xcd < r ? xcd * (q + 1) : r * (q + 1) + (xcd - r) * q) + off; }
        const int nig = WGM * nN, gid = wgid / nig, fm = gid * WGM, gsz = (nM - fm) < WGM ? (nM - fm) : WGM;
        u.pm = fm + ((wgid % nig) % gsz); u.pn = (wgid % nig) / gsz; u.e = 0; u.lrow0 = 0; u.cnt = 0; return true;
    }
    static constexpr bool GATHER = false;
    DI unsigned tokpair(const Unit&, int, int) const { return 0u; }
};
template <bool GATHER_> struct GroupedOrder {
    static constexpr bool GATHER = GATHER_;
    const LAS int* TP; const LAS int* CNT; int NT, G, c; const int* list;
    DI bool next(int i, Unit& u) const {
        const int total = TP[256] * NT; const int L = i * G + c; if (L >= total) return false;
        const int mt = L / NT, nt = L - mt * NT;
        int lo = 0, hi = 255;
        while (lo < hi) { const int mid = (lo + hi + 1) >> 1; if (TP[mid] <= mt) lo = mid; else hi = mid - 1; }
        u.pm = __builtin_amdgcn_readfirstlane(mt); u.pn = __builtin_amdgcn_readfirstlane(lo * NT + nt); u.e = __builtin_amdgcn_readfirstlane(lo);
        u.lrow0 = __builtin_amdgcn_readfirstlane((mt - TP[lo]) * BM); u.cnt = __builtin_amdgcn_readfirstlane(CNT[lo]); return true;
    }
    DI unsigned tokpair(const Unit& u, int R0, int) const {
        int l0 = u.lrow0 + R0, l1 = l0 + HALF; l0 = l0 < u.cnt ? l0 : u.cnt - 1; l1 = l1 < u.cnt ? l1 : u.cnt - 1;
        const unsigned t0 = (unsigned)(list[u.e * NTOK + l0] >> 3), t1 = (unsigned)(list[u.e * NTOK + l1] >> 3); return t0 | (t1 << 16);
    }
};

template <class Epi, class Sched>
__device__ __forceinline__ void gemm_phase(LAS unsigned char* lds, const Gemm g, const Sched& S, const Epi& E, int wid_) {
    int lane; asm volatile("v_mbcnt_lo_u32_b32 %0, -1, 0\n\tv_mbcnt_hi_u32_b32 %0, -1, %0" : "=v"(lane));
    int wid = wid_; asm volatile("" : "+s"(wid)); const int tid = wid * 64 + lane, wr = wid >> 2, wc = wid & 3, fr = lane & 15, fq = lane >> 4;
    const int K = g.K, nt = K / BK;
    constexpr bool GA = Sched::GATHER;
    unsigned voffA[2], voffB[2]; int RA[2];
#pragma unroll
    for (int i = 0; i < 2; ++i) { int R, C; stage_rc(tid * 16 + i * 8192, R, C); const int Rb = Epi::PERM ? ((R & ~31) + perm32(R & 31)) : R;
        RA[i] = R; voffA[i] = GA ? (unsigned)(C * 2) : (unsigned)(R * K + C) * 2u; voffB[i] = (unsigned)(Rb * K + C) * 2u; }
    const size_t kstep = (size_t)(BK * 2);
    const size_t hstep = (size_t)HALF * K * 2;
    const size_t tstep = 2 * hstep;
    const unsigned ldsw = (unsigned)wid * 1024u;
    const int aoff = lds_byte(wr * 64 + fr, fq * 8), boff = lds_byte(wc * 32 + fr, fq * 8);
#define PG8_SA(b, h) (((b) * 2 + (h)) * HTB)
#define PG8_SB(b, h) ((4 + (b) * 2 + (h)) * HTB)
#define PG8_STAGE(bufoff, gbase, voff) do { _Pragma("unroll") for (int _i = 0; _i < 2; ++_i) \
        __builtin_amdgcn_global_load_lds((const unsigned*)((const char*)(gbase) + (voff)[_i]), (LAS unsigned*)(lds + (bufoff) + ldsw + _i * 8192), 16, 0, 0); } while (0)
#define PG8_STAGEA(bufoff, ubase, tp, hh, kb) do { _Pragma("unroll") for (int _i = 0; _i < 2; ++_i) { \
        const char* _p = GA ? ((const char*)g.A + (size_t)(kb) + (size_t)((((tp)[_i] >> (16 * (hh))) & 0xffffu) * (unsigned)(K * 2)) + voffA[_i]) : ((ubase) + (size_t)(hh) * hstep + (size_t)(kb) + voffA[_i]); \
        __builtin_amdgcn_global_load_lds((const unsigned*)_p, (LAS unsigned*)(lds + (bufoff) + ldsw + _i * 8192), 16, 0, 0); } } while (0)
#define PG8_LDA(dst, b, h) do { _Pragma("unroll") for (int m = 0; m < 4; ++m) _Pragma("unroll") for (int k = 0; k < 2; ++k) dst[m][k] = *(const LAS bf16x8*)(lds + PG8_SA(b, h) + aoff + m * 2048 + k * 1024); } while (0)
#define PG8_LDB(dst, b, h) do { _Pragma("unroll") for (int n = 0; n < 2; ++n) _Pragma("unroll") for (int k = 0; k < 2; ++k) dst[n][k] = *(const LAS bf16x8*)(lds + PG8_SB(b, h) + boff + n * 2048 + k * 1024); } while (0)
#define PG8_MMA(ai, bj, At, Bt) do { __builtin_amdgcn_s_setprio(1); _Pragma("unroll") for (int m = 0; m < 4; ++m) _Pragma("unroll") for (int n = 0; n < 2; ++n) _Pragma("unroll") for (int k = 0; k < 2; ++k) \
        acc[ai][bj][m][n] = __builtin_amdgcn_mfma_f32_16x16x32_bf16(Bt[n][k], At[m][k], acc[ai][bj][m][n], 0, 0, 0); __builtin_amdgcn_s_setprio(0); } while (0)
#define PG8_WAIT_V(n) asm volatile("s_waitcnt vmcnt(" #n ")" ::: "memory")
#define PG8_WAIT_L(n) asm volatile("s_waitcnt lgkmcnt(" #n ")" ::: "memory")
#define PG8_BAR __builtin_amdgcn_s_barrier()
#define PG8_SCHED __builtin_amdgcn_sched_barrier(0)
    Unit cur, nxt; int ui = 0;
    if (!S.next(0, cur)) return;
    f32x4 acc[2][2][4][2];
#pragma unroll
    for (int a = 0; a < 2; ++a)
#pragma unroll
        for (int b = 0; b < 2; ++b)
#pragma unroll
            for (int m = 0; m < 4; ++m)
#pragma unroll
                for (int n = 0; n < 2; ++n) acc[a][b][m][n] = (f32x4){0.f, 0.f, 0.f, 0.f};
    bf16x8 At[4][2], B0[2][2], B1[2][2];
    unsigned tpc[2] = {0u, 0u}, tpn[2] = {0u, 0u};
    if (GA) {
#pragma unroll
        for (int i = 0; i < 2; ++i) tpc[i] = S.tokpair(cur, RA[i], 0); }
#define PG8_FRESH_R(i, Rv) int Rv; { int l2_; asm volatile("v_mbcnt_lo_u32_b32 %0, -1, 0\n\tv_mbcnt_hi_u32_b32 %0, -1, %0" : "=v"(l2_)); int C2_; stage_rc((wid * 64 + l2_) * 16 + (i) * 8192, Rv, C2_); }
    const char* cA = GA ? (const char*)g.A : (const char*)g.A + (size_t)cur.pm * tstep; const char* cB = (const char*)g.Bt + (size_t)cur.pn * tstep;
    {
        PG8_STAGE(PG8_SB(0, 0), cB, voffB); PG8_STAGE(PG8_SB(0, 1), cB + hstep, voffB); PG8_STAGEA(PG8_SA(0, 0), cA, tpc, 0, 0); PG8_STAGEA(PG8_SA(0, 1), cA, tpc, 1, 0);
        if (wr == 1) PG8_BAR;
        PG8_WAIT_V(2); PG8_BAR;
        PG8_STAGE(PG8_SB(1, 0), cB + kstep, voffB); PG8_STAGEA(PG8_SA(1, 0), cA, tpc, 0, kstep); PG8_STAGE(PG8_SB(1, 1), cB + hstep + kstep, voffB);
        PG8_WAIT_V(6); PG8_BAR;
    }
    for (;;) {
        const bool has_next = S.next(ui + 1, nxt);
        const char* nA = GA ? cA : (has_next ? (const char*)g.A + (size_t)nxt.pm * tstep : cA); const char* nB = has_next ? (const char*)g.Bt + (size_t)nxt.pn * tstep : cB;
        if (GA) {
#pragma unroll
            for (int i = 0; i < 2; ++i) { if (has_next) { PG8_FRESH_R(i, Rn_); tpn[i] = S.tokpair(nxt, Rn_, 0); } else tpn[i] = tpc[i]; } }
#pragma unroll 1
        for (int t = 0; t < nt; t += 2) {
            const bool last = (t == nt - 2);
            const size_t k1 = (size_t)(t + 1) * kstep;
            const size_t k2 = last ? 0 : (size_t)(t + 2) * kstep; const size_t k3 = k2 + kstep;
            const char* a2 = last ? nA : cA;
            unsigned tp2[2];
#pragma unroll
            for (int i = 0; i < 2; ++i) tp2[i] = last ? tpn[i] : tpc[i];
            const char* b2 = last ? nB : cB + (size_t)(t + 2) * kstep;
            const char* b3 = b2 + kstep;
            PG8_LDB(B0, 0, 0); PG8_LDB(B1, 0, 1); PG8_SCHED; PG8_LDA(At, 0, 0); PG8_STAGEA(PG8_SA(1, 1), cA, tpc, 1, k1);
            PG8_WAIT_V(8); PG8_WAIT_L(0); PG8_BAR; PG8_MMA(0, 0, At, B0); PG8_MMA(0, 1, At, B1); PG8_BAR; PG8_SCHED;
            PG8_LDA(At, 0, 1); PG8_STAGE(PG8_SB(0, 0), b2, voffB); PG8_STAGE(PG8_SB(0, 1), b2 + hstep, voffB); PG8_STAGEA(PG8_SA(0, 0), a2, tp2, 0, k2);
            PG8_WAIT_V(8); PG8_WAIT_L(0); PG8_BAR; PG8_MMA(1, 0, At, B0); PG8_MMA(1, 1, At, B1); PG8_BAR; PG8_SCHED;
            PG8_LDB(B0, 1, 0); PG8_LDB(B1, 1, 1); PG8_SCHED; PG8_LDA(At, 1, 0); PG8_STAGEA(PG8_SA(0, 1), a2, tp2, 1, k2);
            PG8_WAIT_V(8); PG8_WAIT_L(0); PG8_BAR; PG8_MMA(0, 0, At, B0); PG8_MMA(0, 1, At, B1); PG8_BAR; PG8_SCHED;
            PG8_LDA(At, 1, 1); PG8_STAGE(PG8_SB(1, 0), b3, voffB); PG8_STAGE(PG8_SB(1, 1), b3 + hstep, voffB); PG8_STAGEA(PG8_SA(1, 0), a2, tp2, 0, k3);
            PG8_WAIT_V(8); PG8_WAIT_L(0); PG8_BAR; PG8_MMA(1, 0, At, B0); PG8_MMA(1, 1, At, B1); PG8_BAR; PG8_SCHED;
        }
        if (wr == 0) PG8_BAR;
        E(acc, cur, wr, wc, fr, fq);
        if (!has_next) break;
#pragma unroll
        for (int a = 0; a < 2; ++a)
#pragma unroll
            for (int b = 0; b < 2; ++b)
#pragma unroll
                for (int m = 0; m < 4; ++m)
#pragma unroll
                    for (int n = 0; n < 2; ++n) acc[a][b][m][n] = (f32x4){0.f, 0.f, 0.f, 0.f};
        cur = nxt; cA = nA; cB = nB; ++ui;
#pragma unroll
        for (int i = 0; i < 2; ++i) tpc[i] = tpn[i];
        if (wr == 1) PG8_BAR;
    }
    PG8_WAIT_V(0);
    PG8_BAR;
#undef PG8_SA
#undef PG8_SB
#undef PG8_STAGE
#undef PG8_STAGEA
#undef PG8_FRESH_R
#undef PG8_LDA
#undef PG8_LDB
#undef PG8_MMA
#undef PG8_WAIT_V
#undef PG8_WAIT_L
#undef PG8_BAR
#undef PG8_SCHED
}

DI u32x4 pack8(const f32x4& v0, const f32x4& v1) { u32x4 w; w.x = cvtpk(v0[0], v0[1]); w.y = cvtpk(v0[2], v0[3]); w.z = cvtpk(v1[0], v1[1]); w.w = cvtpk(v1[2], v1[3]); return w; }

struct EpiQKV { static constexpr bool PERM = true;
    bf16_t* O; float* SM;
    DI void operator()(const f32x4 (&acc)[2][2][4][2], const Unit& u, int wr, int wc, int fr, int fq) const {
        const int row0 = u.pm * BM + wr * 64 + fr, colt = u.pn * BM + wc * 32 + 8 * fq;
#pragma unroll
        for (int bj = 0; bj < 2; ++bj) { const int col = colt + bj * HALF;
            const bool isq = (col < C_AK) || (col >= C_BQ && col < C_BKC) || (col >= C_CQ && col < C_CK);
            const float sc = isq ? C2 : 1.f; const bool sm = (col >= C_SM && col < C_SM + 32);
#pragma unroll
            for (int ai = 0; ai < 2; ++ai)
#pragma unroll
                for (int m = 0; m < 4; ++m) { const int row = row0 + ai * HALF + m * 16;
                    const f32x4 v0 = acc[ai][bj][m][0] * sc, v1 = acc[ai][bj][m][1] * sc;
                    *(u32x4*)(O + (size_t)row * QKV_N + col) = pack8(v0, v1);
                    if (sm) { float* sp = SM + (size_t)row * 32 + (col - C_SM); *(f32x4*)sp = v0; *(f32x4*)(sp + 4) = v1; } } }
    }
};
struct EpiWO { static constexpr bool PERM = false;
    const float* xin; float* V; const float* g1;
    DI void operator()(const f32x4 (&acc)[2][2][4][2], const Unit& u, int wr, int wc, int fr, int fq) const {
        const int row0 = u.pm * BM + wr * 64 + fr, col0 = u.pn * BM + wc * 32 + 4 * fq; const int b = (u.pm * BM) >> 12;
#pragma unroll
        for (int bj = 0; bj < 2; ++bj)
#pragma unroll
            for (int n = 0; n < 2; ++n) { const int col = col0 + bj * HALF + n * 16; const f32x4 gg = *(const f32x4*)(g1 + (size_t)b * 6144 + col) + 1.f;
#pragma unroll
                for (int ai = 0; ai < 2; ++ai)
#pragma unroll
                    for (int m = 0; m < 4; ++m) { const size_t off = (size_t)(row0 + ai * HALF + m * 16) * DM + col;
                        const f32x4 xv = *(const f32x4*)(xin + off); *(f32x4*)(V + off) = xv * ALPHA + gg * acc[ai][bj][m][n]; } }
    }
};
DI f32x4 swiglu4(const f32x4& g, const f32x4& u) { f32x4 r; r[0] = siluf_(g[0]) * u[0]; r[1] = siluf_(g[1]) * u[1]; r[2] = siluf_(g[2]) * u[2]; r[3] = siluf_(g[3]) * u[3]; return r; }
struct EpiSH { static constexpr bool PERM = true;
    float* LOG; bf16_t* ACT;
    DI void operator()(const f32x4 (&acc)[2][2][4][2], const Unit& u, int wr, int wc, int fr, int fq) const {
        const int row0 = u.pm * BM + wr * 64 + fr, c8 = wc * 32 + 8 * fq;
        if (u.pn == 0) {
#pragma unroll
            for (int bj = 0; bj < 2; ++bj)
#pragma unroll
                for (int ai = 0; ai < 2; ++ai)
#pragma unroll
                    for (int m = 0; m < 4; ++m) { float* p = LOG + (size_t)(row0 + ai * HALF + m * 16) * 256 + bj * HALF + c8; *(f32x4*)p = acc[ai][bj][m][0]; *(f32x4*)(p + 4) = acc[ai][bj][m][1]; }
        } else {
            const int cb = (u.pn - 1) * HALF + c8;
#pragma unroll
            for (int ai = 0; ai < 2; ++ai)
#pragma unroll
                for (int m = 0; m < 4; ++m) { const f32x4 a0 = swiglu4(acc[ai][0][m][0], acc[ai][1][m][0]), a1 = swiglu4(acc[ai][0][m][1], acc[ai][1][m][1]);
                    *(u32x4*)(ACT + (size_t)(row0 + ai * HALF + m * 16) * 256 + cb) = pack8(a0, a1); }
        }
    }
};
struct EpiGU { static constexpr bool PERM = true;
    bf16_t* ACT;
    DI void operator()(const f32x4 (&acc)[2][2][4][2], const Unit& u, int wr, int wc, int fr, int fq) const {
        const int rin0 = wr * 64 + fr, cb = (u.pn & 1) * HALF + wc * 32 + 8 * fq;
#pragma unroll
        for (int ai = 0; ai < 2; ++ai)
#pragma unroll
            for (int m = 0; m < 4; ++m) { const int rin = rin0 + ai * HALF + m * 16;
                if (u.lrow0 + rin < u.cnt) { const f32x4 a0 = swiglu4(acc[ai][0][m][0], acc[ai][1][m][0]), a1 = swiglu4(acc[ai][0][m][1], acc[ai][1][m][1]);
                    *(u32x4*)(ACT + (size_t)(u.pm * BM + rin) * 256 + cb) = pack8(a0, a1); } }
    }
};
struct EpiDown { static constexpr bool PERM = true;
    bf16_t* YB; const int* DST; const float* WL;
    DI void operator()(const f32x4 (&acc)[2][2][4][2], const Unit& u, int wr, int wc, int fr, int fq) const {
        const int rin0 = wr * 64 + fr, cb = (u.pn & 3) * BM + wc * 32 + 8 * fq;
#pragma unroll
        for (int ai = 0; ai < 2; ++ai)
#pragma unroll
            for (int m = 0; m < 4; ++m) { const int local = u.lrow0 + rin0 + ai * HALF + m * 16;
                if (local < u.cnt) { const int dst = DST[(size_t)u.e * NTOK + local]; const float w = WL[(size_t)u.e * NTOK + local];
#pragma unroll
                    for (int bj = 0; bj < 2; ++bj) *(u32x4*)(YB + (size_t)dst * DM + cb + bj * HALF) = pack8(acc[ai][bj][m][0] * w, acc[ai][bj][m][1] * w); } }
    }
};
struct EpiShDown { static constexpr bool PERM = true;
    bf16_t* Y;
    DI void operator()(const f32x4 (&acc)[2][2][4][2], const Unit& u, int wr, int wc, int fr, int fq) const {
        const int row0 = u.pm * BM + wr * 64 + fr, cb = u.pn * BM + wc * 32 + 8 * fq;
#pragma unroll
        for (int ai = 0; ai < 2; ++ai)
#pragma unroll
            for (int m = 0; m < 4; ++m)
#pragma unroll
                for (int bj = 0; bj < 2; ++bj) *(u32x4*)(Y + (size_t)(row0 + ai * HALF + m * 16) * DM + cb + bj * HALF) = pack8(acc[ai][bj][m][0], acc[ai][bj][m][1]);
    }
};
}

namespace att {
#define MFMA32(a, b, c) __builtin_amdgcn_mfma_f32_32x32x16_bf16((a), (b), (c), 0, 0, 0)
constexpr int A_KB = 0, A_VB = 16384, A_IMP = 32768, A_SEL = A_IMP + 4 * 64 * 65 * 4  , A_END = A_SEL + 512;
static_assert(A_END <= RING_BYTES, "attention LDS");
constexpr float NEGINF = -__builtin_inff();
enum { M_BAND = 0, M_SLC = 1, M_FOX = 2, M_CMP1 = 3, M_CMP2 = 4 };
typedef short v4i16_t __attribute__((ext_vector_type(4)));
DI s16x4 vtr(LAS const char* p) { return __builtin_bit_cast(s16x4, __builtin_amdgcn_ds_read_tr16_b64_v4i16((LAS v4i16_t*)p)); }
DI int cofs(int i) { return (i & 3) + 8 * (i >> 2); }

struct Acc { f32x16 o0, o1; float m, l; };
struct PassArgs {
    const bf16_t* Kg; const bf16_t* Vg; int pitch;
    int jfirst, ntiles, step;
    int tq0;
    const LAS float* lut;
    unsigned long long sel;
    float dq; const float* dkg;
    float fm, frl;
    LAS float* imp;
};

DI void qk_tile(f32x16& p0, f32x16& p1, LAS const char* kb, const bf16x8 (&qr)[4], int r, int h) {
#pragma unroll
    for (int i = 0; i < 16; ++i) { p0[i] = 0.f; p1[i] = 0.f; }
    LAS const char* rp = kb + r * 128;
#pragma unroll
    for (int s = 0; s < 4; ++s) { const int o = 16 * ((2 * s + h) ^ (r & 7));
        const bf16x8 a0 = *(const LAS bf16x8*)(rp + o), a1 = *(const LAS bf16x8*)(rp + 4096 + o);
        p0 = MFMA32(a0, qr[s], p0); p1 = MFMA32(a1, qr[s], p1); }
}
DI bf16x8 pack_step(const f32x16& x, int s) { u32x4 p; p.x = cvtpk(x[8 * s], x[8 * s + 1]); p.y = cvtpk(x[8 * s + 2], x[8 * s + 3]); p.z = cvtpk(x[8 * s + 4], x[8 * s + 5]); p.w = cvtpk(x[8 * s + 6], x[8 * s + 7]); return __builtin_bit_cast(bf16x8, p); }
DI void pv_tile(f32x16& o0, f32x16& o1, const f32x16& p0, const f32x16& p1, LAS const char* va0, LAS const char* va1) {
#pragma unroll
    for (int blk = 0; blk < 2; ++blk)
#pragma unroll
        for (int s = 0; s < 2; ++s) { const bf16x8 xs = pack_step(blk ? p1 : p0, s); const int ro = (32 * blk + 16 * s) * 128;
            { const s16x4 lo = vtr(va0 + ro), hi = vtr(va0 + ro + 1024); const bf16x8 vf = __builtin_shufflevector(lo, hi, 0, 1, 2, 3, 4, 5, 6, 7); o0 = MFMA32(vf, xs, o0); }
            { const s16x4 lo = vtr(va1 + ro), hi = vtr(va1 + ro + 1024); const bf16x8 vf = __builtin_shufflevector(lo, hi, 0, 1, 2, 3, 4, 5, 6, 7); o1 = MFMA32(vf, xs, o1); } }
}

template <int MODE, int W>
DI void attn_pass(LAS char* lds, const PassArgs& P, const bf16x8 (&qr)[4], Acc& a, int tid_, int lane_) {
    int lane; asm volatile("v_mbcnt_lo_u32_b32 %0, -1, 0\n\tv_mbcnt_hi_u32_b32 %0, -1, %0" : "=v"(lane)); const int tid = (tid_ & ~63) | lane; (void)lane_;
    const int r = lane & 31, h = lane >> 5;
    const int lrow = tid >> 3, lch = tid & 7;
    const size_t goff = (size_t)lrow * P.pitch + lch * 8;
    const int kdst = lrow * 128 + 16 * (lch ^ (lrow & 7)), vdst = lrow * 128 + 16 * (lch ^ (((lrow >> 1) & 1) << 2));
    const int q4 = (lane & 15) >> 2, p4 = lane & 3, g1 = (lane >> 4) & 1, swb = (q4 >> 1) & 1;
    const int vofs0 = (4 * h + q4) * 128 + 16 * (4 * (0 ^ swb) + 2 * g1 + (p4 >> 1)) + 8 * (p4 & 1);
    const int vofs1 = (4 * h + q4) * 128 + 16 * (4 * (1 ^ swb) + 2 * g1 + (p4 >> 1)) + 8 * (p4 & 1);
    const int tq = P.tq0 + r;
    u32x4 kr, vr;
    { const size_t t0 = (size_t)P.jfirst * 64 * P.pitch + goff; kr = *(const u32x4*)(P.Kg + t0); vr = *(const u32x4*)(P.Vg + t0); }
    *(LAS u32x4*)(lds + A_KB + kdst) = kr; *(LAS u32x4*)(lds + A_VB + vdst) = vr;
    __syncthreads();
    float carry = 0.f;
    for (int it = 0; it < P.ntiles; ++it) {
        const int j = P.jfirst + it * P.step, buf = it & 1;
        const bool more = (it + 1 < P.ntiles);
        if (more) { const size_t t0 = (size_t)(j + P.step) * 64 * P.pitch + goff; kr = *(const u32x4*)(P.Kg + t0); vr = *(const u32x4*)(P.Vg + t0); }
        const int kv0 = 64 * j;
        bool skip;
        if (MODE == M_BAND) skip = (kv0 > P.tq0 + 31) || (kv0 + 63 < P.tq0 - (W - 1));
        else if (MODE == M_SLC) skip = (kv0 > P.tq0 + 31) || (__ballot((P.sel >> j) & 1ull) == 0ull);
        else if (MODE == M_FOX) skip = (kv0 > P.tq0 + 31);
        else skip = (1024 * j > P.tq0);
        if (!skip) {
            LAS const char* kb = lds + A_KB + buf * 8192; LAS const char* vb = lds + A_VB + buf * 8192;
            f32x16 p0, p1; qk_tile(p0, p1, kb, qr, r, h);
            if (MODE == M_BAND || MODE == M_SLC) {
                const bool far = (P.tq0 - (kv0 + 63) >= 127) && (MODE == M_SLC || (P.tq0 + 31 - kv0 < W));
                if (far) { const float c = P.lut[127];
#pragma unroll
                    for (int i = 0; i < 16; ++i) { p0[i] += c; p1[i] += c; }
                } else { const int base = tq - kv0 - 4 * h;
#pragma unroll
                    for (int i = 0; i < 16; ++i) {
                        { const int rel = base - cofs(i); const bool ok = (MODE == M_SLC) ? (rel >= 0) : ((unsigned)rel < (unsigned)W); int ix = rel < 127 ? rel : 127; ix = ix > 0 ? ix : 0; p0[i] = ok ? p0[i] + P.lut[ix] : NEGINF; }
                        { const int rel = base - 32 - cofs(i); const bool ok = (MODE == M_SLC) ? (rel >= 0) : ((unsigned)rel < (unsigned)W); int ix = rel < 127 ? rel : 127; ix = ix > 0 ? ix : 0; p1[i] = ok ? p1[i] + P.lut[ix] : NEGINF; } }
                }
                if (MODE == M_SLC) { if (!((P.sel >> j) & 1ull)) {
#pragma unroll
                    for (int i = 0; i < 16; ++i) { p0[i] = NEGINF; p1[i] = NEGINF; } } }
            } else if (MODE == M_FOX) {
                const bool full = (kv0 + 63 <= P.tq0); const int base = tq - kv0 - 4 * h;
#pragma unroll
                for (int k = 0; k < 4; ++k) { const f32x4 d0 = *(const f32x4*)(P.dkg + kv0 + 8 * k + 4 * h), d1 = *(const f32x4*)(P.dkg + kv0 + 32 + 8 * k + 4 * h);
#pragma unroll
                    for (int e = 0; e < 4; ++e) { const int i = 4 * k + e; const int rel = base - cofs(i);
                        const float v0 = p0[i] + (P.dq - d0[e]), v1 = p1[i] + (P.dq - d1[e]);
                        p0[i] = (full || rel >= 0) ? v0 : NEGINF; p1[i] = (full || rel - 32 >= 0) ? v1 : NEGINF; } }
            } else {
                const int base = tq - 31 - 16 * (64 * j + 4 * h);
#pragma unroll
                for (int i = 0; i < 16; ++i) {
                    { const int rel = base - 16 * cofs(i); const bool ok = rel >= 0; int ix = rel < 127 ? rel : 127; ix = ix > 0 ? ix : 0; p0[i] = ok ? p0[i] + P.lut[ix] : NEGINF; }
                    { const int rel = base - 512 - 16 * cofs(i); const bool ok = rel >= 0; int ix = rel < 127 ? rel : 127; ix = ix > 0 ? ix : 0; p1[i] = ok ? p1[i] + P.lut[ix] : NEGINF; } }
            }
            if (MODE != M_CMP2) {
                float tm = fmaxf(p0[0], p1[0]);
#pragma unroll
                for (int i = 1; i < 16; ++i) tm = fmaxf(tm, fmaxf(p0[i], p1[i]));
                tm = fmaxf(tm, __shfl_xor(tm, 32));
                const float mn = fmaxf(a.m, tm);
                const float alpha = fast_exp2(a.m - mn);
                a.m = mn;
                if (__any(alpha != 1.f)) { a.l *= alpha;
                    if (MODE != M_CMP1) {
#pragma unroll
                        for (int i = 0; i < 16; ++i) { a.o0[i] *= alpha; a.o1[i] *= alpha; } } }
                float s = 0.f;
#pragma unroll
                for (int i = 0; i < 16; ++i) { p0[i] = fast_exp2(p0[i] - mn); p1[i] = fast_exp2(p1[i] - mn); s += p0[i] + p1[i]; }
                a.l += s;
                if (MODE != M_CMP1) pv_tile(a.o0, a.o1, p0, p1, vb + vofs0, vb + vofs1);
            } else {
#pragma unroll
                for (int i = 0; i < 16; ++i) { p0[i] = fast_exp2(p0[i] - P.fm) * P.frl; p1[i] = fast_exp2(p1[i] - P.fm) * P.frl; }
                float a8[8], b8[8];
#pragma unroll
                for (int k = 0; k < 4; ++k) { a8[k] = p0[4 * k] + p0[4 * k + 1] + p0[4 * k + 2] + 0.5f * p0[4 * k + 3]; b8[k] = 0.5f * p0[4 * k + 3];
                    a8[4 + k] = p1[4 * k] + p1[4 * k + 1] + p1[4 * k + 2] + 0.5f * p1[4 * k + 3]; b8[4 + k] = 0.5f * p1[4 * k + 3]; }
                float bs[8];
#pragma unroll
                for (int k = 0; k < 8; ++k) bs[k] = __shfl_xor(b8[k], 32);
#pragma unroll
                for (int k = 0; k < 8; ++k) { const float prev = (k == 0) ? carry : bs[k > 0 ? k - 1 : 0]; P.imp[16 * j + 2 * k + h] = a8[k] + (h ? bs[k] : prev); }
                carry = bs[7];
                pv_tile(a.o0, a.o1, p0, p1, vb + vofs0, vb + vofs1);
            }
        } else if (MODE == M_CMP2) {
            if (h == 0) P.imp[16 * j] = carry;
            carry = 0.f;
        }
        if (more) { *(LAS u32x4*)(lds + A_KB + (buf ^ 1) * 8192 + kdst) = kr; *(LAS u32x4*)(lds + A_VB + (buf ^ 1) * 8192 + vdst) = vr; }
        __syncthreads();
    }
}
DI void acc_init(Acc& a, float m0, float l0) {
#pragma unroll
    for (int i = 0; i < 16; ++i) { a.o0[i] = 0.f; a.o1[i] = 0.f; }
    a.m = m0; a.l = l0;
}
DI void load_q(bf16x8 (&qr)[4], const bf16_t* Qrow  , int lane) {
    const bf16_t* p = Qrow + (size_t)(lane & 31) * QKV_N + 8 * (lane >> 5);
#pragma unroll
    for (int s = 0; s < 4; ++s) qr[s] = *(const bf16x8*)(p + 16 * s);
}
DI void store_ot(bf16_t* O, const f32x16& y0, const f32x16& y1, float sc, int lane) {
    bf16_t* rowp = O + (size_t)(lane & 31) * DM + 4 * (lane >> 5);
#pragma unroll
    for (int g = 0; g < 4; ++g) {
        u32x2 a; a.x = cvtpk(y0[4 * g] * sc, y0[4 * g + 1] * sc); a.y = cvtpk(y0[4 * g + 2] * sc, y0[4 * g + 3] * sc); *(u32x2*)(rowp + 8 * g) = a;
        u32x2 b; b.x = cvtpk(y1[4 * g] * sc, y1[4 * g + 1] * sc); b.y = cvtpk(y1[4 * g + 2] * sc, y1[4 * g + 3] * sc); *(u32x2*)(rowp + 32 + 8 * g) = b; }
}
}

#ifndef PH_MASK
#define PH_MASK 0xFFFF
#endif
#define PH(k) ((PH_MASK >> (k)) & 1)
#ifndef REP_PHASE
#define REP_PHASE -1
#endif
#ifndef REP_N
#define REP_N 1
#endif
#define NREP(k) (((k) == REP_PHASE) ? REP_N : 1)
struct Args { const float* in[25]; float* out; unsigned char* ws; };

DI float wave_sum(float v) {
#pragma unroll
    for (int o = 1; o < 64; o <<= 1) v += __shfl_xor(v, o);
    return v;
}
DI unsigned f2bf(float f) { unsigned u = __builtin_bit_cast(unsigned, f); return (u + 0x7fffu + ((u >> 16) & 1u)) >> 16; }
DI unsigned pk2(float lo, float hi) { return f2bf(lo) | (f2bf(hi) << 16); }

enum { MAP_ID = 0, MAP_WIN = 1, MAP_GU_G = 2, MAP_GU_U = 3 };
DI int map_row(int kind, int c) {
    if (kind == MAP_WIN) { if (c < 1280) return c; if (c < 1292) return C_SM + (c - 1280); if (c < 2444) return c - 12; return c; }
    if (kind == MAP_GU_G) return (c >> 7) * 256 + (c & 127);
    if (kind == MAP_GU_U) return (c >> 7) * 256 + 128 + (c & 127);
    return c;
}
DI void cvt_item(const float* W, int K, int N, bf16_t* WT, int kind, int row_off, LAS float* scr, int item, int lane) {
    const int nblk = (N + 31) / 32, kb = item / nblk, nb = item % nblk, k0 = 64 * kb, n0 = 32 * nb;
    const int cn = n0 + (lane & 31); const bool cok = cn < N;
    float vv[32];
#pragma unroll
    for (int i = 0; i < 32; ++i) { const int kk = 2 * i + (lane >> 5); vv[i] = cok ? __builtin_nontemporal_load(W + (size_t)(k0 + kk) * N + cn) : 0.f; }
#pragma unroll
    for (int i = 0; i < 32; ++i) { const int kk = 2 * i + (lane >> 5); scr[kk * 33 + (lane & 31)] = vv[i]; }
    asm volatile("s_waitcnt lgkmcnt(0)" ::: "memory");
    const int c = lane & 7;
#pragma unroll
    for (int j = 0; j < 4; ++j) { const int n = (lane >> 3) + 8 * j; const LAS float* s = scr + (8 * c) * 33 + n;
        u32x4 o; o.x = pk2(s[0 * 33], s[1 * 33]); o.y = pk2(s[2 * 33], s[3 * 33]); o.z = pk2(s[4 * 33], s[5 * 33]); o.w = pk2(s[6 * 33], s[7 * 33]);
        if (n0 + n < N) *(u32x4*)(WT + (size_t)(row_off + map_row(kind, n0 + n)) * K + k0 + 8 * c) = o; }
    asm volatile("s_waitcnt lgkmcnt(0)" ::: "memory");
}

DI unsigned long long ldp(volatile LAS unsigned long long* PT, int k) { int ko = k; asm volatile("" : "+v"(ko)); const unsigned long long v = PT[ko];
    const unsigned lo = __builtin_amdgcn_readfirstlane((unsigned)v), hi = __builtin_amdgcn_readfirstlane((unsigned)(v >> 32)); return ((unsigned long long)hi << 32) | lo; }
#define INP(k) ((const float*)ldp(PT, (k)))
#define WSP(off) ((unsigned char*)ldp(PT, 26) + (off))
#define OUTP ((float*)ldp(PT, 25))

__global__ void __launch_bounds__(512, 2) mega_fwd(Args args) {
    extern __shared__ __attribute__((aligned(16))) unsigned char lds_raw[];
    LAS unsigned char* lds = (LAS unsigned char*)lds_raw;
    volatile LAS unsigned* MISC = (volatile LAS unsigned*)(lds + L_MISC);
    LAS float* LUT = (LAS float*)(lds + L_LUT);
    LAS int* TP = (LAS int*)(lds + L_TP);
    LAS int* CNTL = (LAS int*)(lds + L_CNT);
    const int wid0 = __builtin_amdgcn_readfirstlane((int)threadIdx.x >> 6);
#define LAUNDER_TID int lane; asm volatile("v_mbcnt_lo_u32_b32 %0, -1, 0\n\tv_mbcnt_hi_u32_b32 %0, -1, %0" : "=v"(lane)); int wid = wid0; asm volatile("" : "+s"(wid)); const int tid = wid * 64 + lane; (void)tid;
    const int G = gridDim.x, bx = blockIdx.x;
    volatile LAS unsigned long long* PT = (volatile LAS unsigned long long*)(lds + L_PT);
    { LAUNDER_TID
    if (tid == 0) {
        PT[0] = (unsigned long long)args.in[0]; PT[1] = (unsigned long long)args.in[1]; PT[2] = (unsigned long long)args.in[2]; PT[3] = (unsigned long long)args.in[3];
        PT[4] = (unsigned long long)args.in[4]; PT[5] = (unsigned long long)args.in[5]; PT[6] = (unsigned long long)args.in[6]; PT[7] = (unsigned long long)args.in[7];
        PT[8] = (unsigned long long)args.in[8]; PT[9] = (unsigned long long)args.in[9]; PT[10] = (unsigned long long)args.in[10]; PT[11] = (unsigned long long)args.in[11];
        PT[12] = (unsigned long long)args.in[12]; PT[13] = (unsigned long long)args.in[13]; PT[14] = (unsigned long long)args.in[14]; PT[15] = (unsigned long long)args.in[15];
        PT[16] = (unsigned long long)args.in[16]; PT[17] = (unsigned long long)args.in[17]; PT[18] = (unsigned long long)args.in[18]; PT[19] = (unsigned long long)args.in[19];
        PT[20] = (unsigned long long)args.in[20]; PT[21] = (unsigned long long)args.in[21]; PT[22] = (unsigned long long)args.in[22]; PT[23] = (unsigned long long)args.in[23];
        PT[24] = (unsigned long long)args.in[24]; PT[25] = (unsigned long long)args.out; PT[26] = (unsigned long long)args.ws;
    }
    for (int u = tid; u < 64; u += 512) MISC[u] = 0u;
    for (int u = tid; u < 1280; u += 512) { const int hh = u >> 7, rel = u & 127; int bk = rel;
        if (rel >= 16) { bk = 16; const int th[15] = {19, 21, 24, 27, 31, 35, 40, 46, 52, 59, 67, 77, 87, 99, 113};
#pragma unroll
            for (int q = 0; q < 15; ++q) bk += (rel >= th[q]) ? 1 : 0; }
        LUT[u] = args.in[10][bk * 10 + hh] * LOG2E; }
    }
    __syncthreads();
    XcdBarrier bar = xcd_barrier_post((unsigned*)WSP(WS_CTL) + CW_BAR, MISC);
#define GRID_BAR() do { XcdBarrier b2_ = bar; b2_.bar = (unsigned*)WSP(WS_CTL) + CW_BAR; asm volatile("" : "+s"(b2_.x)); int ln_; asm volatile("v_mbcnt_lo_u32_b32 %0, -1, 0\n\tv_mbcnt_hi_u32_b32 %0, -1, %0" : "=v"(ln_)); xcd_barrier(b2_, (wid0 == 0) && (ln_ == 0)); } while (0)
#define QNEXT(ctr, dstvar) do { if (tid == 0) MISC[8] = atomicAdd((ctr), 1u); __syncthreads(); dstvar = (int)__builtin_amdgcn_readfirstlane(MISC[8]); __syncthreads(); } while (0)

    for (int rep = 0; rep < NREP(0); ++rep) if (PH(0)) { LAUNDER_TID
            float* ADA = (float*)WSP(WS_ADA); float* CPOS = (float*)WSP(WS_CPOS); bf16_t* WIN = (bf16_t*)WSP(WS_WIN); bf16_t* WO = (bf16_t*)WSP(WS_WO); bf16_t* WSH = (bf16_t*)WSP(WS_WSH); bf16_t* WSD = (bf16_t*)WSP(WS_WSD); bf16_t* WCT = (bf16_t*)WSP(WS_WCT); bf16_t* WGU = (bf16_t*)WSP(WS_WGU); bf16_t* WD = (bf16_t*)WSP(WS_WD);
        if (bx < 192) {
            LAS float* cond = (LAS float*)lds;
            LAS float* red = (LAS float*)(lds + 32768);
            for (int u = tid; u < 8192; u += 512) cond[u] = siluf_(INP(1)[u]);
            __syncthreads();
            const int l = bx / 96, j0 = (bx % 96) * 64;
            const float* wa = INP(11) + (size_t)l * DM * 6144 + j0 + lane;
            float accb[8];
#pragma unroll
            for (int b = 0; b < 8; ++b) accb[b] = 0.f;
#pragma unroll 8
            for (int kk = 0; kk < 128; ++kk) { const int k = wid * 128 + kk; const float w = wa[(size_t)k * 6144];
#pragma unroll
                for (int b = 0; b < 8; ++b) accb[b] += cond[b * 1024 + k] * w; }
#pragma unroll
            for (int b = 0; b < 8; ++b) red[(wid * 8 + b) * 64 + lane] = accb[b];
            __syncthreads();
            { const int b = tid >> 6; float s = INP(12)[l * 6144 + j0 + lane];
#pragma unroll
                for (int w = 0; w < 8; ++w) s += red[(w * 8 + b) * 64 + lane];
                ADA[((size_t)l * 8 + b) * 6144 + j0 + lane] = s; }
            __syncthreads();
        } else if (bx < 196) {
            const int l = (bx - 192) >> 1, which = (bx - 192) & 1;
            const float* pos = INP(which ? 7 : 5) + (size_t)l * 2048 + wid * 256; const float* w = INP(which ? 8 : 6) + (size_t)l * 2048 * 64 + (size_t)wid * 256 * 64;
            LAS float* red = (LAS float*)lds;
            float s = 0.f;
#pragma unroll 16
            for (int k = 0; k < 256; ++k) s += pos[k] * w[(size_t)k * 64 + lane];
            red[wid * 64 + lane] = s;
            __syncthreads();
            if (wid == 0) { float t = 0.f;
#pragma unroll
                for (int w8 = 0; w8 < 8; ++w8) t += red[w8 * 64 + lane];
                CPOS[(l * 2 + which) * 64 + lane] = t; }
            __syncthreads();
        }
        { const int gt = bx * 512 + tid; const int per = (QKV_N - D_IN) * DM / 8;
            for (int u = gt; u < 2 * per; u += G * 512) { const int l = u / per, r = u % per; *(u32x4*)(WIN + ((size_t)l * QKV_N + D_IN) * DM + (size_t)r * 8) = (u32x4){0u, 0u, 0u, 0u}; } }
        LAS float* scr = (LAS float*)(lds + wid * 16384);
        const int gw = bx * 8 + wid, NGW = G * 8;
        constexpr int I_SMALL = 2384, I_EXP = 384;
        const int NITEMS = DEPTH * I_SMALL + DEPTH * NEXP * I_EXP;
        for (int it = gw; it < NITEMS; it += NGW) {
            if (it < DEPTH * I_SMALL) { const int l = it / I_SMALL; int r = it % I_SMALL;
                if (r < 1232) { cvt_item(INP(2) + (size_t)l * DM * D_IN, DM, D_IN, WIN + (size_t)l * QKV_N * DM, MAP_WIN, 0, scr, r, lane); continue; } r -= 1232;
                if (r < 512) { cvt_item(INP(3) + (size_t)l * DM * DM, DM, DM, WO + (size_t)l * DM * DM, MAP_ID, 0, scr, r, lane); continue; } r -= 512;
                if (r < 128) { cvt_item(INP(17) + (size_t)l * DM * 256, DM, 256, WSH + (size_t)l * 768 * DM, MAP_ID, 0, scr, r, lane); continue; } r -= 128;
                if (r < 128) { cvt_item(INP(22) + (size_t)l * DM * 256, DM, 256, WSH + (size_t)l * 768 * DM, MAP_GU_G, 256, scr, r, lane); continue; } r -= 128;
                if (r < 128) { cvt_item(INP(23) + (size_t)l * DM * 256, DM, 256, WSH + (size_t)l * 768 * DM, MAP_GU_U, 256, scr, r, lane); continue; } r -= 128;
                if (r < 128) { cvt_item(INP(24) + (size_t)l * 256 * DM, 256, DM, WSD + (size_t)l * DM * 256, MAP_ID, 0, scr, r, lane); continue; } r -= 128;
                if (r < 64) { cvt_item(INP(6) + (size_t)l * 2048 * 64, 2048, 64, WCT + (size_t)(l * 2 + 0) * 64 * 2048, MAP_ID, 0, scr, r, lane); continue; } r -= 64;
                cvt_item(INP(8) + (size_t)l * 2048 * 64, 2048, 64, WCT + (size_t)(l * 2 + 1) * 64 * 2048, MAP_ID, 0, scr, r, lane);
            } else { const int r0 = it - DEPTH * I_SMALL; const int le = r0 / I_EXP, r = r0 % I_EXP;
                if (r < 128) cvt_item(INP(19) + (size_t)le * DM * EDIM, DM, EDIM, WGU + (size_t)le * 512 * DM, MAP_GU_G, 0, scr, r, lane);
                else if (r < 256) cvt_item(INP(20) + (size_t)le * DM * EDIM, DM, EDIM, WGU + (size_t)le * 512 * DM, MAP_GU_U, 0, scr, r - 128, lane);
                else cvt_item(INP(21) + (size_t)le * EDIM * DM, EDIM, DM, WD + (size_t)le * DM * EDIM, MAP_ID, 0, scr, r - 256, lane);
            }
        }
    }
    GRID_BAR();
    if (PH(1)) { LAUNDER_TID
            float* ADA = (float*)WSP(WS_ADA); bf16_t* H = (bf16_t*)WSP(WS_H);
        const int gw = bx * 8 + wid, NGW = G * 8;
        for (int m = gw; m < NTOK; m += NGW) { const int b = m >> 12; const float* ad = ADA + (size_t)b * 6144;
            const f32x4* xr = (const f32x4*)(INP(0) + (size_t)m * DM) + lane; unsigned long long* o8 = (unsigned long long*)(H + (size_t)m * DM) + lane;
#pragma unroll
            for (int j = 0; j < 4; ++j) { const f32x4 v = xr[64 * j]; const f32x4 sh = *((const f32x4*)(ad) + 64 * j + lane), sc = *((const f32x4*)(ad + 1024) + 64 * j + lane);
                const f32x4 hv = v * (sc + 1.f) + sh; o8[64 * j] = (unsigned long long)cvtpk(hv[0], hv[1]) | ((unsigned long long)cvtpk(hv[2], hv[3]) << 32); } }
    }
    GRID_BAR();

    for (int l = 0; l < DEPTH; ++l) {
        for (int rep = 0; rep < NREP(2); ++rep) if (PH(2)) { LAUNDER_TID
            bf16_t* H = (bf16_t*)WSP(WS_H); bf16_t* WIN = (bf16_t*)WSP(WS_WIN); bf16_t* QKV = (bf16_t*)WSP(WS_QKV); float* SMALL = (float*)WSP(WS_SMALL);
            pg8::Gemm g{H, WIN + (size_t)l * QKV_N * DM, DM}; pg8::StaticOrder S; S.init(NTOK, QKV_N, G, bx);
            pg8::EpiQKV E{QKV, SMALL};
            pg8::gemm_phase<pg8::EpiQKV, pg8::StaticOrder>(lds, g, S, E, wid);
        }
        GRID_BAR();
        for (int rep = 0; rep < NREP(3); ++rep) if (PH(3)) { LAUNDER_TID
            unsigned* ctl = (unsigned*)WSP(WS_CTL); bf16_t* QKV = (bf16_t*)WSP(WS_QKV); bf16_t* WCT = (bf16_t*)WSP(WS_WCT); float* CPOS = (float*)WSP(WS_CPOS); bf16_t* KCMP = (bf16_t*)WSP(WS_KCMP); bf16_t* VCMP = (bf16_t*)WSP(WS_VCMP); float* SMALL = (float*)WSP(WS_SMALL); float* DC = (float*)WSP(WS_DC); bf16_t* OB = (bf16_t*)WSP(WS_O);
            unsigned* qctr = ctl + CW_Q + 64 * (l * 4 + 0 + 8 * rep);
            for (;;) {
                int u; QNEXT(qctr, u);
                if (u >= 32 + 48 + 768) break;
                if (u < 32) {
                    const int b = u >> 2, which = (u >> 1) & 1, cblk = u & 1, nblk = wid, r = lane & 31, h = lane >> 5;
                    int n = 32 * nblk + r; n = n < 254 ? n : 254;
                    const bf16_t* arow = QKV + ((size_t)b * SEQ + 16 * n) * QKV_N + (which ? C_BVC : C_BKC) + 8 * h;
                    const bf16_t* brow = WCT + ((size_t)(l * 2 + which) * 64 + 32 * cblk + r) * 2048 + 8 * h;
                    f32x16 acc;
#pragma unroll
                    for (int i = 0; i < 16; ++i) acc[i] = 0.f;
#pragma unroll 4
                    for (int s = 0; s < 128; ++s) { const int k = 16 * s; const bf16x8 af = *(const bf16x8*)(arow + (size_t)(k >> 6) * QKV_N + (k & 63)); const bf16x8 bf = *(const bf16x8*)(brow + k);
                        acc = MFMA32(af, bf, acc); }
                    const float cp = CPOS[(l * 2 + which) * 64 + 32 * cblk + r]; bf16_t* dst = (which ? VCMP : KCMP) + (size_t)b * 256 * 64 + 32 * cblk + r;
#pragma unroll
                    for (int i = 0; i < 16; ++i) { const int nn = 32 * nblk + (i & 3) + 8 * (i >> 2) + 4 * h; dst[(size_t)nn * 64] = (bf16_t)(nn < 255 ? f2bf(acc[i] + cp) : 0u); }
                } else if (u < 80) {
                    const int b = (u - 32) / 6, hh = (u - 32) % 6; const float fb = INP(9)[l * 6 + hh];
                    LAS float* wsum = (LAS float*)lds;
                    float v[8]; float run = 0.f;
#pragma unroll
                    for (int i = 0; i < 8; ++i) { const float x = SMALL[((size_t)b * SEQ + 8 * tid + i) * 32 + 12 + hh] + fb; const float lf = fminf(x, 0.f) - log1pf(__expf(-fabsf(x))); run += lf; v[i] = run; }
                    float incl = run;
#pragma unroll
                    for (int o = 1; o < 64; o <<= 1) { const float t = __shfl_up(incl, o); if (lane >= o) incl += t; }
                    if (lane == 63) wsum[wid] = incl;
                    __syncthreads();
                    float base = incl - run;
                    for (int w = 0; w < wid; ++w) base += wsum[w];
                    float* dst = DC + ((size_t)b * 6 + hh) * SEQ + 8 * tid;
#pragma unroll
                    for (int i = 0; i < 8; ++i) dst[i] = (base + v[i]) * LOG2E;
                    __syncthreads();
                } else {
                    const int ua = u - 80, qt = ua & 15, hq = (ua >> 4) % 6, b = ua / 96, kvh = hq / 3;
                    const size_t tok0 = (size_t)b * SEQ + 256 * qt + 32 * wid;
                    bf16x8 qr[4]; att::load_q(qr, QKV + tok0 * QKV_N + C_AQ + 64 * hq, lane);
                    att::Acc a; att::acc_init(a, INP(4)[l * 6 + hq] * LOG2E, (lane < 32) ? 1.f : 0.f);
                    att::PassArgs P; P.Kg = QKV + (size_t)b * SEQ * QKV_N + C_AK + 64 * kvh; P.Vg = QKV + (size_t)b * SEQ * QKV_N + C_AV + 64 * kvh; P.pitch = QKV_N;
                    P.jfirst = (4 * qt - 2) > 0 ? (4 * qt - 2) : 0; P.ntiles = 4 * qt + 3 - P.jfirst + 1; P.step = 1; P.tq0 = 256 * qt + 32 * wid;
                    P.lut = LUT + 128 * hq; P.sel = 0ull; P.dq = 0.f; P.dkg = nullptr; P.fm = 0.f; P.frl = 0.f; P.imp = nullptr;
                    att::attn_pass<att::M_BAND, 128>((LAS char*)lds, P, qr, a, tid, lane);
                    const float lt = a.l + __shfl_xor(a.l, 32);
                    att::store_ot(OB + tok0 * DM + O_A + 64 * hq, a.o0, a.o1, 1.f / lt, lane);
                }
            }
        }
        GRID_BAR();
        for (int rep = 0; rep < NREP(4); ++rep) if (PH(4)) { LAUNDER_TID
            unsigned* ctl = (unsigned*)WSP(WS_CTL); bf16_t* QKV = (bf16_t*)WSP(WS_QKV); float* DC = (float*)WSP(WS_DC); bf16_t* KCMP = (bf16_t*)WSP(WS_KCMP); bf16_t* VCMP = (bf16_t*)WSP(WS_VCMP); float* SMALL = (float*)WSP(WS_SMALL); bf16_t* OB = (bf16_t*)WSP(WS_O);
            unsigned* qctr = ctl + CW_Q + 64 * (l * 4 + 1 + 8 * rep);
            for (;;) {
                int u; QNEXT(qctr, u);
                if (u >= 1280) break;
                const int grp = u / 80, rr = u % 80, L = 15 - grp;
                if (rr < 48) { if (PH(14)) {
                    const int b = rr / 6, hh = rr % 6, qt = L;
                    const size_t tok0 = (size_t)b * SEQ + 256 * qt + 32 * wid;
                    bf16x8 qr[4]; att::load_q(qr, QKV + tok0 * QKV_N + C_CQ + 64 * hh, lane);
                    att::Acc a; att::acc_init(a, -1e30f, 0.f);
                    att::PassArgs P; P.Kg = QKV + (size_t)b * SEQ * QKV_N + C_CK + 64 * hh; P.Vg = QKV + (size_t)b * SEQ * QKV_N + C_CV + 64 * hh; P.pitch = QKV_N;
                    P.jfirst = 4 * qt + 3; P.ntiles = 4 * qt + 4; P.step = -1; P.tq0 = 256 * qt + 32 * wid;
                    P.lut = LUT; P.sel = 0ull; P.dkg = DC + ((size_t)b * 6 + hh) * SEQ; P.dq = P.dkg[P.tq0 + (lane & 31)]; P.fm = 0.f; P.frl = 0.f; P.imp = nullptr;
                    att::attn_pass<att::M_FOX, 0>((LAS char*)lds, P, qr, a, tid, lane);
                    const float lt = a.l + __shfl_xor(a.l, 32);
                    att::store_ot(OB + tok0 * DM + O_C + 64 * hh, a.o0, a.o1, 1.f / lt, lane);
                } } else if (PH(15)) {
                    const int r2 = rr - 48, qt = 4 * L + 3 - (r2 >> 3), b = r2 & 7, head = wid >> 1, qh = wid & 1;
                    const size_t tok0 = (size_t)b * SEQ + 64 * qt + 32 * qh; const int tq0 = 64 * qt + 32 * qh;
                    const int r = lane & 31, h = lane >> 5;
                    LAS float* IMP = (LAS float*)(lds + att::A_IMP);
                    LAS unsigned long long* SELM = (LAS unsigned long long*)(lds + att::A_SEL);
                    for (int q = tid; q < 4 * 64 * 65; q += 512) IMP[q] = 0.f;
                    bf16x8 qr[4]; att::load_q(qr, QKV + tok0 * QKV_N + C_BQ + 64 * head, lane);
                    const float* gl = SMALL + (tok0 + r) * 32 + head;
                    const float g0 = sigmoidf_(gl[0]), g1 = sigmoidf_(gl[4]), g2 = sigmoidf_(gl[8]);
                    att::PassArgs P; P.pitch = 64; P.Kg = KCMP + (size_t)b * 256 * 64; P.Vg = VCMP + (size_t)b * 256 * 64;
                    P.jfirst = 0; P.ntiles = (qt >> 4) + 1; P.step = 1; P.tq0 = tq0; P.lut = LUT + 128 * (6 + head); P.sel = 0ull; P.dq = 0.f; P.dkg = nullptr;
                    P.fm = 0.f; P.frl = 0.f; P.imp = IMP + (head * 64 + 32 * qh + r) * 65;
                    att::Acc a; att::acc_init(a, -1e30f, 0.f);
                    att::attn_pass<att::M_CMP1, 0>((LAS char*)lds, P, qr, a, tid, lane);
                    { const float lt = a.l + __shfl_xor(a.l, 32); P.fm = a.m; P.frl = lt > 0.f ? 1.f / lt : 0.f; }
                    att::acc_init(a, 0.f, 0.f);
                    att::attn_pass<att::M_CMP2, 0>((LAS char*)lds, P, qr, a, tid, lane);
#pragma unroll
                    for (int i = 0; i < 16; ++i) { a.o0[i] *= g0; a.o1[i] *= g0; }
                    for (int qi = 0; qi < 8; ++qi) { const int q = 8 * wid + qi;
                        float v = IMP[(0 * 64 + q) * 65 + lane] + IMP[(1 * 64 + q) * 65 + lane] + IMP[(2 * 64 + q) * 65 + lane] + IMP[(3 * 64 + q) * 65 + lane];
                        if (lane == 0 || lane == qt || lane == qt - 1) v = 1e4f; else if (lane > qt) v = -1.f;
                        int rank = 0;
#pragma unroll
                        for (int jj = 0; jj < 64; ++jj) { const float vj = __uint_as_float(__builtin_amdgcn_readlane(__float_as_uint(v), jj)); rank += ((vj > v) || (vj == v && jj < lane)) ? 1 : 0; }
                        const unsigned long long mk = __ballot(rank < 16);
                        if (lane == 0) SELM[q] = mk; }
                    __syncthreads();
                    P.sel = SELM[32 * qh + r];
                    LAS float* FR = IMP + tid;
#pragma unroll
                    for (int i = 0; i < 16; ++i) { FR[512 * i] = a.o0[i]; FR[512 * (16 + i)] = a.o1[i]; }
                    P.pitch = QKV_N; P.Kg = QKV + (size_t)b * SEQ * QKV_N + C_BKS; P.Vg = QKV + (size_t)b * SEQ * QKV_N + C_BVS; P.jfirst = 0; P.ntiles = qt + 1; P.step = 1;
                    att::acc_init(a, -1e30f, 0.f);
                    att::attn_pass<att::M_SLC, 0>((LAS char*)lds, P, qr, a, tid, lane);
                    { const float lt = a.l + __shfl_xor(a.l, 32); const float sc = g1 / lt;
#pragma unroll
                        for (int i = 0; i < 16; ++i) { FR[512 * i] += sc * a.o0[i]; FR[512 * (16 + i)] += sc * a.o1[i]; } }
                    P.Kg = QKV + (size_t)b * SEQ * QKV_N + C_BKW; P.Vg = QKV + (size_t)b * SEQ * QKV_N + C_BVW; P.jfirst = (qt - 8) > 0 ? (qt - 8) : 0; P.ntiles = qt - P.jfirst + 1;
                    att::acc_init(a, -1e30f, 0.f);
                    att::attn_pass<att::M_BAND, 512>((LAS char*)lds, P, qr, a, tid, lane);
                    { const float lt = a.l + __shfl_xor(a.l, 32); const float sc = g2 / lt;
#pragma unroll
                        for (int i = 0; i < 16; ++i) { a.o0[i] = FR[512 * i] + sc * a.o0[i]; a.o1[i] = FR[512 * (16 + i)] + sc * a.o1[i]; } }
                    att::store_ot(OB + tok0 * DM + O_B + 64 * head, a.o0, a.o1, 1.f, lane);
                }
            }
        }
        GRID_BAR();
        for (int rep = 0; rep < NREP(5); ++rep) if (PH(5)) { LAUNDER_TID
            bf16_t* OB = (bf16_t*)WSP(WS_O); bf16_t* WO = (bf16_t*)WSP(WS_WO); const float* xin = (l == 0) ? INP(0) : (const float*)OUTP; float* VB = (float*)WSP(WS_V); const float* ada_l = (const float*)WSP(WS_ADA) + (size_t)l * 8 * 6144;
            pg8::Gemm g{OB, WO + (size_t)l * DM * DM, DM}; pg8::StaticOrder S; S.init(NTOK, DM, G, bx);
            pg8::EpiWO E{xin, VB, ada_l + 2 * 1024};
            pg8::gemm_phase<pg8::EpiWO, pg8::StaticOrder>(lds, g, S, E, wid);
        }
        GRID_BAR();
        for (int rep = 0; rep < NREP(6); ++rep) if (PH(6)) { LAUNDER_TID
            float* VB = (float*)WSP(WS_V); float* X1 = (float*)WSP(WS_X1); bf16_t* H = (bf16_t*)WSP(WS_H); const float* ada_l = (const float*)WSP(WS_ADA) + (size_t)l * 8 * 6144;
            const int gw = bx * 8 + wid, NGW = G * 8; const float* lg = INP(13) + l * DM; const float* lb = INP(14) + l * DM;
            for (int m = gw; m < NTOK; m += NGW) { const int b = m >> 12; const float* ad = ada_l + (size_t)b * 6144;
                const f32x4* xr = (const f32x4*)(VB + (size_t)m * DM) + lane; f32x4 v[4]; float s = 0.f;
#pragma unroll
                for (int j = 0; j < 4; ++j) { v[j] = xr[64 * j]; s += (v[j][0] + v[j][1]) + (v[j][2] + v[j][3]); }
                const float mean = wave_sum(s) * (1.f / DM); float s2 = 0.f;
#pragma unroll
                for (int j = 0; j < 4; ++j) { v[j] = v[j] - mean; s2 += (v[j][0] * v[j][0] + v[j][1] * v[j][1]) + (v[j][2] * v[j][2] + v[j][3] * v[j][3]); }
                const float rstd = 1.f / sqrtf(wave_sum(s2) * (1.f / DM) + LN_EPS);
                f32x4* xo = (f32x4*)(X1 + (size_t)m * DM) + lane; unsigned long long* o8 = (unsigned long long*)(H + (size_t)m * DM) + lane;
#pragma unroll
                for (int j = 0; j < 4; ++j) { const f32x4 gg = *((const f32x4*)lg + 64 * j + lane), bb = *((const f32x4*)lb + 64 * j + lane);
                    const f32x4 x1 = v[j] * rstd * gg + bb; xo[64 * j] = x1;
                    const f32x4 sh = *((const f32x4*)(ad + 3 * 1024) + 64 * j + lane), sc = *((const f32x4*)(ad + 4 * 1024) + 64 * j + lane);
                    const f32x4 hv = x1 * (sc + 1.f) + sh; o8[64 * j] = (unsigned long long)cvtpk(hv[0], hv[1]) | ((unsigned long long)cvtpk(hv[2], hv[3]) << 32); } }
        }
        GRID_BAR();
        for (int rep = 0; rep < NREP(7); ++rep) if (PH(7)) { LAUNDER_TID
            bf16_t* H = (bf16_t*)WSP(WS_H); bf16_t* WSH = (bf16_t*)WSP(WS_WSH); float* LOG = (float*)WSP(WS_LOG); bf16_t* ACTSH = (bf16_t*)WSP(WS_ACTSH);
            pg8::Gemm g{H, WSH + (size_t)l * 768 * DM, DM}; pg8::StaticOrder S; S.init(NTOK, 768, G, bx);
            pg8::EpiSH E{LOG, ACTSH};
            pg8::gemm_phase<pg8::EpiSH, pg8::StaticOrder>(lds, g, S, E, wid);
        }
        GRID_BAR();
        if (PH(8)) { LAUNDER_TID
            unsigned* ctl = (unsigned*)WSP(WS_CTL); float* LOG = (float*)WSP(WS_LOG); int* DST = (int*)WSP(WS_DST); float* WL = (float*)WSP(WS_WL);
            unsigned* CNT = ctl + CW_CNT + l * 256;
            LAS int* hist = (LAS int*)lds;
            LAS int* basel = (LAS int*)(lds + 1024);
            LAS int* asg_e = (LAS int*)(lds + 2048);
            LAS int* asg_r = (LAS int*)(lds + 2048 + 4096);
            LAS float* asg_w = (LAS float*)(lds + 2048 + 8192);
            const float* rb = INP(18) + l * 256;
            for (int chunk = bx; chunk < NTOK / 128; chunk += G) {
                for (int u = tid; u < 256; u += 512) hist[u] = 0;
                __syncthreads();
                for (int ti = 0; ti < 16; ++ti) { const int tl = wid * 16 + ti, n = chunk * 128 + tl;
                    const f32x4 lg = *((const f32x4*)(LOG + (size_t)n * 256) + lane); const f32x4 rbv = *((const f32x4*)rb + lane);
                    float sc[4], ch[4];
#pragma unroll
                    for (int i = 0; i < 4; ++i) { sc[i] = sigmoidf_(lg[i]); ch[i] = sc[i] + rbv[i]; }
                    float m1 = fmaxf(ch[0], ch[1]), m2 = fminf(ch[0], ch[1]);
                    { const float a1 = fmaxf(ch[2], ch[3]), a2 = fminf(ch[2], ch[3]); const float n1 = fmaxf(m1, a1), n2 = fmaxf(fminf(m1, a1), fmaxf(m2, a2)); m1 = n1; m2 = n2; }
#pragma unroll
                    for (int o = 1; o < 8; o <<= 1) { const float b1 = __shfl_xor(m1, o), b2 = __shfl_xor(m2, o); const float n1 = fmaxf(m1, b1), n2 = fmaxf(fminf(m1, b1), fmaxf(m2, b2)); m1 = n1; m2 = n2; }
                    const float gs = m1 + m2; const int grp = lane >> 3; int grank = 0;
#pragma unroll
                    for (int jg = 0; jg < 8; ++jg) { const float o = __shfl(gs, 8 * jg); grank += ((o > gs) || (o == gs && jg < grp)) ? 1 : 0; }
                    const bool gsel = grank < 4;
                    float val[4];
#pragma unroll
                    for (int i = 0; i < 4; ++i) val[i] = gsel ? ch[i] : -1e30f;
                    float wsum_ = 0.f; int my_e = 0; float my_s = 0.f;
#pragma unroll
                    for (int k = 0; k < 8; ++k) {
                        float bv = val[0]; int bi = 4 * lane; float bsc = sc[0];
#pragma unroll
                        for (int i = 1; i < 4; ++i) if (val[i] > bv) { bv = val[i]; bi = 4 * lane + i; bsc = sc[i]; }
#pragma unroll
                        for (int o = 1; o < 64; o <<= 1) { const float ov = __shfl_xor(bv, o); const int oi = __shfl_xor(bi, o); const float os = __shfl_xor(bsc, o);
                            if (ov > bv || (ov == bv && oi < bi)) { bv = ov; bi = oi; bsc = os; } }
                        if ((bi >> 2) == lane) {
#pragma unroll
                            for (int i = 0; i < 4; ++i) if ((bi & 3) == i) val[i] = -3e38f; }
                        wsum_ += bsc; if (lane == k) { my_e = bi; my_s = bsc; }
                    }
                    if (lane < 8) { const int rk = __hip_atomic_fetch_add(&hist[my_e], 1, __ATOMIC_RELAXED, __HIP_MEMORY_SCOPE_WORKGROUP); asg_e[tl * 8 + lane] = my_e; asg_r[tl * 8 + lane] = rk; asg_w[tl * 8 + lane] = my_s / wsum_ * 2.5f; }
                }
                __syncthreads();
                if (tid < 256) { const int c = hist[tid]; basel[tid] = c ? (int)atomicAdd(&CNT[tid], (unsigned)c) : 0; }
                __syncthreads();
                for (int u = tid; u < 1024; u += 512) { const int e = asg_e[u]; const int pos = basel[e] + asg_r[u]; DST[(size_t)e * NTOK + pos] = (chunk * 128) * 8 + u; WL[(size_t)e * NTOK + pos] = asg_w[u]; }
                __syncthreads();
            }
        }
        GRID_BAR();
        for (int rep = 0; rep < NREP(9); ++rep) if (PH(9)) { LAUNDER_TID
            unsigned* ctl = (unsigned*)WSP(WS_CTL); bf16_t* H = (bf16_t*)WSP(WS_H); bf16_t* WGU = (bf16_t*)WSP(WS_WGU); int* DST = (int*)WSP(WS_DST); bf16_t* ACT = (bf16_t*)WSP(WS_ACT);
            const unsigned* CNT = ctl + CW_CNT + l * 256;
            if (tid < 256) CNTL[tid] = (int)__hip_atomic_load(CNT + tid, __ATOMIC_RELAXED, __HIP_MEMORY_SCOPE_AGENT);
            __syncthreads();
            if (tid == 0) { int s = 0; for (int e = 0; e < 256; ++e) { TP[e] = s; s += (CNTL[e] + 255) >> 8; } TP[256] = s; }
            __syncthreads();
            pg8::Gemm g{H, WGU + (size_t)l * NEXP * 512 * DM, DM};
            pg8::GroupedOrder<true> S{TP, CNTL, 2, G, bx, DST};
            pg8::EpiGU E{ACT};
            pg8::gemm_phase<pg8::EpiGU, pg8::GroupedOrder<true>>(lds, g, S, E, wid);
        }
        GRID_BAR();
        for (int rep = 0; rep < NREP(10); ++rep) if (PH(10)) { LAUNDER_TID
            bf16_t* ACTSH = (bf16_t*)WSP(WS_ACTSH); bf16_t* WSD = (bf16_t*)WSP(WS_WSD); bf16_t* YSH = (bf16_t*)WSP(WS_YSH); bf16_t* ACT = (bf16_t*)WSP(WS_ACT); bf16_t* WD = (bf16_t*)WSP(WS_WD); bf16_t* YB = (bf16_t*)WSP(WS_YB); int* DST = (int*)WSP(WS_DST); float* WL = (float*)WSP(WS_WL);
            if (PH(12)) { pg8::Gemm g{ACTSH, WSD + (size_t)l * DM * 256, 256}; pg8::StaticOrder S; S.init(NTOK, DM, G, bx);
              pg8::EpiShDown E{YSH};
              pg8::gemm_phase<pg8::EpiShDown, pg8::StaticOrder>(lds, g, S, E, wid); }
            if (PH(13)) { pg8::Gemm g{ACT, WD + (size_t)l * NEXP * DM * 256, 256};
              pg8::GroupedOrder<false> S{TP, CNTL, 4, G, bx, nullptr};
              pg8::EpiDown E{YB, DST, WL};
              pg8::gemm_phase<pg8::EpiDown, pg8::GroupedOrder<false>>(lds, g, S, E, wid); }
        }
        GRID_BAR();
        for (int rep = 0; rep < NREP(11); ++rep) if (PH(11)) { LAUNDER_TID
            bf16_t* YSH = (bf16_t*)WSP(WS_YSH); bf16_t* YB = (bf16_t*)WSP(WS_YB); float* X1 = (float*)WSP(WS_X1); float* OUT = OUTP; bf16_t* H = (bf16_t*)WSP(WS_H); float* ADA = (float*)WSP(WS_ADA); const float* ada_l = (const float*)WSP(WS_ADA) + (size_t)l * 8 * 6144;
            const int gw = bx * 8 + wid, NGW = G * 8; const float* lg = INP(15) + l * DM; const float* lb = INP(16) + l * DM;
            for (int m = gw; m < NTOK; m += NGW) { const int b = m >> 12; const float* ad = ada_l + (size_t)b * 6144;
                f32x4 v[4]; float s = 0.f;
#pragma unroll
                for (int j = 0; j < 4; ++j) { const int c0 = 256 * j + 4 * lane;
                    f32x4 y; { const u32x2 t = *(const u32x2*)(YSH + (size_t)m * DM + c0); y[0] = __uint_as_float(t.x << 16); y[1] = __uint_as_float(t.x & 0xffff0000u); y[2] = __uint_as_float(t.y << 16); y[3] = __uint_as_float(t.y & 0xffff0000u); }
#pragma unroll
                    for (int k = 0; k < 8; ++k) { const u32x2 t = *(const u32x2*)(YB + ((size_t)m * 8 + k) * DM + c0);
                        y[0] += __uint_as_float(t.x << 16); y[1] += __uint_as_float(t.x & 0xffff0000u); y[2] += __uint_as_float(t.y << 16); y[3] += __uint_as_float(t.y & 0xffff0000u); }
                    const f32x4 x1 = *((const f32x4*)(X1 + (size_t)m * DM) + 64 * j + lane); const f32x4 g2 = *((const f32x4*)(ad + 5 * 1024) + 64 * j + lane);
                    v[j] = x1 * ALPHA + (g2 + 1.f) * y; s += (v[j][0] + v[j][1]) + (v[j][2] + v[j][3]); }
                const float mean = wave_sum(s) * (1.f / DM); float s2 = 0.f;
#pragma unroll
                for (int j = 0; j < 4; ++j) { v[j] = v[j] - mean; s2 += (v[j][0] * v[j][0] + v[j][1] * v[j][1]) + (v[j][2] * v[j][2] + v[j][3] * v[j][3]); }
                const float rstd = 1.f / sqrtf(wave_sum(s2) * (1.f / DM) + LN_EPS);
                f32x4* xo = (f32x4*)(OUT + (size_t)m * DM) + lane; unsigned long long* o8 = (unsigned long long*)(H + (size_t)m * DM) + lane;
                const float* adn = ADA + ((size_t)(l + 1) * 8 + b) * 6144;
#pragma unroll
                for (int j = 0; j < 4; ++j) { const f32x4 gg = *((const f32x4*)lg + 64 * j + lane), bb = *((const f32x4*)lb + 64 * j + lane);
                    const f32x4 xn = v[j] * rstd * gg + bb; xo[64 * j] = xn;
                    if (l + 1 < DEPTH) { const f32x4 sh = *((const f32x4*)(adn) + 64 * j + lane), sc = *((const f32x4*)(adn + 1024) + 64 * j + lane);
                        const f32x4 hv = xn * (sc + 1.f) + sh; o8[64 * j] = (unsigned long long)cvtpk(hv[0], hv[1]) | ((unsigned long long)cvtpk(hv[2], hv[3]) << 32); } } }
        }
        if (l + 1 < DEPTH) GRID_BAR();
    }
}

extern "C" void kernel_launch(void* const* d_in, const int* in_sizes, int n_in, void* d_out, int out_size, void* d_ws, size_t ws_size, hipStream_t stream) {
    static int grid = 0;
    if (grid == 0) {
        if (n_in != 25 || out_size != NTOK * DM || ws_size < WS_END) { fprintf(stderr, "kernel_launch: unexpected shapes (n_in %d, out %d, ws %zu)\n", n_in, out_size, ws_size); grid = -1; return; }
        int dev = 0, cus = 0;
        if (hipGetDevice(&dev) != hipSuccess || hipDeviceGetAttribute(&cus, hipDeviceAttributeMultiprocessorCount, dev) != hipSuccess) { grid = -1; return; }
        if (hipFuncSetAttribute((const void*)mega_fwd, hipFuncAttributeMaxDynamicSharedMemorySize, LDS_BYTES) != hipSuccess) { fprintf(stderr, "kernel_launch: hipFuncSetAttribute failed\n"); grid = -1; return; }
        int per_cu = 0;
        if (hipOccupancyMaxActiveBlocksPerMultiprocessor(&per_cu, (const void*)mega_fwd, 512, LDS_BYTES) != hipSuccess || per_cu < 1) fprintf(stderr, "kernel_launch: occupancy query says %d\n", per_cu);
        (void)hipGetLastError();
        grid = cus;
    }
    if (grid < 0) return;
    if (hipMemsetAsync((char*)d_ws + WS_CTL, 0, CTL_BYTES, stream) != hipSuccess) return;
    Args a{};
    for (int i = 0; i < 25; ++i) a.in[i] = (const float*)d_in[i];
    a.out = (float*)d_out; a.ws = (unsigned char*)d_ws;
    hipLaunchKernelGGL(mega_fwd, dim3(grid), dim3(512), LDS_BYTES, stream, a);
}
```

```cpp
#include <hip/hip_runtime.h>
#include <cstdio>
#include <cstdint>

#define DI __device__ __forceinline__
#define LAS __attribute__((address_space(3)))
#define GAS __attribute__((address_space(1)))
typedef unsigned short bf16_t;
typedef short bf16x8 __attribute__((ext_vector_type(8)));
typedef short s16x4 __attribute__((ext_vector_type(4)));
typedef float f32x2 __attribute__((ext_vector_type(2)));
typedef float f32x4 __attribute__((ext_vector_type(4)));
typedef float f32x16 __attribute__((ext_vector_type(16)));
typedef unsigned u32x2 __attribute__((ext_vector_type(2)));
typedef unsigned u32x4 __attribute__((ext_vector_type(4)));

constexpr int DM = 1024, NB = 8, SEQ = 4096, NTOK = NB * SEQ, DEPTH = 2;
constexpr int D_IN = 2450, QKV_N = 2560;
constexpr int NEXP = 256, TOPK = 8, EDIM = 256;
constexpr float LOG2E = 1.4426950408889634f;
constexpr float C2 = 0.125f * LOG2E;
constexpr float ALPHA = 1.4142135623730951f;
constexpr float LN_EPS = 1e-5f;
constexpr int C_AQ = 0, C_AK = 384, C_AV = 512, C_BQ = 640, C_BKC = 896, C_BVC = 960, C_BKS = 1024, C_BVS = 1088, C_BKW = 1152, C_BVW = 1216,
              C_CQ = 1280, C_CK = 1664, C_CV = 2048, C_SM = 2432;
constexpr int O_A = 0, O_B = 384, O_C = 640;

constexpr size_t MiB = 1u << 20;
constexpr size_t WS_CTL = 0, CTL_BYTES = 1 * MiB;
constexpr size_t WS_ADA = 1 * MiB;
constexpr size_t WS_CPOS = WS_ADA + 512 * 1024;
constexpr size_t WS_KCMP = 2 * MiB;
constexpr size_t WS_VCMP = WS_KCMP + 256 * 1024;
constexpr size_t WS_DC = 3 * MiB;
constexpr size_t WS_KM = 3 * MiB + 832 * 1024;
constexpr size_t WS_WCT = 4 * MiB;
constexpr size_t WS_WIN = 8 * MiB;
constexpr size_t WS_WO = 18 * MiB;
constexpr size_t WS_WSH = 22 * MiB;
constexpr size_t WS_WSD = 25 * MiB;
constexpr size_t WS_WGU = 32 * MiB;
constexpr size_t WS_WD = 544 * MiB;
constexpr size_t WS_H = 800 * MiB;
constexpr size_t WS_X1 = 864 * MiB;
constexpr size_t WS_LOG = 992 * MiB;
constexpr size_t WS_ACTSH = 1024 * MiB;
constexpr size_t WS_YSH = 1040 * MiB;
constexpr size_t WS_DST = 1104 * MiB;
constexpr size_t WS_WL = 1136 * MiB;
constexpr size_t WS_SMALL = 1168 * MiB;
constexpr size_t WS_ACT = 1172 * MiB;
constexpr size_t WS_R1 = 1332 * MiB;
constexpr size_t WS_QKV = WS_R1;
constexpr size_t WS_O = WS_R1 + 160 * MiB;
constexpr size_t WS_V = WS_R1 + 224 * MiB;
constexpr size_t WS_YB = WS_R1;
constexpr size_t WS_END = 1844 * MiB;

constexpr int CW_BAR = 4096;
constexpr int CW_Q = 16384;
constexpr int CW_CNT = 32768;

constexpr int RING_BYTES = 131072;
constexpr int L_MISC = RING_BYTES;
constexpr int L_LUT = L_MISC + 256;
constexpr int L_TP = L_LUT + 5120;
constexpr int L_CNT = L_TP + 1040;
constexpr int L_PT = L_CNT + 1024;
constexpr int LDS_BYTES = 147456;
static_assert(L_PT + 256 <= LDS_BYTES, "LDS map");

DI unsigned cvtpk(float lo, float hi) { typedef __bf16 b2 __attribute__((ext_vector_type(2))); f32x2 v = {lo, hi}; b2 b = __builtin_convertvector(v, b2); return __builtin_bit_cast(unsigned, b); }
DI float bf2f(bf16_t v) { return __uint_as_float((unsigned)v << 16); }
DI float fast_exp2(float x) { return __builtin_amdgcn_exp2f(x); }
DI float sigmoidf_(float x) { return 1.f / (1.f + __expf(-x)); }
DI float siluf_(float x) { return x / (1.f + __expf(-x)); }

#define XB_TMO      128
#define XB_XCNT(j)  (256  + 64 * (j))
#define XB_XSUB(j)  (1280 + 64 * (j))
#define XB_XGEN(j)  (2304 + 64 * (j))
#define XB_TOP      3328
#define XB_TOPGEN   3392
#define XCD_BAR_WORDS 3456
#define XB_SPIN_CAP (1u << 22)

__device__ __forceinline__ unsigned xb_ld(unsigned* p)              { return __hip_atomic_load(p, __ATOMIC_RELAXED, __HIP_MEMORY_SCOPE_AGENT); }
__device__ __forceinline__ unsigned xb_add(unsigned* p, unsigned v) { return __hip_atomic_fetch_add(p, v, __ATOMIC_RELAXED, __HIP_MEMORY_SCOPE_AGENT); }
__device__ __forceinline__ unsigned xb_xcc_id() { return (unsigned)__builtin_amdgcn_s_getreg((3 << 11) | 20) & 0xFu; }
#define XB_SPIN(cond, bar) do { unsigned _sp = 0; while (cond) { __builtin_amdgcn_s_sleep(1); \
    if ((++_sp & 255u) == 0u) { if (xb_ld(&(bar)[XB_TMO])) break; if (_sp > XB_SPIN_CAP) { atomicAdd(&(bar)[XB_TMO], 1u); break; } } } } while (0)

struct XcdBarrier { unsigned* bar; unsigned x; volatile LAS unsigned* st; };

__device__ __forceinline__ XcdBarrier xcd_barrier_post(unsigned* bar, volatile LAS unsigned* st) {
    XcdBarrier b; b.bar = bar; b.x = xb_xcc_id(); b.st = st;
    if (threadIdx.x == 0) (void)xb_add(&bar[XB_XCNT(b.x)], 1u);
    return b;
}
__device__ __forceinline__ void xcd_barrier_complete(unsigned* bar, unsigned x, unsigned& nloc, unsigned& nx) {
    const unsigned G = gridDim.x * gridDim.y * gridDim.z;
    unsigned sum, cnt, mine, sp = 0u;
    for (;;) {
        sum = 0u; cnt = 0u; mine = 0u;
#pragma unroll
        for (unsigned j = 0; j < 16; ++j) { const unsigned c = xb_ld(&bar[XB_XCNT(j)]); sum += c; cnt += (c > 0u) ? 1u : 0u; mine = (j == x) ? c : mine; }
        if (sum == G) break;
        __builtin_amdgcn_s_sleep(1);
        if ((++sp & 255u) == 0u) { if (xb_ld(&bar[XB_TMO])) break; if (sp > XB_SPIN_CAP) { atomicAdd(&bar[XB_TMO], 1u); break; } }
    }
    nloc = mine > 0u ? mine : 1u; nx = cnt > 0u ? cnt : 1u;
}
__device__ __forceinline__ void xcd_barrier(const XcdBarrier& b, bool leader_thread) {
    asm volatile("s_waitcnt vmcnt(0)" ::: "memory");
    __syncthreads();
    if (leader_thread) {
        unsigned* bar = b.bar;
        __builtin_amdgcn_s_waitcnt(0);
        unsigned nloc = b.st[0], nx = b.st[1];
        if (nloc == 0u) { xcd_barrier_complete(bar, b.x, nloc, nx); b.st[0] = nloc; b.st[1] = nx; }
        const unsigned old = xb_add(&bar[XB_XSUB(b.x)], 1u);
        const unsigned gen = old / nloc;
        if (old + 1u == (gen + 1u) * nloc) {
            __builtin_amdgcn_fence(__ATOMIC_RELEASE, "agent");
            asm volatile("s_waitcnt vmcnt(0)" ::: "memory");
            const unsigned og = xb_add(&bar[XB_TOP], 1u);
            const unsigned tg = og / nx;
            if (og + 1u == (tg + 1u) * nx) xb_add(&bar[XB_TOPGEN], 1u);
            else XB_SPIN(xb_ld(&bar[XB_TOPGEN]) == tg, bar);
            __builtin_amdgcn_fence(__ATOMIC_ACQUIRE, "agent");
            xb_add(&bar[XB_XGEN(b.x)], 1u);
            asm volatile("s_waitcnt vmcnt(0)" ::: "memory");
        } else {
            XB_SPIN(xb_ld(&bar[XB_XGEN(b.x)]) == gen, bar);
            __builtin_amdgcn_fence(__ATOMIC_ACQUIRE, "agent");
            asm volatile("s_waitcnt vmcnt(0)" ::: "memory");
        }
    }
    __syncthreads();
}

namespace pg8 {
constexpr int BM = 256, BK = 64, HALF = 128, HTB = HALF * BK * 2, STAGE_BYTES = 8 * HTB, NXCD = 8, WGM = 8;
__host__ __device__ __forceinline__ int lds_byte(int r, int c) { const int st = (r >> 4) * 2 + (c >> 5), rr = r & 15, cc = c & 31, ob = rr * 64 + cc * 2; return st * 1024 + (ob ^ (((ob >> 9) & 1) << 5)); }
__host__ __device__ __forceinline__ void stage_rc(int b, int& R, int& C) { const int st = b / 1024, sb = b % 1024, swz = sb ^ (((sb >> 9) & 1) << 5); R = (st >> 1) * 16 + swz / 64; C = (st & 1) * 32 + (swz % 64) / 2; }
__host__ __device__ __forceinline__ int perm32(int rho) { const int n = rho >> 4, i = rho & 15; return 8 * (i >> 2) + 4 * n + (i & 3); }

struct Unit { int pm, pn, e, lrow0, cnt; };
struct Gemm { const bf16_t* A; const bf16_t* Bt; int K; };

struct StaticOrder {
    int nM, nN, nwg, G, c;
    DI void init(int M, int N, int G_, int c_) { nM = M / BM; nN = N / BM; nwg = nM * nN; G = G_; c = c_; }
    DI bool next(int i, Unit& u) const {
        const long L = (long)i * G + c; if (L >= nwg) return false;
        int wgid = (int)L; { const int q = nwg / NXCD, r = nwg % NXCD, xcd = wgid % NXCD, off = wgid / NXCD; wgid = (xcd < r ? xcd * (q + 1) : r * (q + 1) + (xcd - r) * q) + off; }
        const int nig = WGM * nN, gid = wgid / nig, fm = gid * WGM, gsz = (nM - fm) < WGM ? (nM - fm) : WGM;
        u.pm = fm + ((wgid % nig) % gsz); u.pn = (wgid % nig) / gsz; u.e = 0; u.lrow0 = 0; u.cnt = 0; return true;
    }
    static constexpr bool GATHER = false;
    DI unsigned tokpair(const Unit&, int, int) const { return 0u; }
};
template <bool GATHER_> struct GroupedOrder {
    static constexpr bool GATHER = GATHER_;
    const LAS int* TP; const LAS int* CNT; int NT, G, c; const int* list;
    DI bool next(int i, Unit& u) const {
        const int total = TP[256] * NT; const int L = i * G + c; if (L >= total) return false;
        const int mt = L / NT, nt = L - mt * NT;
        int lo = 0, hi = 255;
        while (lo < hi) { const int mid = (lo + hi + 1) >> 1; if (TP[mid] <= mt) lo = mid; else hi = mid - 1; }
        u.pm = __builtin_amdgcn_readfirstlane(mt); u.pn = __builtin_amdgcn_readfirstlane(lo * NT + nt); u.e = __builtin_amdgcn_readfirstlane(lo);
        u.lrow0 = __builtin_amdgcn_readfirstlane((mt - TP[lo]) * BM); u.cnt = __builtin_amdgcn_readfirstlane(CNT[lo]); return true;
    }
    DI unsigned tokpair(const Unit& u, int R0, int) const {
        int l0 = u.lrow0 + R0, l1 = l0 + HALF; l0 = l0 < u.cnt ? l0 : u.cnt - 1; l1 = l1 < u.cnt ? l1 : u.cnt - 1;
        const unsigned t0 = (unsigned)(list[u.e * NTOK + l0] >> 3), t1 = (unsigned)(list[u.e * NTOK + l1] >> 3); return t0 | (t1 << 16);
    }
};

template <class Epi, class Sched>
__device__ __forceinline__ void gemm_phase(LAS unsigned char* lds, const Gemm g, const Sched& S, const Epi& E, int wid_) {
    int lane; asm volatile("v_mbcnt_lo_u32_b32 %0, -1, 0\n\tv_mbcnt_hi_u32_b32 %0, -1, %0" : "=v"(lane));
    int wid = wid_; asm volatile("" : "+s"(wid)); const int tid = wid * 64 + lane, wr = wid >> 2, wc = wid & 3, fr = lane & 15, fq = lane >> 4;
    const int K = g.K, nt = K / BK;
    constexpr bool GA = Sched::GATHER;
    unsigned voffA[2], voffB[2]; int RA[2];
#pragma unroll
    for (int i = 0; i < 2; ++i) { int R, C; stage_rc(tid * 16 + i * 8192, R, C); const int Rb = Epi::PERM ? ((R & ~31) + perm32(R & 31)) : R;
        RA[i] = R; voffA[i] = GA ? (unsigned)(C * 2) : (unsigned)(R * K + C) * 2u; voffB[i] = (unsigned)(Rb * K + C) * 2u; }
    const size_t kstep = (size_t)(BK * 2);
    const size_t hstep = (size_t)HALF * K * 2;
    const size_t tstep = 2 * hstep;
    const unsigned ldsw = (unsigned)wid * 1024u;
    const int aoff = lds_byte(wr * 64 + fr, fq * 8), boff = lds_byte(wc * 32 + fr, fq * 8);
#define PG8_SA(b, h) (((b) * 2 + (h)) * HTB)
#define PG8_SB(b, h) ((4 + (b) * 2 + (h)) * HTB)
#define PG8_STAGE(bufoff, gbase, voff) do { _Pragma("unroll") for (int _i = 0; _i < 2; ++_i) \
        __builtin_amdgcn_global_load_lds((const unsigned*)((const char*)(gbase) + (voff)[_i]), (LAS unsigned*)(lds + (bufoff) + ldsw + _i * 8192), 16, 0, 0); } while (0)
#define PG8_STAGEA(bufoff, ubase, tp, hh, kb) do { _Pragma("unroll") for (int _i = 0; _i < 2; ++_i) { \
        const char* _p = GA ? ((const char*)g.A + (size_t)(kb) + (size_t)((((tp)[_i] >> (16 * (hh))) & 0xffffu) * (unsigned)(K * 2)) + voffA[_i]) : ((ubase) + (size_t)(hh) * hstep + (size_t)(kb) + voffA[_i]); \
        __builtin_amdgcn_global_load_lds((const unsigned*)_p, (LAS unsigned*)(lds + (bufoff) + ldsw + _i * 8192), 16, 0, 0); } } while (0)
#define PG8_LDA(dst, b, h) do { _Pragma("unroll") for (int m = 0; m < 4; ++m) _Pragma("unroll") for (int k = 0; k < 2; ++k) dst[m][k] = *(const LAS bf16x8*)(lds + PG8_SA(b, h) + aoff + m * 2048 + k * 1024); } while (0)
#define PG8_LDB(dst, b, h) do { _Pragma("unroll") for (int n = 0; n < 2; ++n) _Pragma("unroll") for (int k = 0; k < 2; ++k) dst[n][k] = *(const LAS bf16x8*)(lds + PG8_SB(b, h) + boff + n * 2048 + k * 1024); } while (0)
#define PG8_MMA(ai, bj, At, Bt) do { __builtin_amdgcn_s_setprio(1); _Pragma("unroll") for (int m = 0; m < 4; ++m) _Pragma("unroll") for (int n = 0; n < 2; ++n) _Pragma("unroll") for (int k = 0; k < 2; ++k) \
        acc[ai][bj][m][n] = __builtin_amdgcn_mfma_f32_16x16x32_bf16(Bt[n][k], At[m][k], acc[ai][bj][m][n], 0, 0, 0); __builtin_amdgcn_s_setprio(0); } while (0)
#define PG8_WAIT_V(n) asm volatile("s_waitcnt vmcnt(" #n ")" ::: "memory")
#define PG8_WAIT_L(n) asm volatile("s_waitcnt lgkmcnt(" #n ")" ::: "memory")
#define PG8_BAR __builtin_amdgcn_s_barrier()
#define PG8_SCHED __builtin_amdgcn_sched_barrier(0)
    Unit cur, nxt; int ui = 0;
    if (!S.next(0, cur)) return;
    f32x4 acc[2][2][4][2];
#pragma unroll
    for (int a = 0; a < 2; ++a)
#pragma unroll
        for (int b = 0; b < 2; ++b)
#pragma unroll
            for (int m = 0; m < 4; ++m)
#pragma unroll
                for (int n = 0; n < 2; ++n) acc[a][b][m][n] = (f32x4){0.f, 0.f, 0.f, 0.f};
    bf16x8 At[4][2], B0[2][2], B1[2][2];
    unsigned tpc[2] = {0u, 0u}, tpn[2] = {0u, 0u};
    if (GA) {
#pragma unroll
        for (int i = 0; i < 2; ++i) tpc[i] = S.tokpair(cur, RA[i], 0); }
#define PG8_FRESH_R(i, Rv) int Rv; { int l2_; asm volatile("v_mbcnt_lo_u32_b32 %0, -1, 0\n\tv_mbcnt_hi_u32_b32 %0, -1, %0" : "=v"(l2_)); int C2_; stage_rc((wid * 64 + l2_) * 16 + (i) * 8192, Rv, C2_); }
    const char* cA = GA ? (const char*)g.A : (const char*)g.A + (size_t)cur.pm * tstep; const char* cB = (const char*)g.Bt + (size_t)cur.pn * tstep;
    {
        PG8_STAGE(PG8_SB(0, 0), cB, voffB); PG8_STAGE(PG8_SB(0, 1), cB + hstep, voffB); PG8_STAGEA(PG8_SA(0, 0), cA, tpc, 0, 0); PG8_STAGEA(PG8_SA(0, 1), cA, tpc, 1, 0);
        if (wr == 1) PG8_BAR;
        PG8_WAIT_V(2); PG8_BAR;
        PG8_STAGE(PG8_SB(1, 0), cB + kstep, voffB); PG8_STAGEA(PG8_SA(1, 0), cA, tpc, 0, kstep); PG8_STAGE(PG8_SB(1, 1), cB + hstep + kstep, voffB);
        PG8_WAIT_V(6); PG8_BAR;
    }
    for (;;) {
        const bool has_next = S.next(ui + 1, nxt);
        const char* nA = GA ? cA : (has_next ? (const char*)g.A + (size_t)nxt.pm * tstep : cA); const char* nB = has_next ? (const char*)g.Bt + (size_t)nxt.pn * tstep : cB;
        if (GA) {
#pragma unroll
            for (int i = 0; i < 2; ++i) { if (has_next) { PG8_FRESH_R(i, Rn_); tpn[i] = S.tokpair(nxt, Rn_, 0); } else tpn[i] = tpc[i]; } }
#pragma unroll 1
        for (int t = 0; t < nt; t += 2) {
            const bool last = (t == nt - 2);
            const size_t k1 = (size_t)(t + 1) * kstep;
            const size_t k2 = last ? 0 : (size_t)(t + 2) * kstep; const size_t k3 = k2 + kstep;
            const char* a2 = last ? nA : cA;
            unsigned tp2[2];
#pragma unroll
            for (int i = 0; i < 2; ++i) tp2[i] = last ? tpn[i] : tpc[i];
            const char* b2 = last ? nB : cB + (size_t)(t + 2) * kstep;
            const char* b3 = b2 + kstep;
            PG8_LDB(B0, 0, 0); PG8_LDB(B1, 0, 1); PG8_SCHED; PG8_LDA(At, 0, 0); PG8_STAGEA(PG8_SA(1, 1), cA, tpc, 1, k1);
            PG8_WAIT_V(8); PG8_WAIT_L(0); PG8_BAR; PG8_MMA(0, 0, At, B0); PG8_MMA(0, 1, At, B1); PG8_BAR; PG8_SCHED;
            PG8_LDA(At, 0, 1); PG8_STAGE(PG8_SB(0, 0), b2, voffB); PG8_STAGE(PG8_SB(0, 1), b2 + hstep, voffB); PG8_STAGEA(PG8_SA(0, 0), a2, tp2, 0, k2);
            PG8_WAIT_V(8); PG8_WAIT_L(0); PG8_BAR; PG8_MMA(1, 0, At, B0); PG8_MMA(1, 1, At, B1); PG8_BAR; PG8_SCHED;
            PG8_LDB(B0, 1, 0); PG8_LDB(B1, 1, 1); PG8_SCHED; PG8_LDA(At, 1, 0); PG8_STAGEA(PG8_SA(0, 1), a2, tp2, 1, k2);
            PG8_WAIT_V(8); PG8_WAIT_L(0); PG8_BAR; PG8_MMA(0, 0, At, B0); PG8_MMA(0, 1, At, B1); PG8_BAR; PG8_SCHED;
            PG8_LDA(At, 1, 1); PG8_STAGE(PG8_SB(1, 0), b3, voffB); PG8_STAGE(PG8_SB(1, 1), b3 + hstep, voffB); PG8_STAGEA(PG8_SA(1, 0), a2, tp2, 0, k3);
            PG8_WAIT_V(8); PG8_WAIT_L(0); PG8_BAR; PG8_MMA(1, 0, At, B0); PG8_MMA(1, 1, At, B1); PG8_BAR; PG8_SCHED;
        }
        if (wr == 0) PG8_BAR;
        E(acc, cur, wr, wc, fr, fq);
        if (!has_next) break;
#pragma unroll
        for (int a = 0; a < 2; ++a)
#pragma unroll
            for (int b = 0; b < 2; ++b)
#pragma unroll
                for (int m = 0; m < 4; ++m)
#pragma unroll
                    for (int n = 0; n < 2; ++n) acc[a][b][m][n] = (f32x4){0.f, 0.f, 0.f, 0.f};
        cur = nxt; cA = nA; cB = nB; ++ui;
#pragma unroll
        for (int i = 0; i < 2; ++i) tpc[i] = tpn[i];
        if (wr == 1) PG8_BAR;
    }
    PG8_WAIT_V(0);
    PG8_BAR;
#undef PG8_SA
#undef PG8_SB
#undef PG8_STAGE
#undef PG8_STAGEA
#undef PG8_FRESH_R
#undef PG8_LDA
#undef PG8_LDB
#undef PG8_MMA
#undef PG8_WAIT_V
#undef PG8_WAIT_L
#undef PG8_BAR
#undef PG8_SCHED
}

DI u32x4 pack8(const f32x4& v0, const f32x4& v1) { u32x4 w; w.x = cvtpk(v0[0], v0[1]); w.y = cvtpk(v0[2], v0[3]); w.z = cvtpk(v1[0], v1[1]); w.w = cvtpk(v1[2], v1[3]); return w; }

struct EpiQKV { static constexpr bool PERM = true;
    bf16_t* O; float* SM;
    DI void operator()(const f32x4 (&acc)[2][2][4][2], const Unit& u, int wr, int wc, int fr, int fq) const {
        const int row0 = u.pm * BM + wr * 64 + fr, colt = u.pn * BM + wc * 32 + 8 * fq;
#pragma unroll
        for (int bj = 0; bj < 2; ++bj) { const int col = colt + bj * HALF;
            const bool isq = (col < C_AK) || (col >= C_BQ && col < C_BKC) || (col >= C_CQ && col < C_CK);
            const float sc = isq ? C2 : 1.f; const bool sm = (col >= C_SM && col < C_SM + 32);
#pragma unroll
            for (int ai = 0; ai < 2; ++ai)
#pragma unroll
                for (int m = 0; m < 4; ++m) { const int row = row0 + ai * HALF + m * 16;
                    const f32x4 v0 = acc[ai][bj][m][0] * sc, v1 = acc[ai][bj][m][1] * sc;
                    *(u32x4*)(O + (size_t)row * QKV_N + col) = pack8(v0, v1);
                    if (sm) { float* sp = SM + (size_t)row * 32 + (col - C_SM); *(f32x4*)sp = v0; *(f32x4*)(sp + 4) = v1; } } }
    }
};
struct EpiWO { static constexpr bool PERM = false;
    const float* xin; float* V; const float* g1;
    DI void operator()(const f32x4 (&acc)[2][2][4][2], const Unit& u, int wr, int wc, int fr, int fq) const {
        const int row0 = u.pm * BM + wr * 64 + fr, col0 = u.pn * BM + wc * 32 + 4 * fq; const int b = (u.pm * BM) >> 12;
#pragma unroll
        for (int bj = 0; bj < 2; ++bj)
#pragma unroll
            for (int n = 0; n < 2; ++n) { const int col = col0 + bj * HALF + n * 16; const f32x4 gg = *(const f32x4*)(g1 + (size_t)b * 6144 + col) + 1.f;
#pragma unroll
                for (int ai = 0; ai < 2; ++ai)
#pragma unroll
                    for (int m = 0; m < 4; ++m) { const size_t off = (size_t)(row0 + ai * HALF + m * 16) * DM + col;
                        const f32x4 xv = *(const f32x4*)(xin + off); *(f32x4*)(V + off) = xv * ALPHA + gg * acc[ai][bj][m][n]; } }
    }
};
DI f32x4 swiglu4(const f32x4& g, const f32x4& u) { f32x4 r; r[0] = siluf_(g[0]) * u[0]; r[1] = siluf_(g[1]) * u[1]; r[2] = siluf_(g[2]) * u[2]; r[3] = siluf_(g[3]) * u[3]; return r; }
struct EpiSH { static constexpr bool PERM = true;
    float* LOG; bf16_t* ACT;
    DI void operator()(const f32x4 (&acc)[2][2][4][2], const Unit& u, int wr, int wc, int fr, int fq) const {
        const int row0 = u.pm * BM + wr * 64 + fr, c8 = wc * 32 + 8 * fq;
        if (u.pn == 0) {
#pragma unroll
            for (int bj = 0; bj < 2; ++bj)
#pragma unroll
                for (int ai = 0; ai < 2; ++ai)
#pragma unroll
                    for (int m = 0; m < 4; ++m) { float* p = LOG + (size_t)(row0 + ai * HALF + m * 16) * 256 + bj * HALF + c8; *(f32x4*)p = acc[ai][bj][m][0]; *(f32x4*)(p + 4) = acc[ai][bj][m][1]; }
        } else {
            const int cb = (u.pn - 1) * HALF + c8;
#pragma unroll
            for (int ai = 0; ai < 2; ++ai)
#pragma unroll
                for (int m = 0; m < 4; ++m) { const f32x4 a0 = swiglu4(acc[ai][0][m][0], acc[ai][1][m][0]), a1 = swiglu4(acc[ai][0][m][1], acc[ai][1][m][1]);
                    *(u32x4*)(ACT + (size_t)(row0 + ai * HALF + m * 16) * 256 + cb) = pack8(a0, a1); }
        }
    }
};
struct EpiGU { static constexpr bool PERM = true;
    bf16_t* ACT;
    DI void operator()(const f32x4 (&acc)[2][2][4][2], const Unit& u, int wr, int wc, int fr, int fq) const {
        const int rin0 = wr * 64 + fr, cb = (u.pn & 1) * HALF + wc * 32 + 8 * fq;
#pragma unroll
        for (int ai = 0; ai < 2; ++ai)
#pragma unroll
            for (int m = 0; m < 4; ++m) { const int rin = rin0 + ai * HALF + m * 16;
                if (u.lrow0 + rin < u.cnt) { const f32x4 a0 = swiglu4(acc[ai][0][m][0], acc[ai][1][m][0]), a1 = swiglu4(acc[ai][0][m][1], acc[ai][1][m][1]);
                    *(u32x4*)(ACT + (size_t)(u.pm * BM + rin) * 256 + cb) = pack8(a0, a1); } }
    }
};
struct EpiDown { static constexpr bool PERM = true;
    bf16_t* YB; const int* DST; const float* WL;
    DI void operator()(const f32x4 (&acc)[2][2][4][2], const Unit& u, int wr, int wc, int fr, int fq) const {
        const int rin0 = wr * 64 + fr, cb = (u.pn & 3) * BM + wc * 32 + 8 * fq;
#pragma unroll
        for (int ai = 0; ai < 2; ++ai)
#pragma unroll
            for (int m = 0; m < 4; ++m) { const int local = u.lrow0 + rin0 + ai * HALF + m * 16;
                if (local < u.cnt) { const int dst = DST[(size_t)u.e * NTOK + local]; const float w = WL[(size_t)u.e * NTOK + local];
#pragma unroll
                    for (int bj = 0; bj < 2; ++bj) *(u32x4*)(YB + (size_t)dst * DM + cb + bj * HALF) = pack8(acc[ai][bj][m][0] * w, acc[ai][bj][m][1] * w); } }
    }
};
struct EpiShDown { static constexpr bool PERM = true;
    bf16_t* Y;
    DI void operator()(const f32x4 (&acc)[2][2][4][2], const Unit& u, int wr, int wc, int fr, int fq) const {
        const int row0 = u.pm * BM + wr * 64 + fr, cb = u.pn * BM + wc * 32 + 8 * fq;
#pragma unroll
        for (int ai = 0; ai < 2; ++ai)
#pragma unroll
            for (int m = 0; m < 4; ++m)
#pragma unroll
                for (int bj = 0; bj < 2; ++bj) *(u32x4*)(Y + (size_t)(row0 + ai * HALF + m * 16) * DM + cb + bj * HALF) = pack8(acc[ai][bj][m][0], acc[ai][bj][m][1]);
    }
};
}

namespace att {
#define MFMA32(a, b, c) __builtin_amdgcn_mfma_f32_32x32x16_bf16((a), (b), (c), 0, 0, 0)
constexpr int A_KB = 0, A_VB = 16384, A_IMP = 32768, A_SEL = A_IMP + 4 * 64 * 65 * 4  , A_DK = A_SEL + 512, A_NEED = A_DK + 512, A_KM = A_NEED + 64, A_END = A_KM + 512;
static_assert(A_END <= RING_BYTES, "attention LDS");
constexpr float NEGINF = -__builtin_inff();
enum { M_BAND = 0, M_SLC = 1, M_FOX = 2, M_CMP1 = 3, M_CMP2 = 4 };
typedef short v4i16_t __attribute__((ext_vector_type(4)));
DI s16x4 vtr(LAS const char* p) { return __builtin_bit_cast(s16x4, __builtin_amdgcn_ds_read_tr16_b64_v4i16((LAS v4i16_t*)p)); }
DI int cofs(int i) { return (i & 3) + 8 * (i >> 2); }

struct Acc { f32x16 o0, o1; float m, l; };
struct PassArgs {
    const bf16_t* Kg; const bf16_t* Vg; int pitch;
    int jfirst, ntiles, step;
    int tq0;
    const LAS float* lut;
    unsigned long long sel;
    float dq; const float* dkg;
    float qn; const float* km;
    float fm, frl;
    LAS float* imp;
};

DI void qk_tile(f32x16& p0, f32x16& p1, LAS const char* kb, const bf16x8 (&qr)[4], int r, int h) {
#pragma unroll
    for (int i = 0; i < 16; ++i) { p0[i] = 0.f; p1[i] = 0.f; }
    LAS const char* rp = kb + r * 128;
#pragma unroll
    for (int s = 0; s < 4; ++s) { const int o = 16 * ((2 * s + h) ^ (r & 7));
        const bf16x8 a0 = *(const LAS bf16x8*)(rp + o), a1 = *(const LAS bf16x8*)(rp + 4096 + o);
        p0 = MFMA32(a0, qr[s], p0); p1 = MFMA32(a1, qr[s], p1); }
}
DI bf16x8 pack_step(const f32x16& x, int s) { u32x4 p; p.x = cvtpk(x[8 * s], x[8 * s + 1]); p.y = cvtpk(x[8 * s + 2], x[8 * s + 3]); p.z = cvtpk(x[8 * s + 4], x[8 * s + 5]); p.w = cvtpk(x[8 * s + 6], x[8 * s + 7]); return __builtin_bit_cast(bf16x8, p); }
DI void pv_tile(f32x16& o0, f32x16& o1, const f32x16& p0, const f32x16& p1, LAS const char* va0, LAS const char* va1) {
#pragma unroll
    for (int blk = 0; blk < 2; ++blk)
#pragma unroll
        for (int s = 0; s < 2; ++s) { const bf16x8 xs = pack_step(blk ? p1 : p0, s); const int ro = (32 * blk + 16 * s) * 128;
            { const s16x4 lo = vtr(va0 + ro), hi = vtr(va0 + ro + 1024); const bf16x8 vf = __builtin_shufflevector(lo, hi, 0, 1, 2, 3, 4, 5, 6, 7); o0 = MFMA32(vf, xs, o0); }
            { const s16x4 lo = vtr(va1 + ro), hi = vtr(va1 + ro + 1024); const bf16x8 vf = __builtin_shufflevector(lo, hi, 0, 1, 2, 3, 4, 5, 6, 7); o1 = MFMA32(vf, xs, o1); } }
}

template <int MODE, int W>
DI void attn_pass(LAS char* lds, const PassArgs& P, const bf16x8 (&qr)[4], Acc& a, int tid_, int lane_) {
    int lane; asm volatile("v_mbcnt_lo_u32_b32 %0, -1, 0\n\tv_mbcnt_hi_u32_b32 %0, -1, %0" : "=v"(lane)); const int tid = (tid_ & ~63) | lane; (void)lane_;
    const int r = lane & 31, h = lane >> 5;
    const int lrow = tid >> 3, lch = tid & 7;
    const size_t goff = (size_t)lrow * P.pitch + lch * 8;
    const int kdst = lrow * 128 + 16 * (lch ^ (lrow & 7)), vdst = lrow * 128 + 16 * (lch ^ (((lrow >> 1) & 1) << 2));
    const int q4 = (lane & 15) >> 2, p4 = lane & 3, g1 = (lane >> 4) & 1, swb = (q4 >> 1) & 1;
    const int vofs0 = (4 * h + q4) * 128 + 16 * (4 * (0 ^ swb) + 2 * g1 + (p4 >> 1)) + 8 * (p4 & 1);
    const int vofs1 = (4 * h + q4) * 128 + 16 * (4 * (1 ^ swb) + 2 * g1 + (p4 >> 1)) + 8 * (p4 & 1);
    const int tq = P.tq0 + r;
    u32x4 kr, vr;
    { const size_t t0 = (size_t)P.jfirst * 64 * P.pitch + goff; kr = *(const GAS u32x4*)(P.Kg + t0); vr = *(const GAS u32x4*)(P.Vg + t0); }
    f32x4 dkr = {0.f, 0.f, 0.f, 0.f};
    if (MODE == M_FOX) { if (tid < 16) { dkr = *(const GAS f32x4*)(P.dkg + 64 * P.jfirst + 4 * tid); *(LAS f32x4*)(lds + A_DK + 16 * tid) = dkr; } if (tid == 0) { unsigned z_ = 0u; asm volatile("" : "+v"(z_)); *(LAS unsigned*)(lds + A_NEED) = z_; *(LAS unsigned*)(lds + A_NEED + 4) = z_; *(LAS unsigned*)(lds + A_NEED + 8) = z_; }
        if (tid < 64) { *(LAS float*)(lds + A_KM + 4 * tid) = P.km[tid]; *(LAS float*)(lds + A_KM + 256 + 4 * tid) = P.dkg[64 * tid + 63]; } }
    bool wdone = false;
    *(LAS u32x4*)(lds + A_KB + kdst) = kr; *(LAS u32x4*)(lds + A_VB + vdst) = vr;
    __syncthreads();
    float carry = 0.f;
    for (int it = 0; it < P.ntiles; ++it) {
        const int j = P.jfirst + it * P.step, buf = it & 1;
        const bool more = (it + 1 < P.ntiles);
        if (more) { const size_t t0 = (size_t)(j + P.step) * 64 * P.pitch + goff; kr = *(const GAS u32x4*)(P.Kg + t0); vr = *(const GAS u32x4*)(P.Vg + t0);
            if (MODE == M_FOX) { if (tid < 16) dkr = *(const GAS f32x4*)(P.dkg + 64 * (j + P.step) + 4 * tid); } }
        const int kv0 = 64 * j;
        bool skip;
        if (MODE == M_BAND) skip = (kv0 > P.tq0 + 31) || (kv0 + 63 < P.tq0 - (W - 1));
        else if (MODE == M_SLC) skip = (kv0 > P.tq0 + 31) || (__ballot((P.sel >> j) & 1ull) == 0ull);
        else if (MODE == M_FOX) skip = (kv0 > P.tq0 + 31) || wdone;
        else skip = (1024 * j > P.tq0);
        if (!skip) {
            LAS const char* kb = lds + A_KB + buf * 8192; LAS const char* vb = lds + A_VB + buf * 8192;
            f32x16 p0, p1; qk_tile(p0, p1, kb, qr, r, h);
            if (MODE == M_BAND || MODE == M_SLC) {
                const bool far = (P.tq0 - (kv0 + 63) >= 127) && (MODE == M_SLC || (P.tq0 + 31 - kv0 < W));
                if (far) { const float c = P.lut[127];
#pragma unroll
                    for (int i = 0; i < 16; ++i) { p0[i] += c; p1[i] += c; }
                } else { const int base = tq - kv0 - 4 * h;
#pragma unroll
                    for (int i = 0; i < 16; ++i) {
                        { const int rel = base - cofs(i); const bool ok = (MODE == M_SLC) ? (rel >= 0) : ((unsigned)rel < (unsigned)W); int ix = rel < 127 ? rel : 127; ix = ix > 0 ? ix : 0; p0[i] = ok ? p0[i] + P.lut[ix] : NEGINF; }
                        { const int rel = base - 32 - cofs(i); const bool ok = (MODE == M_SLC) ? (rel >= 0) : ((unsigned)rel < (unsigned)W); int ix = rel < 127 ? rel : 127; ix = ix > 0 ? ix : 0; p1[i] = ok ? p1[i] + P.lut[ix] : NEGINF; } }
                }
                if (MODE == M_SLC) { if (!((P.sel >> j) & 1ull)) {
#pragma unroll
                    for (int i = 0; i < 16; ++i) { p0[i] = NEGINF; p1[i] = NEGINF; } } }
            } else if (MODE == M_FOX) {
                const bool full = (kv0 + 63 <= P.tq0); const int base = tq - kv0 - 4 * h;
#pragma unroll
                for (int k = 0; k < 4; ++k) { const f32x4 d0 = *(const LAS f32x4*)(lds + A_DK + buf * 256 + (8 * k + 4 * h) * 4), d1 = *(const LAS f32x4*)(lds + A_DK + buf * 256 + (32 + 8 * k + 4 * h) * 4);
#pragma unroll
                    for (int e = 0; e < 4; ++e) { const int i = 4 * k + e; const int rel = base - cofs(i);
                        const float v0 = p0[i] + (P.dq - d0[e]), v1 = p1[i] + (P.dq - d1[e]);
                        p0[i] = (full || rel >= 0) ? v0 : NEGINF; p1[i] = (full || rel - 32 >= 0) ? v1 : NEGINF; } }
            } else {
                const int base = tq - 31 - 16 * (64 * j + 4 * h);
#pragma unroll
                for (int i = 0; i < 16; ++i) {
                    { const int rel = base - 16 * cofs(i); const bool ok = rel >= 0; int ix = rel < 127 ? rel : 127; ix = ix > 0 ? ix : 0; p0[i] = ok ? p0[i] + P.lut[ix] : NEGINF; }
                    { const int rel = base - 512 - 16 * cofs(i); const bool ok = rel >= 0; int ix = rel < 127 ? rel : 127; ix = ix > 0 ? ix : 0; p1[i] = ok ? p1[i] + P.lut[ix] : NEGINF; } }
            }
            if (MODE != M_CMP2) {
                float tm = fmaxf(p0[0], p1[0]);
#pragma unroll
                for (int i = 1; i < 16; ++i) tm = fmaxf(tm, fmaxf(p0[i], p1[i]));
                tm = fmaxf(tm, __shfl_xor(tm, 32));
                const float mn = fmaxf(a.m, tm);
                const float alpha = fast_exp2(a.m - mn);
                a.m = mn;
                if (__any(alpha != 1.f)) { a.l *= alpha;
                    if (MODE != M_CMP1) {
#pragma unroll
                        for (int i = 0; i < 16; ++i) { a.o0[i] *= alpha; a.o1[i] *= alpha; } } }
                float s = 0.f;
#pragma unroll
                for (int i = 0; i < 16; ++i) { p0[i] = fast_exp2(p0[i] - mn); p1[i] = fast_exp2(p1[i] - mn); s += p0[i] + p1[i]; }
                a.l += s;
                if (MODE != M_CMP1) pv_tile(a.o0, a.o1, p0, p1, vb + vofs0, vb + vofs1);
            } else {
#pragma unroll
                for (int i = 0; i < 16; ++i) { p0[i] = fast_exp2(p0[i] - P.fm) * P.frl; p1[i] = fast_exp2(p1[i] - P.fm) * P.frl; }
                float a8[8], b8[8];
#pragma unroll
                for (int k = 0; k < 4; ++k) { a8[k] = p0[4 * k] + p0[4 * k + 1] + p0[4 * k + 2] + 0.5f * p0[4 * k + 3]; b8[k] = 0.5f * p0[4 * k + 3];
                    a8[4 + k] = p1[4 * k] + p1[4 * k + 1] + p1[4 * k + 2] + 0.5f * p1[4 * k + 3]; b8[4 + k] = 0.5f * p1[4 * k + 3]; }
                float bs[8];
#pragma unroll
                for (int k = 0; k < 8; ++k) bs[k] = __shfl_xor(b8[k], 32);
#pragma unroll
                for (int k = 0; k < 8; ++k) { const float prev = (k == 0) ? carry : bs[k > 0 ? k - 1 : 0]; P.imp[16 * j + 2 * k + h] = a8[k] + (h ? bs[k] : prev); }
                carry = bs[7];
                pv_tile(a.o0, a.o1, p0, p1, vb + vofs0, vb + vofs1);
            }
        } else if (MODE == M_CMP2) {
            if (h == 0) P.imp[16 * j] = carry;
            carry = 0.f;
        }
        if (more) { *(LAS u32x4*)(lds + A_KB + (buf ^ 1) * 8192 + kdst) = kr; *(LAS u32x4*)(lds + A_VB + (buf ^ 1) * 8192 + vdst) = vr;
            if (MODE == M_FOX) { if (tid < 16) *(LAS f32x4*)(lds + A_DK + (buf ^ 1) * 256 + 16 * tid) = dkr; } }
        if (MODE == M_FOX) {
            const int slot = it % 3, nslot = (it + 1) % 3;
            if (more) { const int jn = j + P.step;
                if (!wdone) { const float bound = P.qn * *(LAS float*)(lds + A_KM + 4 * jn) * 1.001f + (P.dq - *(LAS float*)(lds + A_KM + 256 + 4 * jn));
                    const bool need = (bound >= a.m - 40.f);
                    if (__any(need)) { if (lane == 0) *(LAS unsigned*)(lds + A_NEED + 4 * slot) = 1u; } else wdone = true; } }
            if (tid == 0) *(LAS unsigned*)(lds + A_NEED + 4 * nslot) = 0u;
            __syncthreads();
            if (more && *(LAS unsigned*)(lds + A_NEED + 4 * slot) == 0u) break;
        } else {
            __syncthreads();
        }
    }
}
DI void acc_init(Acc& a, float m0, float l0) {
#pragma unroll
    for (int i = 0; i < 16; ++i) { a.o0[i] = 0.f; a.o1[i] = 0.f; }
    a.m = m0; a.l = l0;
}
DI void load_q(bf16x8 (&qr)[4], const bf16_t* Qrow  , int lane) {
    const bf16_t* p = Qrow + (size_t)(lane & 31) * QKV_N + 8 * (lane >> 5);
#pragma unroll
    for (int s = 0; s < 4; ++s) qr[s] = *(const GAS bf16x8*)(p + 16 * s);
}
DI void store_ot(bf16_t* O, const f32x16& y0, const f32x16& y1, float sc, int lane) {
    bf16_t* rowp = O + (size_t)(lane & 31) * DM + 4 * (lane >> 5);
#pragma unroll
    for (int g = 0; g < 4; ++g) {
        u32x2 a; a.x = cvtpk(y0[4 * g] * sc, y0[4 * g + 1] * sc); a.y = cvtpk(y0[4 * g + 2] * sc, y0[4 * g + 3] * sc); *(u32x2*)(rowp + 8 * g) = a;
        u32x2 b; b.x = cvtpk(y1[4 * g] * sc, y1[4 * g + 1] * sc); b.y = cvtpk(y1[4 * g + 2] * sc, y1[4 * g + 3] * sc); *(u32x2*)(rowp + 32 + 8 * g) = b; }
}
}

#ifndef PH_MASK
#define PH_MASK 0xFFFF
#endif
#define PH(k) ((PH_MASK >> (k)) & 1)
#ifndef REP_PHASE
#define REP_PHASE -1
#endif
#ifndef REP_N
#define REP_N 1
#endif
#define NREP(k) (((k) == REP_PHASE) ? REP_N : 1)
struct Args { const float* in[25]; float* out; unsigned char* ws; };

DI float wave_sum(float v) {
#pragma unroll
    for (int o = 1; o < 64; o <<= 1) v += __shfl_xor(v, o);
    return v;
}
DI unsigned f2bf(float f) { unsigned u = __builtin_bit_cast(unsigned, f); return (u + 0x7fffu + ((u >> 16) & 1u)) >> 16; }
DI unsigned pk2(float lo, float hi) { return f2bf(lo) | (f2bf(hi) << 16); }

enum { MAP_ID = 0, MAP_WIN = 1, MAP_GU_G = 2, MAP_GU_U = 3 };
DI int map_row(int kind, int c) {
    if (kind == MAP_WIN) { if (c < 1280) return c; if (c < 1292) return C_SM + (c - 1280); if (c < 2444) return c - 12; return c; }
    if (kind == MAP_GU_G) return (c >> 7) * 256 + (c & 127);
    if (kind == MAP_GU_U) return (c >> 7) * 256 + 128 + (c & 127);
    return c;
}
DI void cvt_item(const float* W, int K, int N, bf16_t* WT, int kind, int row_off, LAS float* scr, int item, int lane) {
    const int nblk = (N + 31) / 32, kb = item / nblk, nb = item % nblk, k0 = 64 * kb, n0 = 32 * nb;
    const int cn = n0 + (lane & 31); const bool cok = cn < N;
    float vv[32];
#pragma unroll
    for (int i = 0; i < 32; ++i) { const int kk = 2 * i + (lane >> 5); vv[i] = cok ? __builtin_nontemporal_load(W + (size_t)(k0 + kk) * N + cn) : 0.f; }
#pragma unroll
    for (int i = 0; i < 32; ++i) { const int kk = 2 * i + (lane >> 5); scr[kk * 33 + (lane & 31)] = vv[i]; }
    asm volatile("s_waitcnt lgkmcnt(0)" ::: "memory");
    const int c = lane & 7;
#pragma unroll
    for (int j = 0; j < 4; ++j) { const int n = (lane >> 3) + 8 * j; const LAS float* s = scr + (8 * c) * 33 + n;
        u32x4 o; o.x = pk2(s[0 * 33], s[1 * 33]); o.y = pk2(s[2 * 33], s[3 * 33]); o.z = pk2(s[4 * 33], s[5 * 33]); o.w = pk2(s[6 * 33], s[7 * 33]);
        if (n0 + n < N) *(u32x4*)(WT + (size_t)(row_off + map_row(kind, n0 + n)) * K + k0 + 8 * c) = o; }
    asm volatile("s_waitcnt lgkmcnt(0)" ::: "memory");
}

DI unsigned long long ldp(volatile LAS unsigned long long* PT, int k) { int ko = k; asm volatile("" : "+v"(ko)); const unsigned long long v = PT[ko];
    const unsigned lo = __builtin_amdgcn_readfirstlane((unsigned)v), hi = __builtin_amdgcn_readfirstlane((unsigned)(v >> 32)); return ((unsigned long long)hi << 32) | lo; }
#define INP(k) ((const float*)ldp(PT, (k)))
#define WSP(off) ((unsigned char*)ldp(PT, 26) + (off))
#define OUTP ((float*)ldp(PT, 25))

__global__ void __launch_bounds__(512, 2) mega_fwd(Args args) {
    extern __shared__ __attribute__((aligned(16))) unsigned char lds_raw[];
    LAS unsigned char* lds = (LAS unsigned char*)lds_raw;
    volatile LAS unsigned* MISC = (volatile LAS unsigned*)(lds + L_MISC);
    LAS float* LUT = (LAS float*)(lds + L_LUT);
    LAS int* TP = (LAS int*)(lds + L_TP);
    LAS int* CNTL = (LAS int*)(lds + L_CNT);
    const int wid0 = __builtin_amdgcn_readfirstlane((int)threadIdx.x >> 6);
#define LAUNDER_TID int lane; asm volatile("v_mbcnt_lo_u32_b32 %0, -1, 0\n\tv_mbcnt_hi_u32_b32 %0, -1, %0" : "=v"(lane)); int wid = wid0; asm volatile("" : "+s"(wid)); const int tid = wid * 64 + lane; (void)tid;
    const int G = gridDim.x, bx = blockIdx.x;
    volatile LAS unsigned long long* PT = (volatile LAS unsigned long long*)(lds + L_PT);
    { LAUNDER_TID
    if (tid == 0) {
        PT[0] = (unsigned long long)args.in[0]; PT[1] = (unsigned long long)args.in[1]; PT[2] = (unsigned long long)args.in[2]; PT[3] = (unsigned long long)args.in[3];
        PT[4] = (unsigned long long)args.in[4]; PT[5] = (unsigned long long)args.in[5]; PT[6] = (unsigned long long)args.in[6]; PT[7] = (unsigned long long)args.in[7];
        PT[8] = (unsigned long long)args.in[8]; PT[9] = (unsigned long long)args.in[9]; PT[10] = (unsigned long long)args.in[10]; PT[11] = (unsigned long long)args.in[11];
        PT[12] = (unsigned long long)args.in[12]; PT[13] = (unsigned long long)args.in[13]; PT[14] = (unsigned long long)args.in[14]; PT[15] = (unsigned long long)args.in[15];
        PT[16] = (unsigned long long)args.in[16]; PT[17] = (unsigned long long)args.in[17]; PT[18] = (unsigned long long)args.in[18]; PT[19] = (unsigned long long)args.in[19];
        PT[20] = (unsigned long long)args.in[20]; PT[21] = (unsigned long long)args.in[21]; PT[22] = (unsigned long long)args.in[22]; PT[23] = (unsigned long long)args.in[23];
        PT[24] = (unsigned long long)args.in[24]; PT[25] = (unsigned long long)args.out; PT[26] = (unsigned long long)args.ws;
    }
    for (int u = tid; u < 64; u += 512) MISC[u] = 0u;
    for (int u = tid; u < 1280; u += 512) { const int hh = u >> 7, rel = u & 127; int bk = rel;
        if (rel >= 16) { bk = 16; const int th[15] = {19, 21, 24, 27, 31, 35, 40, 46, 52, 59, 67, 77, 87, 99, 113};
#pragma unroll
            for (int q = 0; q < 15; ++q) bk += (rel >= th[q]) ? 1 : 0; }
        LUT[u] = args.in[10][bk * 10 + hh] * LOG2E; }
    }
    __syncthreads();
    XcdBarrier bar = xcd_barrier_post((unsigned*)WSP(WS_CTL) + CW_BAR, MISC);
#define GRID_BAR() do { XcdBarrier b2_ = bar; b2_.bar = (unsigned*)WSP(WS_CTL) + CW_BAR; asm volatile("" : "+s"(b2_.x)); int ln_; asm volatile("v_mbcnt_lo_u32_b32 %0, -1, 0\n\tv_mbcnt_hi_u32_b32 %0, -1, %0" : "=v"(ln_)); xcd_barrier(b2_, (wid0 == 0) && (ln_ == 0)); } while (0)
#define QNEXT(ctr, dstvar) do { if (tid == 0) MISC[8] = atomicAdd((ctr), 1u); __syncthreads(); dstvar = (int)__builtin_amdgcn_readfirstlane(MISC[8]); __syncthreads(); } while (0)

    for (int rep = 0; rep < NREP(0); ++rep) if (PH(0)) { LAUNDER_TID
            float* ADA = (float*)WSP(WS_ADA); float* CPOS = (float*)WSP(WS_CPOS); bf16_t* WIN = (bf16_t*)WSP(WS_WIN); bf16_t* WO = (bf16_t*)WSP(WS_WO); bf16_t* WSH = (bf16_t*)WSP(WS_WSH); bf16_t* WSD = (bf16_t*)WSP(WS_WSD); bf16_t* WCT = (bf16_t*)WSP(WS_WCT); bf16_t* WGU = (bf16_t*)WSP(WS_WGU); bf16_t* WD = (bf16_t*)WSP(WS_WD);
        if (bx < 192) {
            LAS float* cond = (LAS float*)lds;
            LAS float* red = (LAS float*)(lds + 32768);
            for (int u = tid; u < 8192; u += 512) cond[u] = siluf_(INP(1)[u]);
            __syncthreads();
            const int l = bx / 96, j0 = (bx % 96) * 64;
            const float* wa = INP(11) + (size_t)l * DM * 6144 + j0 + lane;
            float accb[8];
#pragma unroll
            for (int b = 0; b < 8; ++b) accb[b] = 0.f;
#pragma unroll 8
            for (int kk = 0; kk < 128; ++kk) { const int k = wid * 128 + kk; const float w = wa[(size_t)k * 6144];
#pragma unroll
                for (int b = 0; b < 8; ++b) accb[b] += cond[b * 1024 + k] * w; }
#pragma unroll
            for (int b = 0; b < 8; ++b) red[(wid * 8 + b) * 64 + lane] = accb[b];
            __syncthreads();
            { const int b = tid >> 6; float s = INP(12)[l * 6144 + j0 + lane];
#pragma unroll
                for (int w = 0; w < 8; ++w) s += red[(w * 8 + b) * 64 + lane];
                ADA[((size_t)l * 8 + b) * 6144 + j0 + lane] = s; }
            __syncthreads();
        } else if (bx < 196) {
            const int l = (bx - 192) >> 1, which = (bx - 192) & 1;
            const float* pos = INP(which ? 7 : 5) + (size_t)l * 2048 + wid * 256; const float* w = INP(which ? 8 : 6) + (size_t)l * 2048 * 64 + (size_t)wid * 256 * 64;
            LAS float* red = (LAS float*)lds;
            float s = 0.f;
#pragma unroll 16
            for (int k = 0; k < 256; ++k) s += pos[k] * w[(size_t)k * 64 + lane];
            red[wid * 64 + lane] = s;
            __syncthreads();
            if (wid == 0) { float t = 0.f;
#pragma unroll
                for (int w8 = 0; w8 < 8; ++w8) t += red[w8 * 64 + lane];
                CPOS[(l * 2 + which) * 64 + lane] = t; }
            __syncthreads();
        }
        { const int gt = bx * 512 + tid; const int per = (QKV_N - D_IN) * DM / 8;
            for (int u = gt; u < 2 * per; u += G * 512) { const int l = u / per, r = u % per; *(u32x4*)(WIN + ((size_t)l * QKV_N + D_IN) * DM + (size_t)r * 8) = (u32x4){0u, 0u, 0u, 0u}; } }
        LAS float* scr = (LAS float*)(lds + wid * 16384);
        const int gw = bx * 8 + wid, NGW = G * 8;
        constexpr int I_SMALL = 2384, I_EXP = 384;
        const int NITEMS = DEPTH * I_SMALL + DEPTH * NEXP * I_EXP;
        for (int it = gw; it < NITEMS; it += NGW) {
            if (it < DEPTH * I_SMALL) { const int l = it / I_SMALL; int r = it % I_SMALL;
                if (r < 1232) { cvt_item(INP(2) + (size_t)l * DM * D_IN, DM, D_IN, WIN + (size_t)l * QKV_N * DM, MAP_WIN, 0, scr, r, lane); continue; } r -= 1232;
                if (r < 512) { cvt_item(INP(3) + (size_t)l * DM * DM, DM, DM, WO + (size_t)l * DM * DM, MAP_ID, 0, scr, r, lane); continue; } r -= 512;
                if (r < 128) { cvt_item(INP(17) + (size_t)l * DM * 256, DM, 256, WSH + (size_t)l * 768 * DM, MAP_ID, 0, scr, r, lane); continue; } r -= 128;
                if (r < 128) { cvt_item(INP(22) + (size_t)l * DM * 256, DM, 256, WSH + (size_t)l * 768 * DM, MAP_GU_G, 256, scr, r, lane); continue; } r -= 128;
                if (r < 128) { cvt_item(INP(23) + (size_t)l * DM * 256, DM, 256, WSH + (size_t)l * 768 * DM, MAP_GU_U, 256, scr, r, lane); continue; } r -= 128;
                if (r < 128) { cvt_item(INP(24) + (size_t)l * 256 * DM, 256, DM, WSD + (size_t)l * DM * 256, MAP_ID, 0, scr, r, lane); continue; } r -= 128;
                if (r < 64) { cvt_item(INP(6) + (size_t)l * 2048 * 64, 2048, 64, WCT + (size_t)(l * 2 + 0) * 64 * 2048, MAP_ID, 0, scr, r, lane); continue; } r -= 64;
                cvt_item(INP(8) + (size_t)l * 2048 * 64, 2048, 64, WCT + (size_t)(l * 2 + 1) * 64 * 2048, MAP_ID, 0, scr, r, lane);
            } else { const int r0 = it - DEPTH * I_SMALL; const int le = r0 / I_EXP, r = r0 % I_EXP;
                if (r < 128) cvt_item(INP(19) + (size_t)le * DM * EDIM, DM, EDIM, WGU + (size_t)le * 512 * DM, MAP_GU_G, 0, scr, r, lane);
                else if (r < 256) cvt_item(INP(20) + (size_t)le * DM * EDIM, DM, EDIM, WGU + (size_t)le * 512 * DM, MAP_GU_U, 0, scr, r - 128, lane);
                else cvt_item(INP(21) + (size_t)le * EDIM * DM, EDIM, DM, WD + (size_t)le * DM * EDIM, MAP_ID, 0, scr, r - 256, lane);
            }
        }
    }
    GRID_BAR();
    if (PH(1)) { LAUNDER_TID
            float* ADA = (float*)WSP(WS_ADA); bf16_t* H = (bf16_t*)WSP(WS_H);
        const int gw = bx * 8 + wid, NGW = G * 8;
        for (int m = gw; m < NTOK; m += NGW) { const int b = m >> 12; const float* ad = ADA + (size_t)b * 6144;
            const f32x4* xr = (const f32x4*)(INP(0) + (size_t)m * DM) + lane; unsigned long long* o8 = (unsigned long long*)(H + (size_t)m * DM) + lane;
#pragma unroll
            for (int j = 0; j < 4; ++j) { const f32x4 v = xr[64 * j]; const f32x4 sh = *((const f32x4*)(ad) + 64 * j + lane), sc = *((const f32x4*)(ad + 1024) + 64 * j + lane);
                const f32x4 hv = v * (sc + 1.f) + sh; o8[64 * j] = (unsigned long long)cvtpk(hv[0], hv[1]) | ((unsigned long long)cvtpk(hv[2], hv[3]) << 32); } }
    }
    GRID_BAR();

    for (int l = 0; l < DEPTH; ++l) {
        for (int rep = 0; rep < NREP(2); ++rep) if (PH(2)) { LAUNDER_TID
            bf16_t* H = (bf16_t*)WSP(WS_H); bf16_t* WIN = (bf16_t*)WSP(WS_WIN); bf16_t* QKV = (bf16_t*)WSP(WS_QKV); float* SMALL = (float*)WSP(WS_SMALL);
            pg8::Gemm g{H, WIN + (size_t)l * QKV_N * DM, DM}; pg8::StaticOrder S; S.init(NTOK, QKV_N, G, bx);
            pg8::EpiQKV E{QKV, SMALL};
            pg8::gemm_phase<pg8::EpiQKV, pg8::StaticOrder>(lds, g, S, E, wid);
        }
        GRID_BAR();
        for (int rep = 0; rep < NREP(3); ++rep) if (PH(3)) { LAUNDER_TID
            unsigned* ctl = (unsigned*)WSP(WS_CTL); bf16_t* QKV = (bf16_t*)WSP(WS_QKV); bf16_t* WCT = (bf16_t*)WSP(WS_WCT); float* CPOS = (float*)WSP(WS_CPOS); bf16_t* KCMP = (bf16_t*)WSP(WS_KCMP); bf16_t* VCMP = (bf16_t*)WSP(WS_VCMP); float* SMALL = (float*)WSP(WS_SMALL); float* DC = (float*)WSP(WS_DC); bf16_t* OB = (bf16_t*)WSP(WS_O); float* KMW = (float*)WSP(WS_KM);
            unsigned* qctr = ctl + CW_Q + 64 * (l * 4 + 0 + 8 * rep);
            for (;;) {
                int u; QNEXT(qctr, u);
                if (u >= 32 + 48 + 768) break;
                if (u < 32) {
                    const int b = u >> 2, which = (u >> 1) & 1, cblk = u & 1, nblk = wid, r = lane & 31, h = lane >> 5;
                    int n = 32 * nblk + r; n = n < 254 ? n : 254;
                    const bf16_t* arow = QKV + ((size_t)b * SEQ + 16 * n) * QKV_N + (which ? C_BVC : C_BKC) + 8 * h;
                    const bf16_t* brow = WCT + ((size_t)(l * 2 + which) * 64 + 32 * cblk + r) * 2048 + 8 * h;
                    f32x16 acc;
#pragma unroll
                    for (int i = 0; i < 16; ++i) acc[i] = 0.f;
#pragma unroll 4
                    for (int s = 0; s < 128; ++s) { const int k = 16 * s; const bf16x8 af = *(const bf16x8*)(arow + (size_t)(k >> 6) * QKV_N + (k & 63)); const bf16x8 bf = *(const bf16x8*)(brow + k);
                        acc = MFMA32(af, bf, acc); }
                    const float cp = CPOS[(l * 2 + which) * 64 + 32 * cblk + r]; bf16_t* dst = (which ? VCMP : KCMP) + (size_t)b * 256 * 64 + 32 * cblk + r;
#pragma unroll
                    for (int i = 0; i < 16; ++i) { const int nn = 32 * nblk + (i & 3) + 8 * (i >> 2) + 4 * h; dst[(size_t)nn * 64] = (bf16_t)(nn < 255 ? f2bf(acc[i] + cp) : 0u); }
                } else if (u < 80) {
                    const int b = (u - 32) / 6, hh = (u - 32) % 6; const float fb = INP(9)[l * 6 + hh];
                    LAS float* wsum = (LAS float*)lds;
                    float v[8]; float run = 0.f;
#pragma unroll
                    for (int i = 0; i < 8; ++i) { const float x = SMALL[((size_t)b * SEQ + 8 * tid + i) * 32 + 12 + hh] + fb; const float lf = fminf(x, 0.f) - log1pf(__expf(-fabsf(x))); run += lf; v[i] = run; }
                    float incl = run;
#pragma unroll
                    for (int o = 1; o < 64; o <<= 1) { const float t = __shfl_up(incl, o); if (lane >= o) incl += t; }
                    if (lane == 63) wsum[wid] = incl;
                    __syncthreads();
                    float base = incl - run;
                    for (int w = 0; w < wid; ++w) base += wsum[w];
                    float* dst = DC + ((size_t)b * 6 + hh) * SEQ + 8 * tid;
#pragma unroll
                    for (int i = 0; i < 8; ++i) dst[i] = (base + v[i]) * LOG2E;
                    LAS float* tmx = (LAS float*)(lds + 1024);
                    { const bf16_t* kp = QKV + ((size_t)b * SEQ + (tid >> 3)) * QKV_N + C_CK + 64 * hh + 8 * (tid & 7);
#pragma unroll 8
                        for (int T = 0; T < 64; ++T) { const bf16x8 kv = *(const GAS bf16x8*)(kp + (size_t)T * 64 * QKV_N); float ss = 0.f;
#pragma unroll
                            for (int e = 0; e < 8; ++e) { const float x = __uint_as_float(((unsigned)(unsigned short)kv[e]) << 16); ss += x * x; }
                            ss += __shfl_xor(ss, 1); ss += __shfl_xor(ss, 2); ss += __shfl_xor(ss, 4);
                            ss = fmaxf(ss, __shfl_xor(ss, 8)); ss = fmaxf(ss, __shfl_xor(ss, 16)); ss = fmaxf(ss, __shfl_xor(ss, 32));
                            if (lane == 0) tmx[wid * 64 + T] = ss; } }
                    __syncthreads();
                    if (tid < 64) { float mx = tmx[tid];
#pragma unroll
                        for (int w = 1; w < 8; ++w) mx = fmaxf(mx, tmx[w * 64 + tid]);
#pragma unroll
                        for (int o = 1; o < 64; o <<= 1) { const float t = __shfl_up(mx, o); if (lane >= o) mx = fmaxf(mx, t); }
                        KMW[((size_t)b * 6 + hh) * 64 + tid] = sqrtf(mx); }
                    __syncthreads();
                } else {
                    const int ua = u - 80, qt = ua & 15, hq = (ua >> 4) % 6, b = ua / 96, kvh = hq / 3;
                    const size_t tok0 = (size_t)b * SEQ + 256 * qt + 32 * wid;
                    bf16x8 qr[4]; att::load_q(qr, QKV + tok0 * QKV_N + C_AQ + 64 * hq, lane);
                    att::Acc a; att::acc_init(a, INP(4)[l * 6 + hq] * LOG2E, (lane < 32) ? 1.f : 0.f);
                    att::PassArgs P; P.Kg = QKV + (size_t)b * SEQ * QKV_N + C_AK + 64 * kvh; P.Vg = QKV + (size_t)b * SEQ * QKV_N + C_AV + 64 * kvh; P.pitch = QKV_N;
                    P.jfirst = (4 * qt - 2) > 0 ? (4 * qt - 2) : 0; P.ntiles = 4 * qt + 3 - P.jfirst + 1; P.step = 1; P.tq0 = 256 * qt + 32 * wid;
                    P.lut = LUT + 128 * hq; P.sel = 0ull; P.dq = 0.f; P.dkg = nullptr; P.fm = 0.f; P.frl = 0.f; P.imp = nullptr; P.qn = 0.f; P.km = nullptr;
                    att::attn_pass<att::M_BAND, 128>((LAS char*)lds, P, qr, a, tid, lane);
                    const float lt = a.l + __shfl_xor(a.l, 32);
                    att::store_ot(OB + tok0 * DM + O_A + 64 * hq, a.o0, a.o1, 1.f / lt, lane);
                }
            }
        }
        GRID_BAR();
        for (int rep = 0; rep < NREP(4); ++rep) if (PH(4)) { LAUNDER_TID
            unsigned* ctl = (unsigned*)WSP(WS_CTL); bf16_t* QKV = (bf16_t*)WSP(WS_QKV); float* DC = (float*)WSP(WS_DC); bf16_t* KCMP = (bf16_t*)WSP(WS_KCMP); bf16_t* VCMP = (bf16_t*)WSP(WS_VCMP); float* SMALL = (float*)WSP(WS_SMALL); bf16_t* OB = (bf16_t*)WSP(WS_O); const float* KM = (const float*)WSP(WS_KM);
            unsigned* qctr = ctl + CW_Q + 64 * (l * 4 + 1 + 8 * rep);
            for (;;) {
                int u; QNEXT(qctr, u);
                if (u >= 1280) break;
                const int grp = u / 80, rr = u % 80, L = 15 - grp;
                if (rr < 48) { if (PH(14)) {
                    const int b = rr / 6, hh = rr % 6, qt = L;
                    const size_t tok0 = (size_t)b * SEQ + 256 * qt + 32 * wid;
                    bf16x8 qr[4]; att::load_q(qr, QKV + tok0 * QKV_N + C_CQ + 64 * hh, lane);
                    att::Acc a; att::acc_init(a, -1e30f, 0.f);
                    att::PassArgs P; P.Kg = QKV + (size_t)b * SEQ * QKV_N + C_CK + 64 * hh; P.Vg = QKV + (size_t)b * SEQ * QKV_N + C_CV + 64 * hh; P.pitch = QKV_N;
                    P.jfirst = 4 * qt + 3; P.ntiles = 4 * qt + 4; P.step = -1; P.tq0 = 256 * qt + 32 * wid;
                    P.lut = LUT; P.sel = 0ull; P.dkg = DC + ((size_t)b * 6 + hh) * SEQ; P.dq = P.dkg[P.tq0 + (lane & 31)]; P.fm = 0.f; P.frl = 0.f; P.imp = nullptr;
                    { float qs = 0.f;
#pragma unroll
                        for (int s4 = 0; s4 < 4; ++s4)
#pragma unroll
                            for (int e = 0; e < 8; ++e) { const float qv = __uint_as_float(((unsigned)(unsigned short)qr[s4][e]) << 16); qs += qv * qv; }
                        qs += __shfl_xor(qs, 32); P.qn = sqrtf(qs); P.km = KM + ((size_t)b * 6 + hh) * 64; }
                    att::attn_pass<att::M_FOX, 0>((LAS char*)lds, P, qr, a, tid, lane);
                    const float lt = a.l + __shfl_xor(a.l, 32);
                    att::store_ot(OB + tok0 * DM + O_C + 64 * hh, a.o0, a.o1, 1.f / lt, lane);
                } } else if (PH(15)) {
                    const int r2 = rr - 48, qt = 4 * L + 3 - (r2 >> 3), b = r2 & 7, head = wid >> 1, qh = wid & 1;
                    const size_t tok0 = (size_t)b * SEQ + 64 * qt + 32 * qh; const int tq0 = 64 * qt + 32 * qh;
                    const int r = lane & 31, h = lane >> 5;
                    LAS float* IMP = (LAS float*)(lds + att::A_IMP);
                    LAS unsigned long long* SELM = (LAS unsigned long long*)(lds + att::A_SEL);
                    for (int q = tid; q < 4 * 64 * 65; q += 512) IMP[q] = 0.f;
                    bf16x8 qr[4]; att::load_q(qr, QKV + tok0 * QKV_N + C_BQ + 64 * head, lane);
                    const float* gl = SMALL + (tok0 + r) * 32 + head;
                    const float g0 = sigmoidf_(gl[0]), g1 = sigmoidf_(gl[4]), g2 = sigmoidf_(gl[8]);
                    att::PassArgs P; P.pitch = 64; P.Kg = KCMP + (size_t)b * 256 * 64; P.Vg = VCMP + (size_t)b * 256 * 64;
                    P.jfirst = 0; P.ntiles = (qt >> 4) + 1; P.step = 1; P.tq0 = tq0; P.lut = LUT + 128 * (6 + head); P.sel = 0ull; P.dq = 0.f; P.dkg = nullptr; P.qn = 0.f; P.km = nullptr;
                    P.fm = 0.f; P.frl = 0.f; P.imp = IMP + (head * 64 + 32 * qh + r) * 65;
                    att::Acc a; att::acc_init(a, -1e30f, 0.f);
                    att::attn_pass<att::M_CMP1, 0>((LAS char*)lds, P, qr, a, tid, lane);
                    { const float lt = a.l + __shfl_xor(a.l, 32); P.fm = a.m; P.frl = lt > 0.f ? 1.f / lt : 0.f; }
                    att::acc_init(a, 0.f, 0.f);
                    att::attn_pass<att::M_CMP2, 0>((LAS char*)lds, P, qr, a, tid, lane);
#pragma unroll
                    for (int i = 0; i < 16; ++i) { a.o0[i] *= g0; a.o1[i] *= g0; }
                    for (int qi = 0; qi < 8; ++qi) { const int q = 8 * wid + qi;
                        float v = IMP[(0 * 64 + q) * 65 + lane] + IMP[(1 * 64 + q) * 65 + lane] + IMP[(2 * 64 + q) * 65 + lane] + IMP[(3 * 64 + q) * 65 + lane];
                        if (lane == 0 || lane == qt || lane == qt - 1) v = 1e4f; else if (lane > qt) v = -1.f;
                        int rank = 0;
#pragma unroll
                        for (int jj = 0; jj < 64; ++jj) { const float vj = __uint_as_float(__builtin_amdgcn_readlane(__float_as_uint(v), jj)); rank += ((vj > v) || (vj == v && jj < lane)) ? 1 : 0; }
                        const unsigned long long mk = __ballot(rank < 16);
                        if (lane == 0) SELM[q] = mk; }
                    __syncthreads();
                    P.sel = SELM[32 * qh + r];
                    LAS float* FR = IMP + tid;
#pragma unroll
                    for (int i = 0; i < 16; ++i) { FR[512 * i] = a.o0[i]; FR[512 * (16 + i)] = a.o1[i]; }
                    P.pitch = QKV_N; P.Kg = QKV + (size_t)b * SEQ * QKV_N + C_BKS; P.Vg = QKV + (size_t)b * SEQ * QKV_N + C_BVS; P.jfirst = 0; P.ntiles = qt + 1; P.step = 1;
                    att::acc_init(a, -1e30f, 0.f);
                    att::attn_pass<att::M_SLC, 0>((LAS char*)lds, P, qr, a, tid, lane);
                    { const float lt = a.l + __shfl_xor(a.l, 32); const float sc = g1 / lt;
#pragma unroll
                        for (int i = 0; i < 16; ++i) { FR[512 * i] += sc * a.o0[i]; FR[512 * (16 + i)] += sc * a.o1[i]; } }
                    P.Kg = QKV + (size_t)b * SEQ * QKV_N + C_BKW; P.Vg = QKV + (size_t)b * SEQ * QKV_N + C_BVW; P.jfirst = (qt - 8) > 0 ? (qt - 8) : 0; P.ntiles = qt - P.jfirst + 1;
                    att::acc_init(a, -1e30f, 0.f);
                    att::attn_pass<att::M_BAND, 512>((LAS char*)lds, P, qr, a, tid, lane);
                    { const float lt = a.l + __shfl_xor(a.l, 32); const float sc = g2 / lt;
#pragma unroll
                        for (int i = 0; i < 16; ++i) { a.o0[i] = FR[512 * i] + sc * a.o0[i]; a.o1[i] = FR[512 * (16 + i)] + sc * a.o1[i]; } }
                    att::store_ot(OB + tok0 * DM + O_B + 64 * head, a.o0, a.o1, 1.f, lane);
                }
            }
        }
        GRID_BAR();
        for (int rep = 0; rep < NREP(5); ++rep) if (PH(5)) { LAUNDER_TID
            bf16_t* OB = (bf16_t*)WSP(WS_O); bf16_t* WO = (bf16_t*)WSP(WS_WO); const float* xin = (l == 0) ? INP(0) : (const float*)OUTP; float* VB = (float*)WSP(WS_V); const float* ada_l = (const float*)WSP(WS_ADA) + (size_t)l * 8 * 6144;
            pg8::Gemm g{OB, WO + (size_t)l * DM * DM, DM}; pg8::StaticOrder S; S.init(NTOK, DM, G, bx);
            pg8::EpiWO E{xin, VB, ada_l + 2 * 1024};
            pg8::gemm_phase<pg8::EpiWO, pg8::StaticOrder>(lds, g, S, E, wid);
        }
        GRID_BAR();
        for (int rep = 0; rep < NREP(6); ++rep) if (PH(6)) { LAUNDER_TID
            float* VB = (float*)WSP(WS_V); float* X1 = (float*)WSP(WS_X1); bf16_t* H = (bf16_t*)WSP(WS_H); const float* ada_l = (const float*)WSP(WS_ADA) + (size_t)l * 8 * 6144;
            const int gw = bx * 8 + wid, NGW = G * 8; const float* lg = INP(13) + l * DM; const float* lb = INP(14) + l * DM;
            for (int m = gw; m < NTOK; m += NGW) { const int b = m >> 12; const float* ad = ada_l + (size_t)b * 6144;
                const f32x4* xr = (const f32x4*)(VB + (size_t)m * DM) + lane; f32x4 v[4]; float s = 0.f;
#pragma unroll
                for (int j = 0; j < 4; ++j) { v[j] = xr[64 * j]; s += (v[j][0] + v[j][1]) + (v[j][2] + v[j][3]); }
                const float mean = wave_sum(s) * (1.f / DM); float s2 = 0.f;
#pragma unroll
                for (int j = 0; j < 4; ++j) { v[j] = v[j] - mean; s2 += (v[j][0] * v[j][0] + v[j][1] * v[j][1]) + (v[j][2] * v[j][2] + v[j][3] * v[j][3]); }
                const float rstd = 1.f / sqrtf(wave_sum(s2) * (1.f / DM) + LN_EPS);
                f32x4* xo = (f32x4*)(X1 + (size_t)m * DM) + lane; unsigned long long* o8 = (unsigned long long*)(H + (size_t)m * DM) + lane;
#pragma unroll
                for (int j = 0; j < 4; ++j) { const f32x4 gg = *((const f32x4*)lg + 64 * j + lane), bb = *((const f32x4*)lb + 64 * j + lane);
                    const f32x4 x1 = v[j] * rstd * gg + bb; xo[64 * j] = x1;
                    const f32x4 sh = *((const f32x4*)(ad + 3 * 1024) + 64 * j + lane), sc = *((const f32x4*)(ad + 4 * 1024) + 64 * j + lane);
                    const f32x4 hv = x1 * (sc + 1.f) + sh; o8[64 * j] = (unsigned long long)cvtpk(hv[0], hv[1]) | ((unsigned long long)cvtpk(hv[2], hv[3]) << 32); } }
        }
        GRID_BAR();
        for (int rep = 0; rep < NREP(7); ++rep) if (PH(7)) { LAUNDER_TID
            bf16_t* H = (bf16_t*)WSP(WS_H); bf16_t* WSH = (bf16_t*)WSP(WS_WSH); float* LOG = (float*)WSP(WS_LOG); bf16_t* ACTSH = (bf16_t*)WSP(WS_ACTSH);
            pg8::Gemm g{H, WSH + (size_t)l * 768 * DM, DM}; pg8::StaticOrder S; S.init(NTOK, 768, G, bx);
            pg8::EpiSH E{LOG, ACTSH};
            pg8::gemm_phase<pg8::EpiSH, pg8::StaticOrder>(lds, g, S, E, wid);
        }
        GRID_BAR();
        if (PH(8)) { LAUNDER_TID
            unsigned* ctl = (unsigned*)WSP(WS_CTL); float* LOG = (float*)WSP(WS_LOG); int* DST = (int*)WSP(WS_DST); float* WL = (float*)WSP(WS_WL);
            unsigned* CNT = ctl + CW_CNT + l * 256;
            LAS int* hist = (LAS int*)lds;
            LAS int* basel = (LAS int*)(lds + 1024);
            LAS int* asg_e = (LAS int*)(lds + 2048);
            LAS int* asg_r = (LAS int*)(lds + 2048 + 4096);
            LAS float* asg_w = (LAS float*)(lds + 2048 + 8192);
            const float* rb = INP(18) + l * 256;
            for (int chunk = bx; chunk < NTOK / 128; chunk += G) {
                for (int u = tid; u < 256; u += 512) hist[u] = 0;
                __syncthreads();
                for (int ti = 0; ti < 16; ++ti) { const int tl = wid * 16 + ti, n = chunk * 128 + tl;
                    const f32x4 lg = *((const f32x4*)(LOG + (size_t)n * 256) + lane); const f32x4 rbv = *((const f32x4*)rb + lane);
                    float sc[4], ch[4];
#pragma unroll
                    for (int i = 0; i < 4; ++i) { sc[i] = sigmoidf_(lg[i]); ch[i] = sc[i] + rbv[i]; }
                    float m1 = fmaxf(ch[0], ch[1]), m2 = fminf(ch[0], ch[1]);
                    { const float a1 = fmaxf(ch[2], ch[3]), a2 = fminf(ch[2], ch[3]); const float n1 = fmaxf(m1, a1), n2 = fmaxf(fminf(m1, a1), fmaxf(m2, a2)); m1 = n1; m2 = n2; }
#pragma unroll
                    for (int o = 1; o < 8; o <<= 1) { const float b1 = __shfl_xor(m1, o), b2 = __shfl_xor(m2, o); const float n1 = fmaxf(m1, b1), n2 = fmaxf(fminf(m1, b1), fmaxf(m2, b2)); m1 = n1; m2 = n2; }
                    const float gs = m1 + m2; const int grp = lane >> 3; int grank = 0;
#pragma unroll
                    for (int jg = 0; jg < 8; ++jg) { const float o = __shfl(gs, 8 * jg); grank += ((o > gs) || (o == gs && jg < grp)) ? 1 : 0; }
                    const bool gsel = grank < 4;
                    float val[4];
#pragma unroll
                    for (int i = 0; i < 4; ++i) val[i] = gsel ? ch[i] : -1e30f;
                    float wsum_ = 0.f; int my_e = 0; float my_s = 0.f;
#pragma unroll
                    for (int k = 0; k < 8; ++k) {
                        float bv = val[0]; int bi = 4 * lane; float bsc = sc[0];
#pragma unroll
                        for (int i = 1; i < 4; ++i) if (val[i] > bv) { bv = val[i]; bi = 4 * lane + i; bsc = sc[i]; }
#pragma unroll
                        for (int o = 1; o < 64; o <<= 1) { const float ov = __shfl_xor(bv, o); const int oi = __shfl_xor(bi, o); const float os = __shfl_xor(bsc, o);
                            if (ov > bv || (ov == bv && oi < bi)) { bv = ov; bi = oi; bsc = os; } }
                        if ((bi >> 2) == lane) {
#pragma unroll
                            for (int i = 0; i < 4; ++i) if ((bi & 3) == i) val[i] = -3e38f; }
                        wsum_ += bsc; if (lane == k) { my_e = bi; my_s = bsc; }
                    }
                    if (lane < 8) { const int rk = __hip_atomic_fetch_add(&hist[my_e], 1, __ATOMIC_RELAXED, __HIP_MEMORY_SCOPE_WORKGROUP); asg_e[tl * 8 + lane] = my_e; asg_r[tl * 8 + lane] = rk; asg_w[tl * 8 + lane] = my_s / wsum_ * 2.5f; }
                }
                __syncthreads();
                if (tid < 256) { const int c = hist[tid]; basel[tid] = c ? (int)atomicAdd(&CNT[tid], (unsigned)c) : 0; }
                __syncthreads();
                for (int u = tid; u < 1024; u += 512) { const int e = asg_e[u]; const int pos = basel[e] + asg_r[u]; DST[(size_t)e * NTOK + pos] = (chunk * 128) * 8 + u; WL[(size_t)e * NTOK + pos] = asg_w[u]; }
                __syncthreads();
            }
        }
        GRID_BAR();
        for (int rep = 0; rep < NREP(9); ++rep) if (PH(9)) { LAUNDER_TID
            unsigned* ctl = (unsigned*)WSP(WS_CTL); bf16_t* H = (bf16_t*)WSP(WS_H); bf16_t* WGU = (bf16_t*)WSP(WS_WGU); int* DST = (int*)WSP(WS_DST); bf16_t* ACT = (bf16_t*)WSP(WS_ACT);
            const unsigned* CNT = ctl + CW_CNT + l * 256;
            if (tid < 256) CNTL[tid] = (int)__hip_atomic_load(CNT + tid, __ATOMIC_RELAXED, __HIP_MEMORY_SCOPE_AGENT);
            __syncthreads();
            if (tid == 0) { int s = 0; for (int e = 0; e < 256; ++e) { TP[e] = s; s += (CNTL[e] + 255) >> 8; } TP[256] = s; }
            __syncthreads();
            pg8::Gemm g{H, WGU + (size_t)l * NEXP * 512 * DM, DM};
            pg8::GroupedOrder<true> S{TP, CNTL, 2, G, bx, DST};
            pg8::EpiGU E{ACT};
            pg8::gemm_phase<pg8::EpiGU, pg8::GroupedOrder<true>>(lds, g, S, E, wid);
        }
        GRID_BAR();
        for (int rep = 0; rep < NREP(10); ++rep) if (PH(10)) { LAUNDER_TID
            bf16_t* ACTSH = (bf16_t*)WSP(WS_ACTSH); bf16_t* WSD = (bf16_t*)WSP(WS_WSD); bf16_t* YSH = (bf16_t*)WSP(WS_YSH); bf16_t* ACT = (bf16_t*)WSP(WS_ACT); bf16_t* WD = (bf16_t*)WSP(WS_WD); bf16_t* YB = (bf16_t*)WSP(WS_YB); int* DST = (int*)WSP(WS_DST); float* WL = (float*)WSP(WS_WL);
            if (PH(12)) { pg8::Gemm g{ACTSH, WSD + (size_t)l * DM * 256, 256}; pg8::StaticOrder S; S.init(NTOK, DM, G, bx);
              pg8::EpiShDown E{YSH};
              pg8::gemm_phase<pg8::EpiShDown, pg8::StaticOrder>(lds, g, S, E, wid); }
            if (PH(13)) { pg8::Gemm g{ACT, WD + (size_t)l * NEXP * DM * 256, 256};
              pg8::GroupedOrder<false> S{TP, CNTL, 4, G, bx, nullptr};
              pg8::EpiDown E{YB, DST, WL};
              pg8::gemm_phase<pg8::EpiDown, pg8::GroupedOrder<false>>(lds, g, S, E, wid); }
        }
        GRID_BAR();
        for (int rep = 0; rep < NREP(11); ++rep) if (PH(11)) { LAUNDER_TID
            bf16_t* YSH = (bf16_t*)WSP(WS_YSH); bf16_t* YB = (bf16_t*)WSP(WS_YB); float* X1 = (float*)WSP(WS_X1); float* OUT = OUTP; bf16_t* H = (bf16_t*)WSP(WS_H); float* ADA = (float*)WSP(WS_ADA); const float* ada_l = (const float*)WSP(WS_ADA) + (size_t)l * 8 * 6144;
            const int gw = bx * 8 + wid, NGW = G * 8; const float* lg = INP(15) + l * DM; const float* lb = INP(16) + l * DM;
            for (int m = gw; m < NTOK; m += NGW) { const int b = m >> 12; const float* ad = ada_l + (size_t)b * 6144;
                f32x4 v[4]; float s = 0.f;
#pragma unroll
                for (int j = 0; j < 4; ++j) { const int c0 = 256 * j + 4 * lane;
                    f32x4 y; { const u32x2 t = *(const u32x2*)(YSH + (size_t)m * DM + c0); y[0] = __uint_as_float(t.x << 16); y[1] = __uint_as_float(t.x & 0xffff0000u); y[2] = __uint_as_float(t.y << 16); y[3] = __uint_as_float(t.y & 0xffff0000u); }
#pragma unroll
                    for (int k = 0; k < 8; ++k) { const u32x2 t = *(const u32x2*)(YB + ((size_t)m * 8 + k) * DM + c0);
                        y[0] += __uint_as_float(t.x << 16); y[1] += __uint_as_float(t.x & 0xffff0000u); y[2] += __uint_as_float(t.y << 16); y[3] += __uint_as_float(t.y & 0xffff0000u); }
                    const f32x4 x1 = *((const f32x4*)(X1 + (size_t)m * DM) + 64 * j + lane); const f32x4 g2 = *((const f32x4*)(ad + 5 * 1024) + 64 * j + lane);
                    v[j] = x1 * ALPHA + (g2 + 1.f) * y; s += (v[j][0] + v[j][1]) + (v[j][2] + v[j][3]); }
                const float mean = wave_sum(s) * (1.f / DM); float s2 = 0.f;
#pragma unroll
                for (int j = 0; j < 4; ++j) { v[j] = v[j] - mean; s2 += (v[j][0] * v[j][0] + v[j][1] * v[j][1]) + (v[j][2] * v[j][2] + v[j][3] * v[j][3]); }
                const float rstd = 1.f / sqrtf(wave_sum(s2) * (1.f / DM) + LN_EPS);
                f32x4* xo = (f32x4*)(OUT + (size_t)m * DM) + lane; unsigned long long* o8 = (unsigned long long*)(H + (size_t)m * DM) + lane;
                const float* adn = ADA + ((size_t)(l + 1) * 8 + b) * 6144;
#pragma unroll
                for (int j = 0; j < 4; ++j) { const f32x4 gg = *((const f32x4*)lg + 64 * j + lane), bb = *((const f32x4*)lb + 64 * j + lane);
                    const f32x4 xn = v[j] * rstd * gg + bb; xo[64 * j] = xn;
                    if (l + 1 < DEPTH) { const f32x4 sh = *((const f32x4*)(adn) + 64 * j + lane), sc = *((const f32x4*)(adn + 1024) + 64 * j + lane);
                        const f32x4 hv = xn * (sc + 1.f) + sh; o8[64 * j] = (unsigned long long)cvtpk(hv[0], hv[1]) | ((unsigned long long)cvtpk(hv[2], hv[3]) << 32); } } }
        }
        if (l + 1 < DEPTH) GRID_BAR();
    }
}

extern "C" void kernel_launch(void* const* d_in, const int* in_sizes, int n_in, void* d_out, int out_size, void* d_ws, size_t ws_size, hipStream_t stream) {
    static int grid = 0;
    if (grid == 0) {
        if (n_in != 25 || out_size != NTOK * DM || ws_size < WS_END) { fprintf(stderr, "kernel_launch: unexpected shapes (n_in %d, out %d, ws %zu)\n", n_in, out_size, ws_size); grid = -1; return; }
        int dev = 0, cus = 0;
        if (hipGetDevice(&dev) != hipSuccess || hipDeviceGetAttribute(&cus, hipDeviceAttributeMultiprocessorCount, dev) != hipSuccess) { grid = -1; return; }
        if (hipFuncSetAttribute((const void*)mega_fwd, hipFuncAttributeMaxDynamicSharedMemorySize, LDS_BYTES) != hipSuccess) { fprintf(stderr, "kernel_launch: hipFuncSetAttribute failed\n"); grid = -1; return; }
        int per_cu = 0;
        if (hipOccupancyMaxActiveBlocksPerMultiprocessor(&per_cu, (const void*)mega_fwd, 512, LDS_BYTES) != hipSuccess || per_cu < 1) fprintf(stderr, "kernel_launch: occupancy query says %d\n", per_cu);
        (void)hipGetLastError();
        grid = cus;
    }
    if (grid < 0) return;
    if (hipMemsetAsync((char*)d_ws + WS_CTL, 0, CTL_BYTES, stream) != hipSuccess) return;
    Args a{};
    for (int i = 0; i < 25; ++i) a.in[i] = (const float*)d_in[i];
    a.out = (float*)d_out; a.ws = (unsigned char*)d_ws;
    hipLaunchKernelGGL(mega_fwd, dim3(grid), dim3(512), LDS_BYTES, stream, a);
}
```

```cpp
#include <hip/hip_runtime.h>
#include <cstdio>
#include <cstdint>

#define DI __device__ __forceinline__
#define LAS __attribute__((address_space(3)))
#define GAS __attribute__((address_space(1)))
typedef unsigned short bf16_t;
typedef short bf16x8 __attribute__((ext_vector_type(8)));
typedef short s16x4 __attribute__((ext_vector_type(4)));
typedef float f32x2 __attribute__((ext_vector_type(2)));
typedef float f32x4 __attribute__((ext_vector_type(4)));
typedef float f32x16 __attribute__((ext_vector_type(16)));
typedef unsigned u32x2 __attribute__((ext_vector_type(2)));
typedef unsigned u32x4 __attribute__((ext_vector_type(4)));

constexpr int DM = 1024, NB = 8, SEQ = 4096, NTOK = NB * SEQ, DEPTH = 2;
constexpr int D_IN = 2450, QKV_N = 2560;
constexpr int NEXP = 256, TOPK = 8, EDIM = 256;
constexpr float LOG2E = 1.4426950408889634f;
constexpr float C2 = 0.125f * LOG2E;
constexpr float ALPHA = 1.4142135623730951f;
constexpr float LN_EPS = 1e-5f;
constexpr int C_AQ = 0, C_AK = 384, C_AV = 512, C_BQ = 640, C_BKC = 896, C_BVC = 960, C_BKS = 1024, C_BVS = 1088, C_BKW = 1152, C_BVW = 1216,
              C_CQ = 1280, C_CK = 1664, C_CV = 2048, C_SM = 2432;
constexpr int O_A = 0, O_B = 384, O_C = 640;

constexpr size_t MiB = 1u << 20;
constexpr size_t WS_CTL = 0, CTL_BYTES = 1 * MiB;
constexpr size_t WS_ADA = 1 * MiB;
constexpr size_t WS_CPOS = WS_ADA + 512 * 1024;
constexpr size_t WS_KCMP = 2 * MiB;
constexpr size_t WS_VCMP = WS_KCMP + 256 * 1024;
constexpr size_t WS_DC = 3 * MiB;
constexpr size_t WS_KM = 3 * MiB + 832 * 1024;
constexpr size_t WS_WCT = 4 * MiB;
constexpr size_t WS_WIN = 8 * MiB;
constexpr size_t WS_WO = 18 * MiB;
constexpr size_t WS_WSH = 22 * MiB;
constexpr size_t WS_WSD = 25 * MiB;
constexpr size_t WS_WGU = 32 * MiB;
constexpr size_t WS_WD = 544 * MiB;
constexpr size_t WS_H = 800 * MiB;
constexpr size_t WS_X1 = 864 * MiB;
constexpr size_t WS_LOG = 992 * MiB;
constexpr size_t WS_ACTSH = 1024 * MiB;
constexpr size_t WS_YSH = 1040 * MiB;
constexpr size_t WS_DST = 1104 * MiB;
constexpr size_t WS_WL = 1136 * MiB;
constexpr size_t WS_SMALL = 1168 * MiB;
constexpr size_t WS_ACT = 1172 * MiB;
constexpr size_t WS_R1 = 1332 * MiB;
constexpr size_t WS_QKV = WS_R1;
constexpr size_t WS_O = WS_R1 + 160 * MiB;
constexpr size_t WS_V = WS_R1 + 224 * MiB;
constexpr size_t WS_YB = WS_R1;
constexpr size_t WS_END = 1844 * MiB;

constexpr int CW_BAR = 4096;
constexpr int CW_Q = 16384;
constexpr int CW_CNT = 32768;

constexpr int RING_BYTES = 131072;
constexpr int L_MISC = RING_BYTES;
constexpr int L_LUT = L_MISC + 256;
constexpr int L_TP = L_LUT + 5120;
constexpr int L_CNT = L_TP + 1040;
constexpr int L_PT = L_CNT + 1024;
constexpr int L_TPX = L_PT + 256;
constexpr int LDS_BYTES = 147456;
static_assert(L_TPX + 144 <= LDS_BYTES, "LDS map");

DI unsigned cvtpk(float lo, float hi) { typedef __bf16 b2 __attribute__((ext_vector_type(2))); f32x2 v = {lo, hi}; b2 b = __builtin_convertvector(v, b2); return __builtin_bit_cast(unsigned, b); }
DI float bf2f(bf16_t v) { return __uint_as_float((unsigned)v << 16); }
DI float fast_exp2(float x) { return __builtin_amdgcn_exp2f(x); }
DI float sigmoidf_(float x) { return 1.f / (1.f + __expf(-x)); }
DI float siluf_(float x) { return x / (1.f + __expf(-x)); }

#define XB_TMO      128
#define XB_XCNT(j)  (256  + 64 * (j))
#define XB_XSUB(j)  (1280 + 64 * (j))
#define XB_XGEN(j)  (2304 + 64 * (j))
#define XB_TOP      3328
#define XB_TOPGEN   3392
#define XCD_BAR_WORDS 3456
#define XB_SPIN_CAP (1u << 22)

__device__ __forceinline__ unsigned xb_ld(unsigned* p)              { return __hip_atomic_load(p, __ATOMIC_RELAXED, __HIP_MEMORY_SCOPE_AGENT); }
__device__ __forceinline__ unsigned xb_add(unsigned* p, unsigned v) { return __hip_atomic_fetch_add(p, v, __ATOMIC_RELAXED, __HIP_MEMORY_SCOPE_AGENT); }
__device__ __forceinline__ unsigned xb_xcc_id() { return (unsigned)__builtin_amdgcn_s_getreg((3 << 11) | 20) & 0xFu; }
#define XB_SPIN(cond, bar) do { unsigned _sp = 0; while (cond) { __builtin_amdgcn_s_sleep(1); \
    if ((++_sp & 255u) == 0u) { if (xb_ld(&(bar)[XB_TMO])) break; if (_sp > XB_SPIN_CAP) { atomicAdd(&(bar)[XB_TMO], 1u); break; } } } } while (0)

struct XcdBarrier { unsigned* bar; unsigned x; volatile LAS unsigned* st; };

__device__ __forceinline__ XcdBarrier xcd_barrier_post(unsigned* bar, volatile LAS unsigned* st) {
    XcdBarrier b; b.bar = bar; b.x = xb_xcc_id(); b.st = st;
    if (threadIdx.x == 0) (void)xb_add(&bar[XB_XCNT(b.x)], 1u);
    return b;
}
__device__ __forceinline__ void xcd_barrier_complete(unsigned* bar, unsigned x, unsigned& nloc, unsigned& nx) {
    const unsigned G = gridDim.x * gridDim.y * gridDim.z;
    unsigned sum, cnt, mine, sp = 0u;
    for (;;) {
        sum = 0u; cnt = 0u; mine = 0u;
#pragma unroll
        for (unsigned j = 0; j < 16; ++j) { const unsigned c = xb_ld(&bar[XB_XCNT(j)]); sum += c; cnt += (c > 0u) ? 1u : 0u; mine = (j == x) ? c : mine; }
        if (sum == G) break;
        __builtin_amdgcn_s_sleep(1);
        if ((++sp & 255u) == 0u) { if (xb_ld(&bar[XB_TMO])) break; if (sp > XB_SPIN_CAP) { atomicAdd(&bar[XB_TMO], 1u); break; } }
    }
    nloc = mine > 0u ? mine : 1u; nx = cnt > 0u ? cnt : 1u;
}
__device__ __forceinline__ void xcd_barrier(const XcdBarrier& b, bool leader_thread) {
    asm volatile("s_waitcnt vmcnt(0)" ::: "memory");
    __syncthreads();
    if (leader_thread) {
        unsigned* bar = b.bar;
        __builtin_amdgcn_s_waitcnt(0);
        unsigned nloc = b.st[0], nx = b.st[1];
        if (nloc == 0u) { xcd_barrier_complete(bar, b.x, nloc, nx); b.st[0] = nloc; b.st[1] = nx; }
        const unsigned old = xb_add(&bar[XB_XSUB(b.x)], 1u);
        const unsigned gen = old / nloc;
        if (old + 1u == (gen + 1u) * nloc) {
            __builtin_amdgcn_fence(__ATOMIC_RELEASE, "agent");
            asm volatile("s_waitcnt vmcnt(0)" ::: "memory");
            const unsigned og = xb_add(&bar[XB_TOP], 1u);
            const unsigned tg = og / nx;
            if (og + 1u == (tg + 1u) * nx) xb_add(&bar[XB_TOPGEN], 1u);
            else XB_SPIN(xb_ld(&bar[XB_TOPGEN]) == tg, bar);
            __builtin_amdgcn_fence(__ATOMIC_ACQUIRE, "agent");
            xb_add(&bar[XB_XGEN(b.x)], 1u);
            asm volatile("s_waitcnt vmcnt(0)" ::: "memory");
        } else {
            XB_SPIN(xb_ld(&bar[XB_XGEN(b.x)]) == gen, bar);
            __builtin_amdgcn_fence(__ATOMIC_ACQUIRE, "agent");
            asm volatile("s_waitcnt vmcnt(0)" ::: "memory");
        }
    }
    __syncthreads();
}

namespace pg8 {
constexpr int BM = 256, BK = 64, HALF = 128, HTB = HALF * BK * 2, STAGE_BYTES = 8 * HTB, NXCD = 8, WGM = 8;
__host__ __device__ __forceinline__ int lds_byte(int r, int c) { const int st = (r >> 4) * 2 + (c >> 5), rr = r & 15, cc = c & 31, ob = rr * 64 + cc * 2; return st * 1024 + (ob ^ (((ob >> 9) & 1) << 5)); }
__host__ __device__ __forceinline__ void stage_rc(int b, int& R, int& C) { const int st = b / 1024, sb = b % 1024, swz = sb ^ (((sb >> 9) & 1) << 5); R = (st >> 1) * 16 + swz / 64; C = (st & 1) * 32 + (swz % 64) / 2; }
__host__ __device__ __forceinline__ int perm32(int rho) { const int n = rho >> 4, i = rho & 15; return 8 * (i >> 2) + 4 * n + (i & 3); }

struct Unit { int pm, pn, e, lrow0, cnt; };
struct Gemm { const bf16_t* A; const bf16_t* Bt; int K; };

struct StaticOrder {
    int nM, nN, nwg, G, c;
    DI void init(int M, int N, int G_, int c_) { nM = M / BM; nN = N / BM; nwg = nM * nN; G = G_; c = c_; }
    DI bool next(int i, Unit& u) const {
        const long L = (long)i * G + c; if (L >= nwg) return false;
        int wgid = (int)L; { const int q = nwg / NXCD, r = nwg % NXCD, xcd = wgid % NXCD, off = wgid / NXCD; wgid = (xcd < r ? xcd * (q + 1) : r * (q + 1) + (xcd - r) * q) + off; }
        const int nig = WGM * nN, gid = wgid / nig, fm = gid * WGM, gsz = (nM - fm) < WGM ? (nM - fm) : WGM;
        u.pm = fm + ((wgid % nig) % gsz); u.pn = (wgid % nig) / gsz; u.e = 0; u.lrow0 = 0; u.cnt = 0; return true;
    }
    static constexpr bool GATHER = false;
    DI unsigned tokpair(const Unit&, int, int) const { return 0u; }
};
template <bool GATHER_> struct GroupedOrder {
    static constexpr bool GATHER = GATHER_;
    const LAS int* TP; const LAS int* TPX; const LAS int* CNT; int NT, nwx, rk, x; const int* list;
    DI bool next(int i, Unit& u) const {
        const int total = TPX[32] * NT; const int L = i * nwx + rk; if (L >= total) return false;
        const int mt = L / NT, nt = L - mt * NT;
        int lo = 0, hi = 31;
        while (lo < hi) { const int mid = (lo + hi + 1) >> 1; if (TPX[mid] <= mt) lo = mid; else hi = mid - 1; }
        const int e = 8 * lo + x, ml = mt - TPX[lo];
        u.pm = __builtin_amdgcn_readfirstlane(TP[e] + ml); u.pn = __builtin_amdgcn_readfirstlane(e * NT + nt); u.e = __builtin_amdgcn_readfirstlane(e);
        u.lrow0 = __builtin_amdgcn_readfirstlane(ml * BM); u.cnt = __builtin_amdgcn_readfirstlane(CNT[e]); return true;
    }
    DI unsigned tokpair(const Unit& u, int R0, int) const {
        int l0 = u.lrow0 + R0, l1 = l0 + HALF; l0 = l0 < u.cnt ? l0 : u.cnt - 1; l1 = l1 < u.cnt ? l1 : u.cnt - 1;
        const unsigned t0 = (unsigned)(list[u.e * NTOK + l0] >> 3), t1 = (unsigned)(list[u.e * NTOK + l1] >> 3); return t0 | (t1 << 16);
    }
};

template <class Epi, class Sched>
__device__ __forceinline__ void gemm_phase(LAS unsigned char* lds, const Gemm g, const Sched& S, const Epi& E, int wid_) {
    int lane; asm volatile("v_mbcnt_lo_u32_b32 %0, -1, 0\n\tv_mbcnt_hi_u32_b32 %0, -1, %0" : "=v"(lane));
    int wid = wid_; asm volatile("" : "+s"(wid)); const int tid = wid * 64 + lane, wr = wid >> 2, wc = wid & 3, fr = lane & 15, fq = lane >> 4;
    const int K = g.K, nt = K / BK;
    constexpr bool GA = Sched::GATHER;
    unsigned voffA[2], voffB[2]; int RA[2];
#pragma unroll
    for (int i = 0; i < 2; ++i) { int R, C; stage_rc(tid * 16 + i * 8192, R, C); const int Rb = Epi::PERM ? ((R & ~31) + perm32(R & 31)) : R;
        RA[i] = R; voffA[i] = GA ? (unsigned)(C * 2) : (unsigned)(R * K + C) * 2u; voffB[i] = (unsigned)(Rb * K + C) * 2u; }
    const size_t kstep = (size_t)(BK * 2);
    const size_t hstep = (size_t)HALF * K * 2;
    const size_t tstep = 2 * hstep;
    const unsigned ldsw = (unsigned)wid * 1024u;
    const int aoff = lds_byte(wr * 64 + fr, fq * 8), boff = lds_byte(wc * 32 + fr, fq * 8);
#define PG8_SA(b, h) (((b) * 2 + (h)) * HTB)
#define PG8_SB(b, h) ((4 + (b) * 2 + (h)) * HTB)
#define PG8_STAGE(bufoff, gbase, voff) do { _Pragma("unroll") for (int _i = 0; _i < 2; ++_i) \
        __builtin_amdgcn_global_load_lds((const unsigned*)((const char*)(gbase) + (voff)[_i]), (LAS unsigned*)(lds + (bufoff) + ldsw + _i * 8192), 16, 0, 0); } while (0)
#define PG8_STAGEA(bufoff, ubase, tp, hh, kb) do { _Pragma("unroll") for (int _i = 0; _i < 2; ++_i) { \
        const char* _p = GA ? ((const char*)g.A + (size_t)(kb) + (size_t)((((tp)[_i] >> (16 * (hh))) & 0xffffu) * (unsigned)(K * 2)) + voffA[_i]) : ((ubase) + (size_t)(hh) * hstep + (size_t)(kb) + voffA[_i]); \
        __builtin_amdgcn_global_load_lds((const unsigned*)_p, (LAS unsigned*)(lds + (bufoff) + ldsw + _i * 8192), 16, 0, 0); } } while (0)
#define PG8_LDA(dst, b, h) do { _Pragma("unroll") for (int m = 0; m < 4; ++m) _Pragma("unroll") for (int k = 0; k < 2; ++k) dst[m][k] = *(const LAS bf16x8*)(lds + PG8_SA(b, h) + aoff + m * 2048 + k * 1024); } while (0)
#define PG8_LDB(dst, b, h) do { _Pragma("unroll") for (int n = 0; n < 2; ++n) _Pragma("unroll") for (int k = 0; k < 2; ++k) dst[n][k] = *(const LAS bf16x8*)(lds + PG8_SB(b, h) + boff + n * 2048 + k * 1024); } while (0)
#define PG8_MMA(ai, bj, At, Bt) do { __builtin_amdgcn_s_setprio(1); _Pragma("unroll") for (int m = 0; m < 4; ++m) _Pragma("unroll") for (int n = 0; n < 2; ++n) _Pragma("unroll") for (int k = 0; k < 2; ++k) \
        acc[ai][bj][m][n] = __builtin_amdgcn_mfma_f32_16x16x32_bf16(Bt[n][k], At[m][k], acc[ai][bj][m][n], 0, 0, 0); __builtin_amdgcn_s_setprio(0); } while (0)
#define PG8_WAIT_V(n) asm volatile("s_waitcnt vmcnt(" #n ")" ::: "memory")
#define PG8_WAIT_L(n) asm volatile("s_waitcnt lgkmcnt(" #n ")" ::: "memory")
#define PG8_BAR __builtin_amdgcn_s_barrier()
#define PG8_SCHED __builtin_amdgcn_sched_barrier(0)
    Unit cur, nxt; int ui = 0;
    if (!S.next(0, cur)) return;
    f32x4 acc[2][2][4][2];
#pragma unroll
    for (int a = 0; a < 2; ++a)
#pragma unroll
        for (int b = 0; b < 2; ++b)
#pragma unroll
            for (int m = 0; m < 4; ++m)
#pragma unroll
                for (int n = 0; n < 2; ++n) acc[a][b][m][n] = (f32x4){0.f, 0.f, 0.f, 0.f};
    bf16x8 At[4][2], B0[2][2], B1[2][2];
    unsigned tpc[2] = {0u, 0u}, tpn[2] = {0u, 0u};
    if (GA) {
#pragma unroll
        for (int i = 0; i < 2; ++i) tpc[i] = S.tokpair(cur, RA[i], 0); }
#define PG8_FRESH_R(i, Rv) int Rv; { int l2_; asm volatile("v_mbcnt_lo_u32_b32 %0, -1, 0\n\tv_mbcnt_hi_u32_b32 %0, -1, %0" : "=v"(l2_)); int C2_; stage_rc((wid * 64 + l2_) * 16 + (i) * 8192, Rv, C2_); }
    const char* cA = GA ? (const char*)g.A : (const char*)g.A + (size_t)cur.pm * tstep; const char* cB = (const char*)g.Bt + (size_t)cur.pn * tstep;
    {
        PG8_STAGE(PG8_SB(0, 0), cB, voffB); PG8_STAGE(PG8_SB(0, 1), cB + hstep, voffB); PG8_STAGEA(PG8_SA(0, 0), cA, tpc, 0, 0); PG8_STAGEA(PG8_SA(0, 1), cA, tpc, 1, 0);
        if (wr == 1) PG8_BAR;
        PG8_WAIT_V(2); PG8_BAR;
        PG8_STAGE(PG8_SB(1, 0), cB + kstep, voffB); PG8_STAGEA(PG8_SA(1, 0), cA, tpc, 0, kstep); PG8_STAGE(PG8_SB(1, 1), cB + hstep + kstep, voffB);
        PG8_WAIT_V(6); PG8_BAR;
    }
    for (;;) {
        const bool has_next = S.next(ui + 1, nxt);
        const char* nA = GA ? cA : (has_next ? (const char*)g.A + (size_t)nxt.pm * tstep : cA); const char* nB = has_next ? (const char*)g.Bt + (size_t)nxt.pn * tstep : cB;
        if (GA) {
#pragma unroll
            for (int i = 0; i < 2; ++i) { if (has_next) { PG8_FRESH_R(i, Rn_); tpn[i] = S.tokpair(nxt, Rn_, 0); } else tpn[i] = tpc[i]; } }
#pragma unroll 1
        for (int t = 0; t < nt; t += 2) {
            const bool last = (t == nt - 2);
            const size_t k1 = (size_t)(t + 1) * kstep;
            const size_t k2 = last ? 0 : (size_t)(t + 2) * kstep; const size_t k3 = k2 + kstep;
            const char* a2 = last ? nA : cA;
            unsigned tp2[2];
#pragma unroll
            for (int i = 0; i < 2; ++i) tp2[i] = last ? tpn[i] : tpc[i];
            const char* b2 = last ? nB : cB + (size_t)(t + 2) * kstep;
            const char* b3 = b2 + kstep;
            PG8_LDB(B0, 0, 0); PG8_LDB(B1, 0, 1); PG8_SCHED; PG8_LDA(At, 0, 0); PG8_STAGEA(PG8_SA(1, 1), cA, tpc, 1, k1);
            PG8_WAIT_V(8); PG8_WAIT_L(0); PG8_BAR; PG8_MMA(0, 0, At, B0); PG8_MMA(0, 1, At, B1); PG8_BAR; PG8_SCHED;
            PG8_LDA(At, 0, 1); PG8_STAGE(PG8_SB(0, 0), b2, voffB); PG8_STAGE(PG8_SB(0, 1), b2 + hstep, voffB); PG8_STAGEA(PG8_SA(0, 0), a2, tp2, 0, k2);
            PG8_WAIT_V(8); PG8_WAIT_L(0); PG8_BAR; PG8_MMA(1, 0, At, B0); PG8_MMA(1, 1, At, B1); PG8_BAR; PG8_SCHED;
            PG8_LDB(B0, 1, 0); PG8_LDB(B1, 1, 1); PG8_SCHED; PG8_LDA(At, 1, 0); PG8_STAGEA(PG8_SA(0, 1), a2, tp2, 1, k2);
            PG8_WAIT_V(8); PG8_WAIT_L(0); PG8_BAR; PG8_MMA(0, 0, At, B0); PG8_MMA(0, 1, At, B1); PG8_BAR; PG8_SCHED;
            PG8_LDA(At, 1, 1); PG8_STAGE(PG8_SB(1, 0), b3, voffB); PG8_STAGE(PG8_SB(1, 1), b3 + hstep, voffB); PG8_STAGEA(PG8_SA(1, 0), a2, tp2, 0, k3);
            PG8_WAIT_V(8); PG8_WAIT_L(0); PG8_BAR; PG8_MMA(1, 0, At, B0); PG8_MMA(1, 1, At, B1); PG8_BAR; PG8_SCHED;
        }
        if (wr == 0) PG8_BAR;
        E(acc, cur, wr, wc, fr, fq);
        if (!has_next) break;
#pragma unroll
        for (int a = 0; a < 2; ++a)
#pragma unroll
            for (int b = 0; b < 2; ++b)
#pragma unroll
                for (int m = 0; m < 4; ++m)
#pragma unroll
                    for (int n = 0; n < 2; ++n) acc[a][b][m][n] = (f32x4){0.f, 0.f, 0.f, 0.f};
        cur = nxt; cA = nA; cB = nB; ++ui;
#pragma unroll
        for (int i = 0; i < 2; ++i) tpc[i] = tpn[i];
        if (wr == 1) PG8_BAR;
    }
    PG8_WAIT_V(0);
    PG8_BAR;
#undef PG8_SA
#undef PG8_SB
#undef PG8_STAGE
#undef PG8_STAGEA
#undef PG8_FRESH_R
#undef PG8_LDA
#undef PG8_LDB
#undef PG8_MMA
#undef PG8_WAIT_V
#undef PG8_WAIT_L
#undef PG8_BAR
#undef PG8_SCHED
}

DI u32x4 pack8(const f32x4& v0, const f32x4& v1) { u32x4 w; w.x = cvtpk(v0[0], v0[1]); w.y = cvtpk(v0[2], v0[3]); w.z = cvtpk(v1[0], v1[1]); w.w = cvtpk(v1[2], v1[3]); return w; }

struct EpiQKV { static constexpr bool PERM = true;
    bf16_t* O; float* SM;
    DI void operator()(const f32x4 (&acc)[2][2][4][2], const Unit& u, int wr, int wc, int fr, int fq) const {
        const int row0 = u.pm * BM + wr * 64 + fr, colt = u.pn * BM + wc * 32 + 8 * fq;
#pragma unroll
        for (int bj = 0; bj < 2; ++bj) { const int col = colt + bj * HALF;
            const bool isq = (col < C_AK) || (col >= C_BQ && col < C_BKC) || (col >= C_CQ && col < C_CK);
            const float sc = isq ? C2 : 1.f; const bool sm = (col >= C_SM && col < C_SM + 32);
#pragma unroll
            for (int ai = 0; ai < 2; ++ai)
#pragma unroll
                for (int m = 0; m < 4; ++m) { const int row = row0 + ai * HALF + m * 16;
                    const f32x4 v0 = acc[ai][bj][m][0] * sc, v1 = acc[ai][bj][m][1] * sc;
                    *(u32x4*)(O + (size_t)row * QKV_N + col) = pack8(v0, v1);
                    if (sm) { float* sp = SM + (size_t)row * 32 + (col - C_SM); *(f32x4*)sp = v0; *(f32x4*)(sp + 4) = v1; } } }
    }
};
struct EpiWO { static constexpr bool PERM = false;
    const float* xin; float* V; const float* g1;
    DI void operator()(const f32x4 (&acc)[2][2][4][2], const Unit& u, int wr, int wc, int fr, int fq) const {
        const int row0 = u.pm * BM + wr * 64 + fr, col0 = u.pn * BM + wc * 32 + 4 * fq; const int b = (u.pm * BM) >> 12;
#pragma unroll
        for (int bj = 0; bj < 2; ++bj)
#pragma unroll
            for (int n = 0; n < 2; ++n) { const int col = col0 + bj * HALF + n * 16; const f32x4 gg = *(const f32x4*)(g1 + (size_t)b * 6144 + col) + 1.f;
#pragma unroll
                for (int ai = 0; ai < 2; ++ai)
#pragma unroll
                    for (int m = 0; m < 4; ++m) { const size_t off = (size_t)(row0 + ai * HALF + m * 16) * DM + col;
                        const f32x4 xv = *(const f32x4*)(xin + off); *(f32x4*)(V + off) = xv * ALPHA + gg * acc[ai][bj][m][n]; } }
    }
};
DI f32x4 swiglu4(const f32x4& g, const f32x4& u) { f32x4 r; r[0] = siluf_(g[0]) * u[0]; r[1] = siluf_(g[1]) * u[1]; r[2] = siluf_(g[2]) * u[2]; r[3] = siluf_(g[3]) * u[3]; return r; }
struct EpiSH { static constexpr bool PERM = true;
    float* LOG; bf16_t* ACT;
    DI void operator()(const f32x4 (&acc)[2][2][4][2], const Unit& u, int wr, int wc, int fr, int fq) const {
        const int row0 = u.pm * BM + wr * 64 + fr, c8 = wc * 32 + 8 * fq;
        if (u.pn == 0) {
#pragma unroll
            for (int bj = 0; bj < 2; ++bj)
#pragma unroll
                for (int ai = 0; ai < 2; ++ai)
#pragma unroll
                    for (int m = 0; m < 4; ++m) { float* p = LOG + (size_t)(row0 + ai * HALF + m * 16) * 256 + bj * HALF + c8; *(f32x4*)p = acc[ai][bj][m][0]; *(f32x4*)(p + 4) = acc[ai][bj][m][1]; }
        } else {
            const int cb = (u.pn - 1) * HALF + c8;
#pragma unroll
            for (int ai = 0; ai < 2; ++ai)
#pragma unroll
                for (int m = 0; m < 4; ++m) { const f32x4 a0 = swiglu4(acc[ai][0][m][0], acc[ai][1][m][0]), a1 = swiglu4(acc[ai][0][m][1], acc[ai][1][m][1]);
                    *(u32x4*)(ACT + (size_t)(row0 + ai * HALF + m * 16) * 256 + cb) = pack8(a0, a1); }
        }
    }
};
struct EpiGU { static constexpr bool PERM = true;
    bf16_t* ACT;
    DI void operator()(const f32x4 (&acc)[2][2][4][2], const Unit& u, int wr, int wc, int fr, int fq) const {
        const int rin0 = wr * 64 + fr, cb = (u.pn & 1) * HALF + wc * 32 + 8 * fq;
#pragma unroll
        for (int ai = 0; ai < 2; ++ai)
#pragma unroll
            for (int m = 0; m < 4; ++m) { const int rin = rin0 + ai * HALF + m * 16;
                if (u.lrow0 + rin < u.cnt) { const f32x4 a0 = swiglu4(acc[ai][0][m][0], acc[ai][1][m][0]), a1 = swiglu4(acc[ai][0][m][1], acc[ai][1][m][1]);
                    *(u32x4*)(ACT + (size_t)(u.pm * BM + rin) * 256 + cb) = pack8(a0, a1); } }
    }
};
struct EpiDown { static constexpr bool PERM = true;
    bf16_t* YB; const int* DST; const float* WL;
    DI void operator()(const f32x4 (&acc)[2][2][4][2], const Unit& u, int wr, int wc, int fr, int fq) const {
        const int rin0 = wr * 64 + fr, cb = (u.pn & 3) * BM + wc * 32 + 8 * fq;
#pragma unroll
        for (int ai = 0; ai < 2; ++ai)
#pragma unroll
            for (int m = 0; m < 4; ++m) { const int local = u.lrow0 + rin0 + ai * HALF + m * 16;
                if (local < u.cnt) { const int dst = DST[(size_t)u.e * NTOK + local]; const float w = WL[(size_t)u.e * NTOK + local];
#pragma unroll
                    for (int bj = 0; bj < 2; ++bj) *(u32x4*)(YB + (size_t)dst * DM + cb + bj * HALF) = pack8(acc[ai][bj][m][0] * w, acc[ai][bj][m][1] * w); } }
    }
};
struct EpiShDown { static constexpr bool PERM = true;
    bf16_t* Y;
    DI void operator()(const f32x4 (&acc)[2][2][4][2], const Unit& u, int wr, int wc, int fr, int fq) const {
        const int row0 = u.pm * BM + wr * 64 + fr, cb = u.pn * BM + wc * 32 + 8 * fq;
#pragma unroll
        for (int ai = 0; ai < 2; ++ai)
#pragma unroll
            for (int m = 0; m < 4; ++m)
#pragma unroll
                for (int bj = 0; bj < 2; ++bj) *(u32x4*)(Y + (size_t)(row0 + ai * HALF + m * 16) * DM + cb + bj * HALF) = pack8(acc[ai][bj][m][0], acc[ai][bj][m][1]);
    }
};
}

namespace att {
#define MFMA32(a, b, c) __builtin_amdgcn_mfma_f32_32x32x16_bf16((a), (b), (c), 0, 0, 0)
constexpr int A_KB = 0, A_VB = 16384, A_IMP = 32768, A_SEL = A_IMP + 4 * 64 * 65 * 4  , A_DK = A_SEL + 512, A_NEED = A_DK + 512, A_KM = A_NEED + 64, A_END = A_KM + 512;
static_assert(A_END <= RING_BYTES, "attention LDS");
constexpr float NEGINF = -__builtin_inff();
enum { M_BAND = 0, M_SLC = 1, M_FOX = 2, M_CMP1 = 3, M_CMP2 = 4 };
typedef short v4i16_t __attribute__((ext_vector_type(4)));
DI s16x4 vtr(LAS const char* p) { return __builtin_bit_cast(s16x4, __builtin_amdgcn_ds_read_tr16_b64_v4i16((LAS v4i16_t*)p)); }
DI int cofs(int i) { return (i & 3) + 8 * (i >> 2); }

struct Acc { f32x16 o0, o1; float m, l; };
struct PassArgs {
    const bf16_t* Kg; const bf16_t* Vg; int pitch;
    int jfirst, ntiles, step;
    int tq0;
    const LAS float* lut;
    unsigned long long sel;
    float dq; const float* dkg;
    float qn; const float* km;
    float fm, frl;
    LAS float* imp;
};

DI void qk_tile(f32x16& p0, f32x16& p1, LAS const char* kb, const bf16x8 (&qr)[4], int r, int h) {
#pragma unroll
    for (int i = 0; i < 16; ++i) { p0[i] = 0.f; p1[i] = 0.f; }
    LAS const char* rp = kb + r * 128;
#pragma unroll
    for (int s = 0; s < 4; ++s) { const int o = 16 * ((2 * s + h) ^ (r & 7));
        const bf16x8 a0 = *(const LAS bf16x8*)(rp + o), a1 = *(const LAS bf16x8*)(rp + 4096 + o);
        p0 = MFMA32(a0, qr[s], p0); p1 = MFMA32(a1, qr[s], p1); }
}
DI bf16x8 pack_step(const f32x16& x, int s) { u32x4 p; p.x = cvtpk(x[8 * s], x[8 * s + 1]); p.y = cvtpk(x[8 * s + 2], x[8 * s + 3]); p.z = cvtpk(x[8 * s + 4], x[8 * s + 5]); p.w = cvtpk(x[8 * s + 6], x[8 * s + 7]); return __builtin_bit_cast(bf16x8, p); }
DI void pv_tile(f32x16& o0, f32x16& o1, const f32x16& p0, const f32x16& p1, LAS const char* va0, LAS const char* va1) {
#pragma unroll
    for (int blk = 0; blk < 2; ++blk)
#pragma unroll
        for (int s = 0; s < 2; ++s) { const bf16x8 xs = pack_step(blk ? p1 : p0, s); const int ro = (32 * blk + 16 * s) * 128;
            { const s16x4 lo = vtr(va0 + ro), hi = vtr(va0 + ro + 1024); const bf16x8 vf = __builtin_shufflevector(lo, hi, 0, 1, 2, 3, 4, 5, 6, 7); o0 = MFMA32(vf, xs, o0); }
            { const s16x4 lo = vtr(va1 + ro), hi = vtr(va1 + ro + 1024); const bf16x8 vf = __builtin_shufflevector(lo, hi, 0, 1, 2, 3, 4, 5, 6, 7); o1 = MFMA32(vf, xs, o1); } }
}

template <int MODE, int W>
DI void attn_pass(LAS char* lds, const PassArgs& P, const bf16x8 (&qr)[4], Acc& a, int tid_, int lane_) {
    int lane; asm volatile("v_mbcnt_lo_u32_b32 %0, -1, 0\n\tv_mbcnt_hi_u32_b32 %0, -1, %0" : "=v"(lane)); const int tid = (tid_ & ~63) | lane; (void)lane_;
    const int r = lane & 31, h = lane >> 5;
    const int lrow = tid >> 3, lch = tid & 7;
    const size_t goff = (size_t)lrow * P.pitch + lch * 8;
    const int kdst = lrow * 128 + 16 * (lch ^ (lrow & 7)), vdst = lrow * 128 + 16 * (lch ^ (((lrow >> 1) & 1) << 2));
    const int q4 = (lane & 15) >> 2, p4 = lane & 3, g1 = (lane >> 4) & 1, swb = (q4 >> 1) & 1;
    const int vofs0 = (4 * h + q4) * 128 + 16 * (4 * (0 ^ swb) + 2 * g1 + (p4 >> 1)) + 8 * (p4 & 1);
    const int vofs1 = (4 * h + q4) * 128 + 16 * (4 * (1 ^ swb) + 2 * g1 + (p4 >> 1)) + 8 * (p4 & 1);
    const int tq = P.tq0 + r;
    u32x4 kr, vr;
    { const size_t t0 = (size_t)P.jfirst * 64 * P.pitch + goff; kr = *(const GAS u32x4*)(P.Kg + t0); vr = *(const GAS u32x4*)(P.Vg + t0); }
    f32x4 dkr = {0.f, 0.f, 0.f, 0.f};
    if (MODE == M_FOX) { if (tid < 16) { dkr = *(const GAS f32x4*)(P.dkg + 64 * P.jfirst + 4 * tid); *(LAS f32x4*)(lds + A_DK + 16 * tid) = dkr; } if (tid == 0) { unsigned z_ = 0u; asm volatile("" : "+v"(z_)); *(LAS unsigned*)(lds + A_NEED) = z_; *(LAS unsigned*)(lds + A_NEED + 4) = z_; *(LAS unsigned*)(lds + A_NEED + 8) = z_; }
        if (tid < 64) { *(LAS float*)(lds + A_KM + 4 * tid) = P.km[tid]; *(LAS float*)(lds + A_KM + 256 + 4 * tid) = P.dkg[64 * tid + 63]; } }
    bool wdone = false;
    *(LAS u32x4*)(lds + A_KB + kdst) = kr; *(LAS u32x4*)(lds + A_VB + vdst) = vr;
    __syncthreads();
    float carry = 0.f;
    for (int it = 0; it < P.ntiles; ++it) {
        const int j = P.jfirst + it * P.step, buf = it & 1;
        const bool more = (it + 1 < P.ntiles);
        if (more) { const size_t t0 = (size_t)(j + P.step) * 64 * P.pitch + goff; kr = *(const GAS u32x4*)(P.Kg + t0); vr = *(const GAS u32x4*)(P.Vg + t0);
            if (MODE == M_FOX) { if (tid < 16) dkr = *(const GAS f32x4*)(P.dkg + 64 * (j + P.step) + 4 * tid); } }
        const int kv0 = 64 * j;
        bool skip;
        if (MODE == M_BAND) skip = (kv0 > P.tq0 + 31) || (kv0 + 63 < P.tq0 - (W - 1));
        else if (MODE == M_SLC) skip = (kv0 > P.tq0 + 31) || (__ballot((P.sel >> j) & 1ull) == 0ull);
        else if (MODE == M_FOX) skip = (kv0 > P.tq0 + 31) || wdone;
        else skip = (1024 * j > P.tq0);
        if (!skip) {
            LAS const char* kb = lds + A_KB + buf * 8192; LAS const char* vb = lds + A_VB + buf * 8192;
            f32x16 p0, p1; qk_tile(p0, p1, kb, qr, r, h);
            if (MODE == M_BAND || MODE == M_SLC) {
                const bool far = (P.tq0 - (kv0 + 63) >= 127) && (MODE == M_SLC || (P.tq0 + 31 - kv0 < W));
                if (far) { const float c = P.lut[127];
#pragma unroll
                    for (int i = 0; i < 16; ++i) { p0[i] += c; p1[i] += c; }
                } else { const int base = tq - kv0 - 4 * h;
#pragma unroll
                    for (int i = 0; i < 16; ++i) {
                        { const int rel = base - cofs(i); const bool ok = (MODE == M_SLC) ? (rel >= 0) : ((unsigned)rel < (unsigned)W); int ix = rel < 127 ? rel : 127; ix = ix > 0 ? ix : 0; p0[i] = ok ? p0[i] + P.lut[ix] : NEGINF; }
                        { const int rel = base - 32 - cofs(i); const bool ok = (MODE == M_SLC) ? (rel >= 0) : ((unsigned)rel < (unsigned)W); int ix = rel < 127 ? rel : 127; ix = ix > 0 ? ix : 0; p1[i] = ok ? p1[i] + P.lut[ix] : NEGINF; } }
                }
                if (MODE == M_SLC) { if (!((P.sel >> j) & 1ull)) {
#pragma unroll
                    for (int i = 0; i < 16; ++i) { p0[i] = NEGINF; p1[i] = NEGINF; } } }
            } else if (MODE == M_FOX) {
                const bool full = (kv0 + 63 <= P.tq0); const int base = tq - kv0 - 4 * h;
#pragma unroll
                for (int k = 0; k < 4; ++k) { const f32x4 d0 = *(const LAS f32x4*)(lds + A_DK + buf * 256 + (8 * k + 4 * h) * 4), d1 = *(const LAS f32x4*)(lds + A_DK + buf * 256 + (32 + 8 * k + 4 * h) * 4);
#pragma unroll
                    for (int e = 0; e < 4; ++e) { const int i = 4 * k + e; const int rel = base - cofs(i);
                        const float v0 = p0[i] + (P.dq - d0[e]), v1 = p1[i] + (P.dq - d1[e]);
                        p0[i] = (full || rel >= 0) ? v0 : NEGINF; p1[i] = (full || rel - 32 >= 0) ? v1 : NEGINF; } }
            } else {
                const int base = tq - 31 - 16 * (64 * j + 4 * h);
#pragma unroll
                for (int i = 0; i < 16; ++i) {
                    { const int rel = base - 16 * cofs(i); const bool ok = rel >= 0; int ix = rel < 127 ? rel : 127; ix = ix > 0 ? ix : 0; p0[i] = ok ? p0[i] + P.lut[ix] : NEGINF; }
                    { const int rel = base - 512 - 16 * cofs(i); const bool ok = rel >= 0; int ix = rel < 127 ? rel : 127; ix = ix > 0 ? ix : 0; p1[i] = ok ? p1[i] + P.lut[ix] : NEGINF; } }
            }
            if (MODE != M_CMP2) {
                float tm = fmaxf(p0[0], p1[0]);
#pragma unroll
                for (int i = 1; i < 16; ++i) tm = fmaxf(tm, fmaxf(p0[i], p1[i]));
                tm = fmaxf(tm, __shfl_xor(tm, 32));
                const float mn = fmaxf(a.m, tm);
                const float alpha = fast_exp2(a.m - mn);
                a.m = mn;
                if (__any(alpha != 1.f)) { a.l *= alpha;
                    if (MODE != M_CMP1) {
#pragma unroll
                        for (int i = 0; i < 16; ++i) { a.o0[i] *= alpha; a.o1[i] *= alpha; } } }
                float s = 0.f;
#pragma unroll
                for (int i = 0; i < 16; ++i) { p0[i] = fast_exp2(p0[i] - mn); p1[i] = fast_exp2(p1[i] - mn); s += p0[i] + p1[i]; }
                a.l += s;
                if (MODE != M_CMP1) pv_tile(a.o0, a.o1, p0, p1, vb + vofs0, vb + vofs1);
            } else {
#pragma unroll
                for (int i = 0; i < 16; ++i) { p0[i] = fast_exp2(p0[i] - P.fm) * P.frl; p1[i] = fast_exp2(p1[i] - P.fm) * P.frl; }
                float a8[8], b8[8];
#pragma unroll
                for (int k = 0; k < 4; ++k) { a8[k] = p0[4 * k] + p0[4 * k + 1] + p0[4 * k + 2] + 0.5f * p0[4 * k + 3]; b8[k] = 0.5f * p0[4 * k + 3];
                    a8[4 + k] = p1[4 * k] + p1[4 * k + 1] + p1[4 * k + 2] + 0.5f * p1[4 * k + 3]; b8[4 + k] = 0.5f * p1[4 * k + 3]; }
                float bs[8];
#pragma unroll
                for (int k = 0; k < 8; ++k) bs[k] = __shfl_xor(b8[k], 32);
#pragma unroll
                for (int k = 0; k < 8; ++k) { const float prev = (k == 0) ? carry : bs[k > 0 ? k - 1 : 0]; P.imp[16 * j + 2 * k + h] = a8[k] + (h ? bs[k] : prev); }
                carry = bs[7];
                pv_tile(a.o0, a.o1, p0, p1, vb + vofs0, vb + vofs1);
            }
        } else if (MODE == M_CMP2) {
            if (h == 0) P.imp[16 * j] = carry;
            carry = 0.f;
        }
        if (more) { *(LAS u32x4*)(lds + A_KB + (buf ^ 1) * 8192 + kdst) = kr; *(LAS u32x4*)(lds + A_VB + (buf ^ 1) * 8192 + vdst) = vr;
            if (MODE == M_FOX) { if (tid < 16) *(LAS f32x4*)(lds + A_DK + (buf ^ 1) * 256 + 16 * tid) = dkr; } }
        if (MODE == M_FOX) {
            const int slot = it % 3, nslot = (it + 1) % 3;
            if (more) { const int jn = j + P.step;
                if (!wdone) { const float bound = P.qn * *(LAS float*)(lds + A_KM + 4 * jn) * 1.001f + (P.dq - *(LAS float*)(lds + A_KM + 256 + 4 * jn));
                    const bool need = (bound >= a.m - 40.f);
                    if (__any(need)) { if (lane == 0) *(LAS unsigned*)(lds + A_NEED + 4 * slot) = 1u; } else wdone = true; } }
            if (tid == 0) *(LAS unsigned*)(lds + A_NEED + 4 * nslot) = 0u;
            __syncthreads();
            if (more && *(LAS unsigned*)(lds + A_NEED + 4 * slot) == 0u) break;
        } else {
            __syncthreads();
        }
    }
}
DI void acc_init(Acc& a, float m0, float l0) {
#pragma unroll
    for (int i = 0; i < 16; ++i) { a.o0[i] = 0.f; a.o1[i] = 0.f; }
    a.m = m0; a.l = l0;
}
DI void load_q(bf16x8 (&qr)[4], const bf16_t* Qrow  , int lane) {
    const bf16_t* p = Qrow + (size_t)(lane & 31) * QKV_N + 8 * (lane >> 5);
#pragma unroll
    for (int s = 0; s < 4; ++s) qr[s] = *(const GAS bf16x8*)(p + 16 * s);
}
DI void store_ot(bf16_t* O, const f32x16& y0, const f32x16& y1, float sc, int lane) {
    bf16_t* rowp = O + (size_t)(lane & 31) * DM + 4 * (lane >> 5);
#pragma unroll
    for (int g = 0; g < 4; ++g) {
        u32x2 a; a.x = cvtpk(y0[4 * g] * sc, y0[4 * g + 1] * sc); a.y = cvtpk(y0[4 * g + 2] * sc, y0[4 * g + 3] * sc); *(u32x2*)(rowp + 8 * g) = a;
        u32x2 b; b.x = cvtpk(y1[4 * g] * sc, y1[4 * g + 1] * sc); b.y = cvtpk(y1[4 * g + 2] * sc, y1[4 * g + 3] * sc); *(u32x2*)(rowp + 32 + 8 * g) = b; }
}
}

#ifndef PH_MASK
#define PH_MASK 0xFFFF
#endif
#define PH(k) ((PH_MASK >> (k)) & 1)
#ifndef REP_PHASE
#define REP_PHASE -1
#endif
#ifndef REP_N
#define REP_N 1
#endif
#define NREP(k) (((k) == REP_PHASE) ? REP_N : 1)
struct Args { const float* in[25]; float* out; unsigned char* ws; };

DI float wave_sum(float v) {
#pragma unroll
    for (int o = 1; o < 64; o <<= 1) v += __shfl_xor(v, o);
    return v;
}
DI unsigned f2bf(float f) { unsigned u = __builtin_bit_cast(unsigned, f); return (u + 0x7fffu + ((u >> 16) & 1u)) >> 16; }
DI unsigned pk2(float lo, float hi) { return f2bf(lo) | (f2bf(hi) << 16); }

enum { MAP_ID = 0, MAP_WIN = 1, MAP_GU_G = 2, MAP_GU_U = 3 };
DI int map_row(int kind, int c) {
    if (kind == MAP_WIN) { if (c < 1280) return c; if (c < 1292) return C_SM + (c - 1280); if (c < 2444) return c - 12; return c; }
    if (kind == MAP_GU_G) return (c >> 7) * 256 + (c & 127);
    if (kind == MAP_GU_U) return (c >> 7) * 256 + 128 + (c & 127);
    return c;
}
DI void cvt_item(const float* W, int K, int N, bf16_t* WT, int kind, int row_off, LAS float* scr, int item, int lane) {
    const int nblk = (N + 31) / 32, kb = item / nblk, nb = item % nblk, k0 = 64 * kb, n0 = 32 * nb;
    const int cn = n0 + (lane & 31); const bool cok = cn < N;
    float vv[32];
#pragma unroll
    for (int i = 0; i < 32; ++i) { const int kk = 2 * i + (lane >> 5); vv[i] = cok ? __builtin_nontemporal_load(W + (size_t)(k0 + kk) * N + cn) : 0.f; }
#pragma unroll
    for (int i = 0; i < 32; ++i) { const int kk = 2 * i + (lane >> 5); scr[kk * 33 + (lane & 31)] = vv[i]; }
    asm volatile("s_waitcnt lgkmcnt(0)" ::: "memory");
    const int c = lane & 7;
#pragma unroll
    for (int j = 0; j < 4; ++j) { const int n = (lane >> 3) + 8 * j; const LAS float* s = scr + (8 * c) * 33 + n;
        u32x4 o; o.x = pk2(s[0 * 33], s[1 * 33]); o.y = pk2(s[2 * 33], s[3 * 33]); o.z = pk2(s[4 * 33], s[5 * 33]); o.w = pk2(s[6 * 33], s[7 * 33]);
        if (n0 + n < N) *(u32x4*)(WT + (size_t)(row_off + map_row(kind, n0 + n)) * K + k0 + 8 * c) = o; }
    asm volatile("s_waitcnt lgkmcnt(0)" ::: "memory");
}

DI unsigned long long ldp(volatile LAS unsigned long long* PT, int k) { int ko = k; asm volatile("" : "+v"(ko)); const unsigned long long v = PT[ko];
    const unsigned lo = __builtin_amdgcn_readfirstlane((unsigned)v), hi = __builtin_amdgcn_readfirstlane((unsigned)(v >> 32)); return ((unsigned long long)hi << 32) | lo; }
#define INP(k) ((const float*)ldp(PT, (k)))
#define WSP(off) ((unsigned char*)ldp(PT, 26) + (off))
#define OUTP ((float*)ldp(PT, 25))

__global__ void __launch_bounds__(512, 2) mega_fwd(Args args) {
    extern __shared__ __attribute__((aligned(16))) unsigned char lds_raw[];
    LAS unsigned char* lds = (LAS unsigned char*)lds_raw;
    volatile LAS unsigned* MISC = (volatile LAS unsigned*)(lds + L_MISC);
    LAS float* LUT = (LAS float*)(lds + L_LUT);
    LAS int* TP = (LAS int*)(lds + L_TP);
    LAS int* CNTL = (LAS int*)(lds + L_CNT);
    LAS int* TPX = (LAS int*)(lds + L_TPX);
    const int wid0 = __builtin_amdgcn_readfirstlane((int)threadIdx.x >> 6);
#define LAUNDER_TID int lane; asm volatile("v_mbcnt_lo_u32_b32 %0, -1, 0\n\tv_mbcnt_hi_u32_b32 %0, -1, %0" : "=v"(lane)); int wid = wid0; asm volatile("" : "+s"(wid)); const int tid = wid * 64 + lane; (void)tid;
    const int G = gridDim.x, bx = blockIdx.x;
    volatile LAS unsigned long long* PT = (volatile LAS unsigned long long*)(lds + L_PT);
    { LAUNDER_TID
    if (tid == 0) {
        PT[0] = (unsigned long long)args.in[0]; PT[1] = (unsigned long long)args.in[1]; PT[2] = (unsigned long long)args.in[2]; PT[3] = (unsigned long long)args.in[3];
        PT[4] = (unsigned long long)args.in[4]; PT[5] = (unsigned long long)args.in[5]; PT[6] = (unsigned long long)args.in[6]; PT[7] = (unsigned long long)args.in[7];
        PT[8] = (unsigned long long)args.in[8]; PT[9] = (unsigned long long)args.in[9]; PT[10] = (unsigned long long)args.in[10]; PT[11] = (unsigned long long)args.in[11];
        PT[12] = (unsigned long long)args.in[12]; PT[13] = (unsigned long long)args.in[13]; PT[14] = (unsigned long long)args.in[14]; PT[15] = (unsigned long long)args.in[15];
        PT[16] = (unsigned long long)args.in[16]; PT[17] = (unsigned long long)args.in[17]; PT[18] = (unsigned long long)args.in[18]; PT[19] = (unsigned long long)args.in[19];
        PT[20] = (unsigned long long)args.in[20]; PT[21] = (unsigned long long)args.in[21]; PT[22] = (unsigned long long)args.in[22]; PT[23] = (unsigned long long)args.in[23];
        PT[24] = (unsigned long long)args.in[24]; PT[25] = (unsigned long long)args.out; PT[26] = (unsigned long long)args.ws;
    }
    for (int u = tid; u < 64; u += 512) MISC[u] = 0u;
    for (int u = tid; u < 1280; u += 512) { const int hh = u >> 7, rel = u & 127; int bk = rel;
        if (rel >= 16) { bk = 16; const int th[15] = {19, 21, 24, 27, 31, 35, 40, 46, 52, 59, 67, 77, 87, 99, 113};
#pragma unroll
            for (int q = 0; q < 15; ++q) bk += (rel >= th[q]) ? 1 : 0; }
        LUT[u] = args.in[10][bk * 10 + hh] * LOG2E; }
    }
    __syncthreads();
    XcdBarrier bar = xcd_barrier_post((unsigned*)WSP(WS_CTL) + CW_BAR, MISC);
#define GRID_BAR() do { XcdBarrier b2_ = bar; b2_.bar = (unsigned*)WSP(WS_CTL) + CW_BAR; asm volatile("" : "+s"(b2_.x)); int ln_; asm volatile("v_mbcnt_lo_u32_b32 %0, -1, 0\n\tv_mbcnt_hi_u32_b32 %0, -1, %0" : "=v"(ln_)); xcd_barrier(b2_, (wid0 == 0) && (ln_ == 0)); } while (0)
#define QNEXT(ctr, dstvar) do { if (tid == 0) MISC[8] = atomicAdd((ctr), 1u); __syncthreads(); dstvar = (int)__builtin_amdgcn_readfirstlane(MISC[8]); __syncthreads(); } while (0)

    for (int rep = 0; rep < NREP(0); ++rep) if (PH(0)) { LAUNDER_TID
            float* ADA = (float*)WSP(WS_ADA); float* CPOS = (float*)WSP(WS_CPOS); bf16_t* WIN = (bf16_t*)WSP(WS_WIN); bf16_t* WO = (bf16_t*)WSP(WS_WO); bf16_t* WSH = (bf16_t*)WSP(WS_WSH); bf16_t* WSD = (bf16_t*)WSP(WS_WSD); bf16_t* WCT = (bf16_t*)WSP(WS_WCT); bf16_t* WGU = (bf16_t*)WSP(WS_WGU); bf16_t* WD = (bf16_t*)WSP(WS_WD);
        if (bx < 192) {
            LAS float* cond = (LAS float*)lds;
            LAS float* red = (LAS float*)(lds + 32768);
            for (int u = tid; u < 8192; u += 512) cond[u] = siluf_(INP(1)[u]);
            __syncthreads();
            const int l = bx / 96, j0 = (bx % 96) * 64;
            const float* wa = INP(11) + (size_t)l * DM * 6144 + j0 + lane;
            float accb[8];
#pragma unroll
            for (int b = 0; b < 8; ++b) accb[b] = 0.f;
#pragma unroll 8
            for (int kk = 0; kk < 128; ++kk) { const int k = wid * 128 + kk; const float w = wa[(size_t)k * 6144];
#pragma unroll
                for (int b = 0; b < 8; ++b) accb[b] += cond[b * 1024 + k] * w; }
#pragma unroll
            for (int b = 0; b < 8; ++b) red[(wid * 8 + b) * 64 + lane] = accb[b];
            __syncthreads();
            { const int b = tid >> 6; float s = INP(12)[l * 6144 + j0 + lane];
#pragma unroll
                for (int w = 0; w < 8; ++w) s += red[(w * 8 + b) * 64 + lane];
                ADA[((size_t)l * 8 + b) * 6144 + j0 + lane] = s; }
            __syncthreads();
        } else if (bx < 196) {
            const int l = (bx - 192) >> 1, which = (bx - 192) & 1;
            const float* pos = INP(which ? 7 : 5) + (size_t)l * 2048 + wid * 256; const float* w = INP(which ? 8 : 6) + (size_t)l * 2048 * 64 + (size_t)wid * 256 * 64;
            LAS float* red = (LAS float*)lds;
            float s = 0.f;
#pragma unroll 16
            for (int k = 0; k < 256; ++k) s += pos[k] * w[(size_t)k * 64 + lane];
            red[wid * 64 + lane] = s;
            __syncthreads();
            if (wid == 0) { float t = 0.f;
#pragma unroll
                for (int w8 = 0; w8 < 8; ++w8) t += red[w8 * 64 + lane];
                CPOS[(l * 2 + which) * 64 + lane] = t; }
            __syncthreads();
        }
        { const int gt = bx * 512 + tid; const int per = (QKV_N - D_IN) * DM / 8;
            for (int u = gt; u < 2 * per; u += G * 512) { const int l = u / per, r = u % per; *(u32x4*)(WIN + ((size_t)l * QKV_N + D_IN) * DM + (size_t)r * 8) = (u32x4){0u, 0u, 0u, 0u}; } }
        LAS float* scr = (LAS float*)(lds + wid * 16384);
        const int gw = bx * 8 + wid, NGW = G * 8;
        constexpr int I_SMALL = 2384, I_EXP = 384;
        const int NITEMS = DEPTH * I_SMALL + DEPTH * NEXP * I_EXP;
        for (int it = gw; it < NITEMS; it += NGW) {
            if (it < DEPTH * I_SMALL) { const int l = it / I_SMALL; int r = it % I_SMALL;
                if (r < 1232) { cvt_item(INP(2) + (size_t)l * DM * D_IN, DM, D_IN, WIN + (size_t)l * QKV_N * DM, MAP_WIN, 0, scr, r, lane); continue; } r -= 1232;
                if (r < 512) { cvt_item(INP(3) + (size_t)l * DM * DM, DM, DM, WO + (size_t)l * DM * DM, MAP_ID, 0, scr, r, lane); continue; } r -= 512;
                if (r < 128) { cvt_item(INP(17) + (size_t)l * DM * 256, DM, 256, WSH + (size_t)l * 768 * DM, MAP_ID, 0, scr, r, lane); continue; } r -= 128;
                if (r < 128) { cvt_item(INP(22) + (size_t)l * DM * 256, DM, 256, WSH + (size_t)l * 768 * DM, MAP_GU_G, 256, scr, r, lane); continue; } r -= 128;
                if (r < 128) { cvt_item(INP(23) + (size_t)l * DM * 256, DM, 256, WSH + (size_t)l * 768 * DM, MAP_GU_U, 256, scr, r, lane); continue; } r -= 128;
                if (r < 128) { cvt_item(INP(24) + (size_t)l * 256 * DM, 256, DM, WSD + (size_t)l * DM * 256, MAP_ID, 0, scr, r, lane); continue; } r -= 128;
                if (r < 64) { cvt_item(INP(6) + (size_t)l * 2048 * 64, 2048, 64, WCT + (size_t)(l * 2 + 0) * 64 * 2048, MAP_ID, 0, scr, r, lane); continue; } r -= 64;
                cvt_item(INP(8) + (size_t)l * 2048 * 64, 2048, 64, WCT + (size_t)(l * 2 + 1) * 64 * 2048, MAP_ID, 0, scr, r, lane);
            } else { const int r0 = it - DEPTH * I_SMALL; const int le = r0 / I_EXP, r = r0 % I_EXP;
                if (r < 128) cvt_item(INP(19) + (size_t)le * DM * EDIM, DM, EDIM, WGU + (size_t)le * 512 * DM, MAP_GU_G, 0, scr, r, lane);
                else if (r < 256) cvt_item(INP(20) + (size_t)le * DM * EDIM, DM, EDIM, WGU + (size_t)le * 512 * DM, MAP_GU_U, 0, scr, r - 128, lane);
                else cvt_item(INP(21) + (size_t)le * EDIM * DM, EDIM, DM, WD + (size_t)le * DM * EDIM, MAP_ID, 0, scr, r - 256, lane);
            }
        }
    }
    GRID_BAR();
    if (PH(1)) { LAUNDER_TID
            float* ADA = (float*)WSP(WS_ADA); bf16_t* H = (bf16_t*)WSP(WS_H);
        const int gw = bx * 8 + wid, NGW = G * 8;
        for (int m = gw; m < NTOK; m += NGW) { const int b = m >> 12; const float* ad = ADA + (size_t)b * 6144;
            const f32x4* xr = (const f32x4*)(INP(0) + (size_t)m * DM) + lane; unsigned long long* o8 = (unsigned long long*)(H + (size_t)m * DM) + lane;
#pragma unroll
            for (int j = 0; j < 4; ++j) { const f32x4 v = xr[64 * j]; const f32x4 sh = *((const f32x4*)(ad) + 64 * j + lane), sc = *((const f32x4*)(ad + 1024) + 64 * j + lane);
                const f32x4 hv = v * (sc + 1.f) + sh; o8[64 * j] = (unsigned long long)cvtpk(hv[0], hv[1]) | ((unsigned long long)cvtpk(hv[2], hv[3]) << 32); } }
    }
    GRID_BAR();

    for (int l = 0; l < DEPTH; ++l) {
        for (int rep = 0; rep < NREP(2); ++rep) if (PH(2)) { LAUNDER_TID
            bf16_t* H = (bf16_t*)WSP(WS_H); bf16_t* WIN = (bf16_t*)WSP(WS_WIN); bf16_t* QKV = (bf16_t*)WSP(WS_QKV); float* SMALL = (float*)WSP(WS_SMALL);
            pg8::Gemm g{H, WIN + (size_t)l * QKV_N * DM, DM}; pg8::StaticOrder S; S.init(NTOK, QKV_N, G, bx);
            pg8::EpiQKV E{QKV, SMALL};
            pg8::gemm_phase<pg8::EpiQKV, pg8::StaticOrder>(lds, g, S, E, wid);
        }
        GRID_BAR();
        for (int rep = 0; rep < NREP(3); ++rep) if (PH(3)) { LAUNDER_TID
            unsigned* ctl = (unsigned*)WSP(WS_CTL); bf16_t* QKV = (bf16_t*)WSP(WS_QKV); bf16_t* WCT = (bf16_t*)WSP(WS_WCT); float* CPOS = (float*)WSP(WS_CPOS); bf16_t* KCMP = (bf16_t*)WSP(WS_KCMP); bf16_t* VCMP = (bf16_t*)WSP(WS_VCMP); float* SMALL = (float*)WSP(WS_SMALL); float* DC = (float*)WSP(WS_DC); bf16_t* OB = (bf16_t*)WSP(WS_O); float* KMW = (float*)WSP(WS_KM);
            unsigned* qctr = ctl + CW_Q + 64 * (l * 4 + 0 + 8 * rep);
            for (;;) {
                int u; QNEXT(qctr, u);
                if (u >= 128 + 48 + 768) break;
                if (u < 128) {
                    const int b = u >> 4, which = (u >> 3) & 1, cblk = (u >> 2) & 1, nblk = 2 * (u & 3) + (wid >> 2), kc = wid & 3, r = lane & 31, h = lane >> 5;
                    int n = 32 * nblk + r; n = n < 254 ? n : 254;
                    const bf16_t* arow = QKV + ((size_t)b * SEQ + 16 * n + 8 * kc) * QKV_N + (which ? C_BVC : C_BKC) + 8 * h;
                    const bf16_t* brow = WCT + ((size_t)(l * 2 + which) * 64 + 32 * cblk + r) * 2048 + 512 * kc + 8 * h;
                    f32x16 acc;
#pragma unroll
                    for (int i = 0; i < 16; ++i) acc[i] = 0.f;
#pragma unroll 8
                    for (int s = 0; s < 32; ++s) { const int k = 16 * s; const bf16x8 af = *(const GAS bf16x8*)(arow + (size_t)(k >> 6) * QKV_N + (k & 63)); const bf16x8 bf = *(const GAS bf16x8*)(brow + k);
                        acc = MFMA32(af, bf, acc); }
                    LAS float* red = (LAS float*)lds;
                    if (kc) {
#pragma unroll
                        for (int i = 0; i < 16; ++i) red[(wid * 16 + i) * 64 + lane] = acc[i]; }
                    __syncthreads();
                    if (kc == 0) {
                        const float cp = CPOS[(l * 2 + which) * 64 + 32 * cblk + r]; bf16_t* dst = (which ? VCMP : KCMP) + (size_t)b * 256 * 64 + 32 * cblk + r;
#pragma unroll
                        for (int i = 0; i < 16; ++i) { const float t = acc[i] + red[((wid + 1) * 16 + i) * 64 + lane] + red[((wid + 2) * 16 + i) * 64 + lane] + red[((wid + 3) * 16 + i) * 64 + lane];
                            const int nn = 32 * nblk + (i & 3) + 8 * (i >> 2) + 4 * h; dst[(size_t)nn * 64] = (bf16_t)(nn < 255 ? f2bf(t + cp) : 0u); } }
                    __syncthreads();
                } else if (u < 176) {
                    const int b = (u - 128) / 6, hh = (u - 128) % 6; const float fb = INP(9)[l * 6 + hh];
                    LAS float* wsum = (LAS float*)lds;
                    float v[8]; float run = 0.f;
#pragma unroll
                    for (int i = 0; i < 8; ++i) { const float x = SMALL[((size_t)b * SEQ + 8 * tid + i) * 32 + 12 + hh] + fb; const float lf = fminf(x, 0.f) - log1pf(__expf(-fabsf(x))); run += lf; v[i] = run; }
                    float incl = run;
#pragma unroll
                    for (int o = 1; o < 64; o <<= 1) { const float t = __shfl_up(incl, o); if (lane >= o) incl += t; }
                    if (lane == 63) wsum[wid] = incl;
                    __syncthreads();
                    float base = incl - run;
                    for (int w = 0; w < wid; ++w) base += wsum[w];
                    float* dst = DC + ((size_t)b * 6 + hh) * SEQ + 8 * tid;
#pragma unroll
                    for (int i = 0; i < 8; ++i) dst[i] = (base + v[i]) * LOG2E;
                    LAS float* tmx = (LAS float*)(lds + 1024);
                    { const bf16_t* kp = QKV + ((size_t)b * SEQ + (tid >> 3)) * QKV_N + C_CK + 64 * hh + 8 * (tid & 7);
#pragma unroll 8
                        for (int T = 0; T < 64; ++T) { const bf16x8 kv = *(const GAS bf16x8*)(kp + (size_t)T * 64 * QKV_N); float ss = 0.f;
#pragma unroll
                            for (int e = 0; e < 8; ++e) { const float x = __uint_as_float(((unsigned)(unsigned short)kv[e]) << 16); ss += x * x; }
                            ss += __shfl_xor(ss, 1); ss += __shfl_xor(ss, 2); ss += __shfl_xor(ss, 4);
                            ss = fmaxf(ss, __shfl_xor(ss, 8)); ss = fmaxf(ss, __shfl_xor(ss, 16)); ss = fmaxf(ss, __shfl_xor(ss, 32));
                            if (lane == 0) tmx[wid * 64 + T] = ss; } }
                    __syncthreads();
                    if (tid < 64) { float mx = tmx[tid];
#pragma unroll
                        for (int w = 1; w < 8; ++w) mx = fmaxf(mx, tmx[w * 64 + tid]);
#pragma unroll
                        for (int o = 1; o < 64; o <<= 1) { const float t = __shfl_up(mx, o); if (lane >= o) mx = fmaxf(mx, t); }
                        KMW[((size_t)b * 6 + hh) * 64 + tid] = sqrtf(mx); }
                    __syncthreads();
                } else {
                    const int ua = u - 176, qt = ua & 15, hq = (ua >> 4) % 6, b = ua / 96, kvh = hq / 3;
                    const size_t tok0 = (size_t)b * SEQ + 256 * qt + 32 * wid;
                    bf16x8 qr[4]; att::load_q(qr, QKV + tok0 * QKV_N + C_AQ + 64 * hq, lane);
                    att::Acc a; att::acc_init(a, INP(4)[l * 6 + hq] * LOG2E, (lane < 32) ? 1.f : 0.f);
                    att::PassArgs P; P.Kg = QKV + (size_t)b * SEQ * QKV_N + C_AK + 64 * kvh; P.Vg = QKV + (size_t)b * SEQ * QKV_N + C_AV + 64 * kvh; P.pitch = QKV_N;
                    P.jfirst = (4 * qt - 2) > 0 ? (4 * qt - 2) : 0; P.ntiles = 4 * qt + 3 - P.jfirst + 1; P.step = 1; P.tq0 = 256 * qt + 32 * wid;
                    P.lut = LUT + 128 * hq; P.sel = 0ull; P.dq = 0.f; P.dkg = nullptr; P.fm = 0.f; P.frl = 0.f; P.imp = nullptr; P.qn = 0.f; P.km = nullptr;
                    att::attn_pass<att::M_BAND, 128>((LAS char*)lds, P, qr, a, tid, lane);
                    const float lt = a.l + __shfl_xor(a.l, 32);
                    att::store_ot(OB + tok0 * DM + O_A + 64 * hq, a.o0, a.o1, 1.f / lt, lane);
                }
            }
        }
        GRID_BAR();
        for (int rep = 0; rep < NREP(4); ++rep) if (PH(4)) { LAUNDER_TID
            unsigned* ctl = (unsigned*)WSP(WS_CTL); bf16_t* QKV = (bf16_t*)WSP(WS_QKV); float* DC = (float*)WSP(WS_DC); bf16_t* KCMP = (bf16_t*)WSP(WS_KCMP); bf16_t* VCMP = (bf16_t*)WSP(WS_VCMP); float* SMALL = (float*)WSP(WS_SMALL); bf16_t* OB = (bf16_t*)WSP(WS_O); const float* KM = (const float*)WSP(WS_KM);
            unsigned* qctr = ctl + CW_Q + 64 * (l * 4 + 1 + 8 * rep);
            for (;;) {
                int u; QNEXT(qctr, u);
                if (u >= 1280) break;
                const int grp = u / 80, rr = u % 80, L = 15 - grp;
                if (rr < 48) { if (PH(14)) {
                    const int b = rr / 6, hh = rr % 6, qt = L;
                    const size_t tok0 = (size_t)b * SEQ + 256 * qt + 32 * wid;
                    bf16x8 qr[4]; att::load_q(qr, QKV + tok0 * QKV_N + C_CQ + 64 * hh, lane);
                    att::Acc a; att::acc_init(a, -1e30f, 0.f);
                    att::PassArgs P; P.Kg = QKV + (size_t)b * SEQ * QKV_N + C_CK + 64 * hh; P.Vg = QKV + (size_t)b * SEQ * QKV_N + C_CV + 64 * hh; P.pitch = QKV_N;
                    P.jfirst = 4 * qt + 3; P.ntiles = 4 * qt + 4; P.step = -1; P.tq0 = 256 * qt + 32 * wid;
                    P.lut = LUT; P.sel = 0ull; P.dkg = DC + ((size_t)b * 6 + hh) * SEQ; P.dq = P.dkg[P.tq0 + (lane & 31)]; P.fm = 0.f; P.frl = 0.f; P.imp = nullptr;
                    { float qs = 0.f;
#pragma unroll
                        for (int s4 = 0; s4 < 4; ++s4)
#pragma unroll
                            for (int e = 0; e < 8; ++e) { const float qv = __uint_as_float(((unsigned)(unsigned short)qr[s4][e]) << 16); qs += qv * qv; }
                        qs += __shfl_xor(qs, 32); P.qn = sqrtf(qs); P.km = KM + ((size_t)b * 6 + hh) * 64; }
                    att::attn_pass<att::M_FOX, 0>((LAS char*)lds, P, qr, a, tid, lane);
                    const float lt = a.l + __shfl_xor(a.l, 32);
                    att::store_ot(OB + tok0 * DM + O_C + 64 * hh, a.o0, a.o1, 1.f / lt, lane);
                } } else if (PH(15)) {
                    const int r2 = rr - 48, qt = 4 * L + 3 - (r2 >> 3), b = r2 & 7, head = wid >> 1, qh = wid & 1;
                    const size_t tok0 = (size_t)b * SEQ + 64 * qt + 32 * qh; const int tq0 = 64 * qt + 32 * qh;
                    const int r = lane & 31, h = lane >> 5;
                    LAS float* IMP = (LAS float*)(lds + att::A_IMP);
                    LAS unsigned long long* SELM = (LAS unsigned long long*)(lds + att::A_SEL);
                    for (int q = tid; q < 4 * 64 * 65; q += 512) IMP[q] = 0.f;
                    bf16x8 qr[4]; att::load_q(qr, QKV + tok0 * QKV_N + C_BQ + 64 * head, lane);
                    const float* gl = SMALL + (tok0 + r) * 32 + head;
                    const float g0 = sigmoidf_(gl[0]), g1 = sigmoidf_(gl[4]), g2 = sigmoidf_(gl[8]);
                    att::PassArgs P; P.pitch = 64; P.Kg = KCMP + (size_t)b * 256 * 64; P.Vg = VCMP + (size_t)b * 256 * 64;
                    P.jfirst = 0; P.ntiles = (qt >> 4) + 1; P.step = 1; P.tq0 = tq0; P.lut = LUT + 128 * (6 + head); P.sel = 0ull; P.dq = 0.f; P.dkg = nullptr; P.qn = 0.f; P.km = nullptr;
                    P.fm = 0.f; P.frl = 0.f; P.imp = IMP + (head * 64 + 32 * qh + r) * 65;
                    att::Acc a; att::acc_init(a, -1e30f, 0.f);
                    att::attn_pass<att::M_CMP1, 0>((LAS char*)lds, P, qr, a, tid, lane);
                    { const float lt = a.l + __shfl_xor(a.l, 32); P.fm = a.m; P.frl = lt > 0.f ? 1.f / lt : 0.f; }
                    att::acc_init(a, 0.f, 0.f);
                    att::attn_pass<att::M_CMP2, 0>((LAS char*)lds, P, qr, a, tid, lane);
#pragma unroll
                    for (int i = 0; i < 16; ++i) { a.o0[i] *= g0; a.o1[i] *= g0; }
                    for (int qi = 0; qi < 8; ++qi) { const int q = 8 * wid + qi;
                        float v = IMP[(0 * 64 + q) * 65 + lane] + IMP[(1 * 64 + q) * 65 + lane] + IMP[(2 * 64 + q) * 65 + lane] + IMP[(3 * 64 + q) * 65 + lane];
                        if (lane == 0 || lane == qt || lane == qt - 1) v = 1e4f; else if (lane > qt) v = -1.f;
                        int rank = 0;
#pragma unroll
                        for (int jj = 0; jj < 64; ++jj) { const float vj = __uint_as_float(__builtin_amdgcn_readlane(__float_as_uint(v), jj)); rank += ((vj > v) || (vj == v && jj < lane)) ? 1 : 0; }
                        const unsigned long long mk = __ballot(rank < 16);
                        if (lane == 0) SELM[q] = mk; }
                    __syncthreads();
                    P.sel = SELM[32 * qh + r];
                    LAS float* FR = IMP + tid;
#pragma unroll
                    for (int i = 0; i < 16; ++i) { FR[512 * i] = a.o0[i]; FR[512 * (16 + i)] = a.o1[i]; }
                    P.pitch = QKV_N; P.Kg = QKV + (size_t)b * SEQ * QKV_N + C_BKS; P.Vg = QKV + (size_t)b * SEQ * QKV_N + C_BVS; P.jfirst = 0; P.ntiles = qt + 1; P.step = 1;
                    att::acc_init(a, -1e30f, 0.f);
                    att::attn_pass<att::M_SLC, 0>((LAS char*)lds, P, qr, a, tid, lane);
                    { const float lt = a.l + __shfl_xor(a.l, 32); const float sc = g1 / lt;
#pragma unroll
                        for (int i = 0; i < 16; ++i) { FR[512 * i] += sc * a.o0[i]; FR[512 * (16 + i)] += sc * a.o1[i]; } }
                    P.Kg = QKV + (size_t)b * SEQ * QKV_N + C_BKW; P.Vg = QKV + (size_t)b * SEQ * QKV_N + C_BVW; P.jfirst = (qt - 8) > 0 ? (qt - 8) : 0; P.ntiles = qt - P.jfirst + 1;
                    att::acc_init(a, -1e30f, 0.f);
                    att::attn_pass<att::M_BAND, 512>((LAS char*)lds, P, qr, a, tid, lane);
                    { const float lt = a.l + __shfl_xor(a.l, 32); const float sc = g2 / lt;
#pragma unroll
                        for (int i = 0; i < 16; ++i) { a.o0[i] = FR[512 * i] + sc * a.o0[i]; a.o1[i] = FR[512 * (16 + i)] + sc * a.o1[i]; } }
                    att::store_ot(OB + tok0 * DM + O_B + 64 * head, a.o0, a.o1, 1.f, lane);
                }
            }
        }
        GRID_BAR();
        for (int rep = 0; rep < NREP(5); ++rep) if (PH(5)) { LAUNDER_TID
            bf16_t* OB = (bf16_t*)WSP(WS_O); bf16_t* WO = (bf16_t*)WSP(WS_WO); const float* xin = (l == 0) ? INP(0) : (const float*)OUTP; float* VB = (float*)WSP(WS_V); const float* ada_l = (const float*)WSP(WS_ADA) + (size_t)l * 8 * 6144;
            pg8::Gemm g{OB, WO + (size_t)l * DM * DM, DM}; pg8::StaticOrder S; S.init(NTOK, DM, G, bx);
            pg8::EpiWO E{xin, VB, ada_l + 2 * 1024};
            pg8::gemm_phase<pg8::EpiWO, pg8::StaticOrder>(lds, g, S, E, wid);
        }
        GRID_BAR();
        for (int rep = 0; rep < NREP(6); ++rep) if (PH(6)) { LAUNDER_TID
            float* VB = (float*)WSP(WS_V); float* X1 = (float*)WSP(WS_X1); bf16_t* H = (bf16_t*)WSP(WS_H); const float* ada_l = (const float*)WSP(WS_ADA) + (size_t)l * 8 * 6144;
            const int gw = bx * 8 + wid, NGW = G * 8; const float* lg = INP(13) + l * DM; const float* lb = INP(14) + l * DM;
            for (int m = 2 * gw; m < NTOK; m += 2 * NGW) { const int b = m >> 12; const float* ad = ada_l + (size_t)b * 6144;
                f32x4 v[2][4]; float s[2] = {0.f, 0.f};
#pragma unroll
                for (int rr = 0; rr < 2; ++rr)
#pragma unroll
                    for (int j = 0; j < 4; ++j) v[rr][j] = *((const GAS f32x4*)(VB + (size_t)(m + rr) * DM) + 64 * j + lane);
#pragma unroll
                for (int rr = 0; rr < 2; ++rr)
#pragma unroll
                    for (int j = 0; j < 4; ++j) s[rr] += (v[rr][j][0] + v[rr][j][1]) + (v[rr][j][2] + v[rr][j][3]);
                const float mean0 = wave_sum(s[0]) * (1.f / DM), mean1 = wave_sum(s[1]) * (1.f / DM); float q[2] = {0.f, 0.f};
#pragma unroll
                for (int rr = 0; rr < 2; ++rr)
#pragma unroll
                    for (int j = 0; j < 4; ++j) { v[rr][j] = v[rr][j] - (rr ? mean1 : mean0); q[rr] += (v[rr][j][0] * v[rr][j][0] + v[rr][j][1] * v[rr][j][1]) + (v[rr][j][2] * v[rr][j][2] + v[rr][j][3] * v[rr][j][3]); }
                const float rstd0 = 1.f / sqrtf(wave_sum(q[0]) * (1.f / DM) + LN_EPS), rstd1 = 1.f / sqrtf(wave_sum(q[1]) * (1.f / DM) + LN_EPS);
#pragma unroll
                for (int j = 0; j < 4; ++j) { const f32x4 gg = *((const f32x4*)lg + 64 * j + lane), bb = *((const f32x4*)lb + 64 * j + lane);
                    const f32x4 sh = *((const f32x4*)(ad + 3 * 1024) + 64 * j + lane), sc = *((const f32x4*)(ad + 4 * 1024) + 64 * j + lane) + 1.f;
#pragma unroll
                    for (int rr = 0; rr < 2; ++rr) { const f32x4 x1 = v[rr][j] * (rr ? rstd1 : rstd0) * gg + bb; *((f32x4*)(X1 + (size_t)(m + rr) * DM) + 64 * j + lane) = x1;
                        const f32x4 hv = x1 * sc + sh; *((unsigned long long*)(H + (size_t)(m + rr) * DM) + 64 * j + lane) = (unsigned long long)cvtpk(hv[0], hv[1]) | ((unsigned long long)cvtpk(hv[2], hv[3]) << 32); } } }
        }
        GRID_BAR();
        for (int rep = 0; rep < NREP(7); ++rep) if (PH(7)) { LAUNDER_TID
            bf16_t* H = (bf16_t*)WSP(WS_H); bf16_t* WSH = (bf16_t*)WSP(WS_WSH); float* LOG = (float*)WSP(WS_LOG); bf16_t* ACTSH = (bf16_t*)WSP(WS_ACTSH);
            pg8::Gemm g{H, WSH + (size_t)l * 768 * DM, DM}; pg8::StaticOrder S; S.init(NTOK, 768, G, bx);
            pg8::EpiSH E{LOG, ACTSH};
            pg8::gemm_phase<pg8::EpiSH, pg8::StaticOrder>(lds, g, S, E, wid);
        }
        GRID_BAR();
        if (PH(8)) { LAUNDER_TID
            unsigned* ctl = (unsigned*)WSP(WS_CTL); float* LOG = (float*)WSP(WS_LOG); int* DST = (int*)WSP(WS_DST); float* WL = (float*)WSP(WS_WL);
            unsigned* CNT = ctl + CW_CNT + l * 256;
            LAS int* hist = (LAS int*)lds;
            LAS int* basel = (LAS int*)(lds + 1024);
            LAS int* asg_e = (LAS int*)(lds + 2048);
            LAS int* asg_r = (LAS int*)(lds + 2048 + 4096);
            LAS float* asg_w = (LAS float*)(lds + 2048 + 8192);
            const float* rb = INP(18) + l * 256;
            for (int chunk = bx; chunk < NTOK / 128; chunk += G) {
                for (int u = tid; u < 256; u += 512) hist[u] = 0;
                __syncthreads();
                for (int ti = 0; ti < 16; ++ti) { const int tl = wid * 16 + ti, n = chunk * 128 + tl;
                    const f32x4 lg = *((const f32x4*)(LOG + (size_t)n * 256) + lane); const f32x4 rbv = *((const f32x4*)rb + lane);
                    float sc[4], ch[4];
#pragma unroll
                    for (int i = 0; i < 4; ++i) { sc[i] = sigmoidf_(lg[i]); ch[i] = sc[i] + rbv[i]; }
                    float m1 = fmaxf(ch[0], ch[1]), m2 = fminf(ch[0], ch[1]);
                    { const float a1 = fmaxf(ch[2], ch[3]), a2 = fminf(ch[2], ch[3]); const float n1 = fmaxf(m1, a1), n2 = fmaxf(fminf(m1, a1), fmaxf(m2, a2)); m1 = n1; m2 = n2; }
#pragma unroll
                    for (int o = 1; o < 8; o <<= 1) { const float b1 = __shfl_xor(m1, o), b2 = __shfl_xor(m2, o); const float n1 = fmaxf(m1, b1), n2 = fmaxf(fminf(m1, b1), fmaxf(m2, b2)); m1 = n1; m2 = n2; }
                    const float gs = m1 + m2; const int grp = lane >> 3; int grank = 0;
#pragma unroll
                    for (int jg = 0; jg < 8; ++jg) { const float o = __shfl(gs, 8 * jg); grank += ((o > gs) || (o == gs && jg < grp)) ? 1 : 0; }
                    const bool gsel = grank < 4;
                    float val[4];
#pragma unroll
                    for (int i = 0; i < 4; ++i) val[i] = gsel ? ch[i] : -1e30f;
                    float wsum_ = 0.f; int my_e = 0; float my_s = 0.f;
#pragma unroll
                    for (int k = 0; k < 8; ++k) {
                        float bv = val[0]; int bi = 4 * lane; float bsc = sc[0];
#pragma unroll
                        for (int i = 1; i < 4; ++i) if (val[i] > bv) { bv = val[i]; bi = 4 * lane + i; bsc = sc[i]; }
#pragma unroll
                        for (int o = 1; o < 64; o <<= 1) { const float ov = __shfl_xor(bv, o); const int oi = __shfl_xor(bi, o); const float os = __shfl_xor(bsc, o);
                            if (ov > bv || (ov == bv && oi < bi)) { bv = ov; bi = oi; bsc = os; } }
                        if ((bi >> 2) == lane) {
#pragma unroll
                            for (int i = 0; i < 4; ++i) if ((bi & 3) == i) val[i] = -3e38f; }
                        wsum_ += bsc; if (lane == k) { my_e = bi; my_s = bsc; }
                    }
                    if (lane < 8) { const int rk = __hip_atomic_fetch_add(&hist[my_e], 1, __ATOMIC_RELAXED, __HIP_MEMORY_SCOPE_WORKGROUP); asg_e[tl * 8 + lane] = my_e; asg_r[tl * 8 + lane] = rk; asg_w[tl * 8 + lane] = my_s / wsum_ * 2.5f; }
                }
                __syncthreads();
                if (tid < 256) { const int c = hist[tid]; basel[tid] = c ? (int)atomicAdd(&CNT[tid], (unsigned)c) : 0; }
                __syncthreads();
                for (int u = tid; u < 1024; u += 512) { const int e = asg_e[u]; const int pos = basel[e] + asg_r[u]; DST[(size_t)e * NTOK + pos] = (chunk * 128) * 8 + u; WL[(size_t)e * NTOK + pos] = asg_w[u]; }
                __syncthreads();
            }
        }
        GRID_BAR();
        for (int rep = 0; rep < NREP(9); ++rep) if (PH(9)) { LAUNDER_TID
            unsigned* ctl = (unsigned*)WSP(WS_CTL); bf16_t* H = (bf16_t*)WSP(WS_H); bf16_t* WGU = (bf16_t*)WSP(WS_WGU); int* DST = (int*)WSP(WS_DST); bf16_t* ACT = (bf16_t*)WSP(WS_ACT);
            const unsigned* CNT = ctl + CW_CNT + l * 256;
            if (tid < 256) CNTL[tid] = (int)__hip_atomic_load(CNT + tid, __ATOMIC_RELAXED, __HIP_MEMORY_SCOPE_AGENT);
            __syncthreads();
            if (tid == 0) { int s = 0; for (int e = 0; e < 256; ++e) { TP[e] = s; s += (CNTL[e] + 255) >> 8; } TP[256] = s; }
            if (tid == 64) { int s = 0; const int x = bx & 7; for (int i = 0; i < 32; ++i) { TPX[i] = s; s += (CNTL[8 * i + x] + 255) >> 8; } TPX[32] = s; }
            __syncthreads();
            pg8::Gemm g{H, WGU + (size_t)l * NEXP * 512 * DM, DM};
            pg8::GroupedOrder<true> S{TP, TPX, CNTL, 2, (G - (bx & 7) + 7) >> 3, bx >> 3, bx & 7, DST};
            pg8::EpiGU E{ACT};
            pg8::gemm_phase<pg8::EpiGU, pg8::GroupedOrder<true>>(lds, g, S, E, wid);
        }
        GRID_BAR();
        for (int rep = 0; rep < NREP(10); ++rep) if (PH(10)) { LAUNDER_TID
            bf16_t* ACTSH = (bf16_t*)WSP(WS_ACTSH); bf16_t* WSD = (bf16_t*)WSP(WS_WSD); bf16_t* YSH = (bf16_t*)WSP(WS_YSH); bf16_t* ACT = (bf16_t*)WSP(WS_ACT); bf16_t* WD = (bf16_t*)WSP(WS_WD); bf16_t* YB = (bf16_t*)WSP(WS_YB); int* DST = (int*)WSP(WS_DST); float* WL = (float*)WSP(WS_WL);
            if (PH(12)) { pg8::Gemm g{ACTSH, WSD + (size_t)l * DM * 256, 256}; pg8::StaticOrder S; S.init(NTOK, DM, G, bx);
              pg8::EpiShDown E{YSH};
              pg8::gemm_phase<pg8::EpiShDown, pg8::StaticOrder>(lds, g, S, E, wid); }
            if (PH(13)) { pg8::Gemm g{ACT, WD + (size_t)l * NEXP * DM * 256, 256};
              pg8::GroupedOrder<false> S{TP, TPX, CNTL, 4, (G - (bx & 7) + 7) >> 3, bx >> 3, bx & 7, nullptr};
              pg8::EpiDown E{YB, DST, WL};
              pg8::gemm_phase<pg8::EpiDown, pg8::GroupedOrder<false>>(lds, g, S, E, wid); }
        }
        GRID_BAR();
        for (int rep = 0; rep < NREP(11); ++rep) if (PH(11)) { LAUNDER_TID
            bf16_t* YSH = (bf16_t*)WSP(WS_YSH); bf16_t* YB = (bf16_t*)WSP(WS_YB); float* X1 = (float*)WSP(WS_X1); float* OUT = OUTP; bf16_t* H = (bf16_t*)WSP(WS_H); float* ADA = (float*)WSP(WS_ADA); const float* ada_l = (const float*)WSP(WS_ADA) + (size_t)l * 8 * 6144;
            const int gw = bx * 8 + wid, NGW = G * 8; const float* lg = INP(15) + l * DM; const float* lb = INP(16) + l * DM;
            for (int m = gw; m < NTOK; m += NGW) { const int b = m >> 12; const float* ad = ada_l + (size_t)b * 6144;
                float y[2][8]; u32x4 t[2][9];
#pragma unroll
                for (int j = 0; j < 2; ++j) { const int c0 = 512 * j + 8 * lane;
                    t[j][8] = *(const GAS u32x4*)(YSH + (size_t)m * DM + c0);
#pragma unroll
                    for (int k = 0; k < 8; ++k) t[j][k] = *(const GAS u32x4*)(YB + ((size_t)m * 8 + k) * DM + c0); }
                f32x4 xa[2][2];
#pragma unroll
                for (int j = 0; j < 2; ++j) { const float* xp = X1 + (size_t)m * DM + 512 * j + 8 * lane; xa[j][0] = *(const GAS f32x4*)xp; xa[j][1] = *(const GAS f32x4*)(xp + 4); }
#pragma unroll
                for (int j = 0; j < 2; ++j) {
#pragma unroll
                    for (int e = 0; e < 4; ++e) { y[j][2 * e] = __uint_as_float(t[j][8][e] << 16); y[j][2 * e + 1] = __uint_as_float(t[j][8][e] & 0xffff0000u); }
#pragma unroll
                    for (int k = 0; k < 8; ++k)
#pragma unroll
                        for (int e = 0; e < 4; ++e) { y[j][2 * e] += __uint_as_float(t[j][k][e] << 16); y[j][2 * e + 1] += __uint_as_float(t[j][k][e] & 0xffff0000u); } }
                float v[2][8]; float s1 = 0.f;
#pragma unroll
                for (int j = 0; j < 2; ++j) { const float* gp = ad + 5 * 1024 + 512 * j + 8 * lane; const f32x4 ga = *(const f32x4*)gp, gb = *(const f32x4*)(gp + 4);
#pragma unroll
                    for (int e = 0; e < 8; ++e) { const float g2 = (e < 4 ? ga[e & 3] : gb[e & 3]) + 1.f; const float xv = (e < 4 ? xa[j][0][e & 3] : xa[j][1][e & 3]); v[j][e] = xv * ALPHA + g2 * y[j][e]; s1 += v[j][e]; } }
                const float mean = wave_sum(s1) * (1.f / DM); float s2 = 0.f;
#pragma unroll
                for (int j = 0; j < 2; ++j)
#pragma unroll
                    for (int e = 0; e < 8; ++e) { v[j][e] -= mean; s2 += v[j][e] * v[j][e]; }
                const float rstd = 1.f / sqrtf(wave_sum(s2) * (1.f / DM) + LN_EPS);
                const float* adn = ADA + ((size_t)(l + 1) * 8 + b) * 6144;
#pragma unroll
                for (int j = 0; j < 2; ++j) { const int c0 = 512 * j + 8 * lane; const f32x4 ga = *(const f32x4*)(lg + c0), gb = *(const f32x4*)(lg + c0 + 4), ba = *(const f32x4*)(lb + c0), bb = *(const f32x4*)(lb + c0 + 4);
                    f32x4 xo0, xo1;
#pragma unroll
                    for (int e = 0; e < 4; ++e) { xo0[e] = v[j][e] * rstd * ga[e] + ba[e]; xo1[e] = v[j][4 + e] * rstd * gb[e] + bb[e]; }
                    *(f32x4*)(OUT + (size_t)m * DM + c0) = xo0; *(f32x4*)(OUT + (size_t)m * DM + c0 + 4) = xo1;
                    if (l + 1 < DEPTH) { const f32x4 sha = *(const f32x4*)(adn + c0), shb = *(const f32x4*)(adn + c0 + 4), sca = *(const f32x4*)(adn + 1024 + c0) + 1.f, scb = *(const f32x4*)(adn + 1024 + c0 + 4) + 1.f;
                        const f32x4 h0 = xo0 * sca + sha, h1 = xo1 * scb + shb;
                        u32x4 hw; hw.x = cvtpk(h0[0], h0[1]); hw.y = cvtpk(h0[2], h0[3]); hw.z = cvtpk(h1[0], h1[1]); hw.w = cvtpk(h1[2], h1[3]); *(u32x4*)(H + (size_t)m * DM + c0) = hw; } } }
        }
        if (l + 1 < DEPTH) GRID_BAR();
    }
}

extern "C" void kernel_launch(void* const* d_in, const int* in_sizes, int n_in, void* d_out, int out_size, void* d_ws, size_t ws_size, hipStream_t stream) {
    static int grid = 0;
    if (grid == 0) {
        if (n_in != 25 || out_size != NTOK * DM || ws_size < WS_END) { fprintf(stderr, "kernel_launch: unexpected shapes (n_in %d, out %d, ws %zu)\n", n_in, out_size, ws_size); grid = -1; return; }
        int dev = 0, cus = 0;
        if (hipGetDevice(&dev) != hipSuccess || hipDeviceGetAttribute(&cus, hipDeviceAttributeMultiprocessorCount, dev) != hipSuccess) { grid = -1; return; }
        if (hipFuncSetAttribute((const void*)mega_fwd, hipFuncAttributeMaxDynamicSharedMemorySize, LDS_BYTES) != hipSuccess) { fprintf(stderr, "kernel_launch: hipFuncSetAttribute failed\n"); grid = -1; return; }
        int per_cu = 0;
        if (hipOccupancyMaxActiveBlocksPerMultiprocessor(&per_cu, (const void*)mega_fwd, 512, LDS_BYTES) != hipSuccess || per_cu < 1) fprintf(stderr, "kernel_launch: occupancy query says %d\n", per_cu);
        (void)hipGetLastError();
        grid = cus;
    }
    if (grid < 0) return;
    if (hipMemsetAsync((char*)d_ws + WS_CTL, 0, CTL_BYTES, stream) != hipSuccess) return;
    Args a{};
    for (int i = 0; i < 25; ++i) a.in[i] = (const float*)d_in[i];
    a.out = (float*)d_out; a.ws = (unsigned char*)d_ws;
    hipLaunchKernelGGL(mega_fwd, dim3(grid), dim3(512), LDS_BYTES, stream, a);
}
```

```cpp
#include <hip/hip_runtime.h>
#include <cstdio>
#include <cstdint>

#define DI __device__ __forceinline__
#define LAS __attribute__((address_space(3)))
#define GAS __attribute__((address_space(1)))
typedef unsigned short bf16_t;
typedef short bf16x8 __attribute__((ext_vector_type(8)));
typedef short s16x4 __attribute__((ext_vector_type(4)));
typedef float f32x2 __attribute__((ext_vector_type(2)));
typedef float f32x4 __attribute__((ext_vector_type(4)));
typedef float f32x16 __attribute__((ext_vector_type(16)));
typedef unsigned u32x2 __attribute__((ext_vector_type(2)));
typedef unsigned u32x4 __attribute__((ext_vector_type(4)));

constexpr int DM = 1024, NB = 8, SEQ = 4096, NTOK = NB * SEQ, DEPTH = 2;
constexpr int D_IN = 2450, QKV_N = 2560;
constexpr int NEXP = 256, TOPK = 8, EDIM = 256;
constexpr float LOG2E = 1.4426950408889634f;
constexpr float C2 = 0.125f * LOG2E;
constexpr float ALPHA = 1.4142135623730951f;
constexpr float LN_EPS = 1e-5f;
constexpr int C_AQ = 0, C_AK = 384, C_AV = 512, C_BQ = 640, C_BKC = 896, C_BVC = 960, C_BKS = 1024, C_BVS = 1088, C_BKW = 1152, C_BVW = 1216,
              C_CQ = 1280, C_CK = 1664, C_CV = 2048, C_SM = 2432;
constexpr int O_A = 0, O_B = 384, O_C = 640;

constexpr size_t MiB = 1u << 20;
constexpr size_t WS_CTL = 0, CTL_BYTES = 1 * MiB;
constexpr size_t WS_ADA = 1 * MiB;
constexpr size_t WS_CPOS = WS_ADA + 512 * 1024;
constexpr size_t WS_KCMP = 2 * MiB;
constexpr size_t WS_VCMP = WS_KCMP + 256 * 1024;
constexpr size_t WS_DC = 3 * MiB;
constexpr size_t WS_KM = 3 * MiB + 832 * 1024;
constexpr size_t WS_WCT = 4 * MiB;
constexpr size_t WS_WIN = 8 * MiB;
constexpr size_t WS_WO = 18 * MiB;
constexpr size_t WS_WSH = 22 * MiB;
constexpr size_t WS_WSD = 25 * MiB;
constexpr size_t WS_WGU = 32 * MiB;
constexpr size_t WS_WD = 544 * MiB;
constexpr size_t WS_H = 800 * MiB;
constexpr size_t WS_X1 = 864 * MiB;
constexpr size_t WS_LOG = 992 * MiB;
constexpr size_t WS_ACTSH = 1024 * MiB;
constexpr size_t WS_YSH = 1040 * MiB;
constexpr size_t WS_DST = 1104 * MiB;
constexpr size_t WS_WL = 1136 * MiB;
constexpr size_t WS_SMALL = 1168 * MiB;
constexpr size_t WS_ACT = 1172 * MiB;
constexpr size_t WS_R1 = 1332 * MiB;
constexpr size_t WS_QKV = WS_R1;
constexpr size_t WS_O = WS_R1 + 160 * MiB;
constexpr size_t WS_V = WS_R1 + 224 * MiB;
constexpr size_t WS_YB = WS_R1;
constexpr size_t WS_END = 1844 * MiB;

constexpr int CW_BAR = 4096;
constexpr int CW_Q = 16384;
constexpr int CW_CNT = 32768;

constexpr int RING_BYTES = 131072;
constexpr int L_MISC = RING_BYTES;
constexpr int L_LUT = L_MISC + 256;
constexpr int L_TP = L_LUT + 5120;
constexpr int L_CNT = L_TP + 1040;
constexpr int L_PT = L_CNT + 1024;
constexpr int L_TPX = L_PT + 256;
constexpr int LDS_BYTES = 147456;
static_assert(L_TPX + 144 <= LDS_BYTES, "LDS map");

DI unsigned cvtpk(float lo, float hi) { typedef __bf16 b2 __attribute__((ext_vector_type(2))); f32x2 v = {lo, hi}; b2 b = __builtin_convertvector(v, b2); return __builtin_bit_cast(unsigned, b); }
DI float bf2f(bf16_t v) { return __uint_as_float((unsigned)v << 16); }
DI float fast_exp2(float x) { return __builtin_amdgcn_exp2f(x); }
DI float sigmoidf_(float x) { return 1.f / (1.f + __expf(-x)); }
DI float siluf_(float x) { return x / (1.f + __expf(-x)); }

#define XB_TMO      128
#define XB_XCNT(j)  (256  + 64 * (j))
#define XB_XSUB(j)  (1280 + 64 * (j))
#define XB_XGEN(j)  (2304 + 64 * (j))
#define XB_TOP      3328
#define XB_TOPGEN   3392
#define XCD_BAR_WORDS 3456
#define XB_SPIN_CAP (1u << 22)

__device__ __forceinline__ unsigned xb_ld(unsigned* p)              { return __hip_atomic_load(p, __ATOMIC_RELAXED, __HIP_MEMORY_SCOPE_AGENT); }
__device__ __forceinline__ unsigned xb_add(unsigned* p, unsigned v) { return __hip_atomic_fetch_add(p, v, __ATOMIC_RELAXED, __HIP_MEMORY_SCOPE_AGENT); }
__device__ __forceinline__ unsigned xb_xcc_id() { return (unsigned)__builtin_amdgcn_s_getreg((3 << 11) | 20) & 0xFu; }
#define XB_SPIN(cond, bar) do { unsigned _sp = 0; while (cond) { __builtin_amdgcn_s_sleep(1); \
    if ((++_sp & 255u) == 0u) { if (xb_ld(&(bar)[XB_TMO])) break; if (_sp > XB_SPIN_CAP) { atomicAdd(&(bar)[XB_TMO], 1u); break; } } } } while (0)

struct XcdBarrier { unsigned* bar; unsigned x; volatile LAS unsigned* st; };

__device__ __forceinline__ XcdBarrier xcd_barrier_post(unsigned* bar, volatile LAS unsigned* st) {
    XcdBarrier b; b.bar = bar; b.x = xb_xcc_id(); b.st = st;
    if (threadIdx.x == 0) (void)xb_add(&bar[XB_XCNT(b.x)], 1u);
    return b;
}
__device__ __forceinline__ void xcd_barrier_complete(unsigned* bar, unsigned x, unsigned& nloc, unsigned& nx) {
    const unsigned G = gridDim.x * gridDim.y * gridDim.z;
    unsigned sum, cnt, mine, sp = 0u;
    for (;;) {
        sum = 0u; cnt = 0u; mine = 0u;
#pragma unroll
        for (unsigned j = 0; j < 16; ++j) { const unsigned c = xb_ld(&bar[XB_XCNT(j)]); sum += c; cnt += (c > 0u) ? 1u : 0u; mine = (j == x) ? c : mine; }
        if (sum == G) break;
        __builtin_amdgcn_s_sleep(1);
        if ((++sp & 255u) == 0u) { if (xb_ld(&bar[XB_TMO])) break; if (sp > XB_SPIN_CAP) { atomicAdd(&bar[XB_TMO], 1u); break; } }
    }
    nloc = mine > 0u ? mine : 1u; nx = cnt > 0u ? cnt : 1u;
}
__device__ __forceinline__ void xcd_barrier(const XcdBarrier& b, bool leader_thread) {
    asm volatile("s_waitcnt vmcnt(0)" ::: "memory");
    __syncthreads();
    if (leader_thread) {
        unsigned* bar = b.bar;
        __builtin_amdgcn_s_waitcnt(0);
        unsigned nloc = b.st[0], nx = b.st[1];
        if (nloc == 0u) { xcd_barrier_complete(bar, b.x, nloc, nx); b.st[0] = nloc; b.st[1] = nx; }
        const unsigned old = xb_add(&bar[XB_XSUB(b.x)], 1u);
        const unsigned gen = old / nloc;
        if (old + 1u == (gen + 1u) * nloc) {
            __builtin_amdgcn_fence(__ATOMIC_RELEASE, "agent");
            asm volatile("s_waitcnt vmcnt(0)" ::: "memory");
            const unsigned og = xb_add(&bar[XB_TOP], 1u);
            const unsigned tg = og / nx;
            if (og + 1u == (tg + 1u) * nx) xb_add(&bar[XB_TOPGEN], 1u);
            else XB_SPIN(xb_ld(&bar[XB_TOPGEN]) == tg, bar);
            __builtin_amdgcn_fence(__ATOMIC_ACQUIRE, "agent");
            xb_add(&bar[XB_XGEN(b.x)], 1u);
            asm volatile("s_waitcnt vmcnt(0)" ::: "memory");
        } else {
            XB_SPIN(xb_ld(&bar[XB_XGEN(b.x)]) == gen, bar);
            __builtin_amdgcn_fence(__ATOMIC_ACQUIRE, "agent");
            asm volatile("s_waitcnt vmcnt(0)" ::: "memory");
        }
    }
    __syncthreads();
}

namespace pg8 {
constexpr int BM = 256, BK = 64, HALF = 128, HTB = HALF * BK * 2, STAGE_BYTES = 8 * HTB, NXCD = 8, WGM = 8;
__host__ __device__ __forceinline__ int lds_byte(int r, int c) { const int st = (r >> 4) * 2 + (c >> 5), rr = r & 15, cc = c & 31, ob = rr * 64 + cc * 2; return st * 1024 + (ob ^ (((ob >> 9) & 1) << 5)); }
__host__ __device__ __forceinline__ void stage_rc(int b, int& R, int& C) { const int st = b / 1024, sb = b % 1024, swz = sb ^ (((sb >> 9) & 1) << 5); R = (st >> 1) * 16 + swz / 64; C = (st & 1) * 32 + (swz % 64) / 2; }
__host__ __device__ __forceinline__ int perm32(int rho) { const int n = rho >> 4, i = rho & 15; return 8 * (i >> 2) + 4 * n + (i & 3); }

struct Unit { int pm, pn, e, lrow0, cnt; };
struct Gemm { const bf16_t* A; const bf16_t* Bt; int K; };

struct StaticOrder {
    int nM, nN, nwg, G, c;
    DI void init(int M, int N, int G_, int c_) { nM = M / BM; nN = N / BM; nwg = nM * nN; G = G_; c = c_; }
    DI bool next(int i, Unit& u) const {
        const long L = (long)i * G + c; if (L >= nwg) return false;
        int wgid = (int)L; { const int q = nwg / NXCD, r = nwg % NXCD, xcd = wgid % NXCD, off = wgid / NXCD; wgid = (xcd < r ? xcd * (q + 1) : r * (q + 1) + (xcd - r) * q) + off; }
        const int nig = WGM * nN, gid = wgid / nig, fm = gid * WGM, gsz = (nM - fm) < WGM ? (nM - fm) : WGM;
        u.pm = fm + ((wgid % nig) % gsz); u.pn = (wgid % nig) / gsz; u.e = 0; u.lrow0 = 0; u.cnt = 0; return true;
    }
    static constexpr bool GATHER = false;
    DI unsigned tokpair(const Unit&, int, int) const { return 0u; }
};
template <bool GATHER_> struct GroupedOrder {
    static constexpr bool GATHER = GATHER_;
    const LAS int* TP; const LAS int* TPX; const LAS int* CNT; int NT, nwx, rk, x; const int* list;
    DI bool next(int i, Unit& u) const {
        const int total = TPX[32] * NT; const int L = i * nwx + rk; if (L >= total) return false;
        const int mt = L / NT, nt = L - mt * NT;
        int lo = 0, hi = 31;
        while (lo < hi) { const int mid = (lo + hi + 1) >> 1; if (TPX[mid] <= mt) lo = mid; else hi = mid - 1; }
        const int e = 8 * lo + x, ml = mt - TPX[lo];
        u.pm = __builtin_amdgcn_readfirstlane(TP[e] + ml); u.pn = __builtin_amdgcn_readfirstlane(e * NT + nt); u.e = __builtin_amdgcn_readfirstlane(e);
        u.lrow0 = __builtin_amdgcn_readfirstlane(ml * BM); u.cnt = __builtin_amdgcn_readfirstlane(CNT[e]); return true;
    }
    DI unsigned tokpair(const Unit& u, int R0, int) const {
        int l0 = u.lrow0 + R0, l1 = l0 + HALF; l0 = l0 < u.cnt ? l0 : u.cnt - 1; l1 = l1 < u.cnt ? l1 : u.cnt - 1;
        const unsigned t0 = (unsigned)(list[u.e * NTOK + l0] >> 3), t1 = (unsigned)(list[u.e * NTOK + l1] >> 3); return t0 | (t1 << 16);
    }
};

template <class Epi, class Sched>
__device__ __forceinline__ void gemm_phase(LAS unsigned char* lds, const Gemm g, const Sched& S, const Epi& E, int wid_) {
    int lane; asm volatile("v_mbcnt_lo_u32_b32 %0, -1, 0\n\tv_mbcnt_hi_u32_b32 %0, -1, %0" : "=v"(lane));
    int wid = wid_; asm volatile("" : "+s"(wid)); const int tid = wid * 64 + lane, wr = wid >> 2, wc = wid & 3, fr = lane & 15, fq = lane >> 4;
    const int K = g.K, nt = K / BK;
    constexpr bool GA = Sched::GATHER;
    unsigned voffA[2], voffB[2]; int RA[2];
#pragma unroll
    for (int i = 0; i < 2; ++i) { int R, C; stage_rc(tid * 16 + i * 8192, R, C); const int Rb = Epi::PERM ? ((R & ~31) + perm32(R & 31)) : R;
        RA[i] = R; voffA[i] = GA ? (unsigned)(C * 2) : (unsigned)(R * K + C) * 2u; voffB[i] = (unsigned)(Rb * K + C) * 2u; }
    const size_t kstep = (size_t)(BK * 2);
    const size_t hstep = (size_t)HALF * K * 2;
    const size_t tstep = 2 * hstep;
    const unsigned ldsw = (unsigned)wid * 1024u;
    const int aoff = lds_byte(wr * 64 + fr, fq * 8), boff = lds_byte(wc * 32 + fr, fq * 8);
#define PG8_SA(b, h) (((b) * 2 + (h)) * HTB)
#define PG8_SB(b, h) ((4 + (b) * 2 + (h)) * HTB)
#define PG8_STAGE(bufoff, gbase, voff) do { _Pragma("unroll") for (int _i = 0; _i < 2; ++_i) \
        __builtin_amdgcn_global_load_lds((const unsigned*)((const char*)(gbase) + (voff)[_i]), (LAS unsigned*)(lds + (bufoff) + ldsw + _i * 8192), 16, 0, 0); } while (0)
#define PG8_STAGEA(bufoff, ubase, tp, hh, kb) do { _Pragma("unroll") for (int _i = 0; _i < 2; ++_i) { \
        const char* _p = GA ? ((const char*)g.A + (size_t)(kb) + (size_t)((((tp)[_i] >> (16 * (hh))) & 0xffffu) * (unsigned)(K * 2)) + voffA[_i]) : ((ubase) + (size_t)(hh) * hstep + (size_t)(kb) + voffA[_i]); \
        __builtin_amdgcn_global_load_lds((const unsigned*)_p, (LAS unsigned*)(lds + (bufoff) + ldsw + _i * 8192), 16, 0, 0); } } while (0)
#define PG8_LDA(dst, b, h) do { _Pragma("unroll") for (int m = 0; m < 4; ++m) _Pragma("unroll") for (int k = 0; k < 2; ++k) dst[m][k] = *(const LAS bf16x8*)(lds + PG8_SA(b, h) + aoff + m * 2048 + k * 1024); } while (0)
#define PG8_LDB(dst, b, h) do { _Pragma("unroll") for (int n = 0; n < 2; ++n) _Pragma("unroll") for (int k = 0; k < 2; ++k) dst[n][k] = *(const LAS bf16x8*)(lds + PG8_SB(b, h) + boff + n * 2048 + k * 1024); } while (0)
#define PG8_MMA(ai, bj, At, Bt) do { __builtin_amdgcn_s_setprio(1); _Pragma("unroll") for (int m = 0; m < 4; ++m) _Pragma("unroll") for (int n = 0; n < 2; ++n) _Pragma("unroll") for (int k = 0; k < 2; ++k) \
        acc[ai][bj][m][n] = __builtin_amdgcn_mfma_f32_16x16x32_bf16(Bt[n][k], At[m][k], acc[ai][bj][m][n], 0, 0, 0); __builtin_amdgcn_s_setprio(0); } while (0)
#define PG8_WAIT_V(n) asm volatile("s_waitcnt vmcnt(" #n ")" ::: "memory")
#define PG8_WAIT_L(n) asm volatile("s_waitcnt lgkmcnt(" #n ")" ::: "memory")
#define PG8_BAR __builtin_amdgcn_s_barrier()
#define PG8_SCHED __builtin_amdgcn_sched_barrier(0)
    Unit cur, nxt; int ui = 0;
    if (!S.next(0, cur)) return;
    f32x4 acc[2][2][4][2];
#pragma unroll
    for (int a = 0; a < 2; ++a)
#pragma unroll
        for (int b = 0; b < 2; ++b)
#pragma unroll
            for (int m = 0; m < 4; ++m)
#pragma unroll
                for (int n = 0; n < 2; ++n) acc[a][b][m][n] = (f32x4){0.f, 0.f, 0.f, 0.f};
    bf16x8 At[4][2], B0[2][2], B1[2][2];
    unsigned tpc[2] = {0u, 0u}, tpn[2] = {0u, 0u};
    if (GA) {
#pragma unroll
        for (int i = 0; i < 2; ++i) tpc[i] = S.tokpair(cur, RA[i], 0); }
#define PG8_FRESH_R(i, Rv) int Rv; { int l2_; asm volatile("v_mbcnt_lo_u32_b32 %0, -1, 0\n\tv_mbcnt_hi_u32_b32 %0, -1, %0" : "=v"(l2_)); int C2_; stage_rc((wid * 64 + l2_) * 16 + (i) * 8192, Rv, C2_); }
    const char* cA = GA ? (const char*)g.A : (const char*)g.A + (size_t)cur.pm * tstep; const char* cB = (const char*)g.Bt + (size_t)cur.pn * tstep;
    {
        PG8_STAGE(PG8_SB(0, 0), cB, voffB); PG8_STAGE(PG8_SB(0, 1), cB + hstep, voffB); PG8_STAGEA(PG8_SA(0, 0), cA, tpc, 0, 0); PG8_STAGEA(PG8_SA(0, 1), cA, tpc, 1, 0);
        if (wr == 1) PG8_BAR;
        PG8_WAIT_V(2); PG8_BAR;
        PG8_STAGE(PG8_SB(1, 0), cB + kstep, voffB); PG8_STAGEA(PG8_SA(1, 0), cA, tpc, 0, kstep); PG8_STAGE(PG8_SB(1, 1), cB + hstep + kstep, voffB);
        PG8_WAIT_V(6); PG8_BAR;
    }
    for (;;) {
        u32x2 warm_ = E.warm(cur, lane);
        const bool has_next = S.next(ui + 1, nxt);
        const char* nA = GA ? cA : (has_next ? (const char*)g.A + (size_t)nxt.pm * tstep : cA); const char* nB = has_next ? (const char*)g.Bt + (size_t)nxt.pn * tstep : cB;
        if (GA) {
#pragma unroll
            for (int i = 0; i < 2; ++i) { if (has_next) { PG8_FRESH_R(i, Rn_); tpn[i] = S.tokpair(nxt, Rn_, 0); } else tpn[i] = tpc[i]; } }
#pragma unroll 1
        for (int t = 0; t < nt; t += 2) {
            const bool last = (t == nt - 2);
            const size_t k1 = (size_t)(t + 1) * kstep;
            const size_t k2 = last ? 0 : (size_t)(t + 2) * kstep; const size_t k3 = k2 + kstep;
            const char* a2 = last ? nA : cA;
            unsigned tp2[2];
#pragma unroll
            for (int i = 0; i < 2; ++i) tp2[i] = last ? tpn[i] : tpc[i];
            const char* b2 = last ? nB : cB + (size_t)(t + 2) * kstep;
            const char* b3 = b2 + kstep;
            PG8_LDB(B0, 0, 0); PG8_LDB(B1, 0, 1); PG8_SCHED; PG8_LDA(At, 0, 0); PG8_STAGEA(PG8_SA(1, 1), cA, tpc, 1, k1);
            PG8_WAIT_V(8); PG8_WAIT_L(0); PG8_BAR; PG8_MMA(0, 0, At, B0); PG8_MMA(0, 1, At, B1); PG8_BAR; PG8_SCHED;
            PG8_LDA(At, 0, 1); PG8_STAGE(PG8_SB(0, 0), b2, voffB); PG8_STAGE(PG8_SB(0, 1), b2 + hstep, voffB); PG8_STAGEA(PG8_SA(0, 0), a2, tp2, 0, k2);
            PG8_WAIT_V(8); PG8_WAIT_L(0); PG8_BAR; PG8_MMA(1, 0, At, B0); PG8_MMA(1, 1, At, B1); PG8_BAR; PG8_SCHED;
            PG8_LDB(B0, 1, 0); PG8_LDB(B1, 1, 1); PG8_SCHED; PG8_LDA(At, 1, 0); PG8_STAGEA(PG8_SA(0, 1), a2, tp2, 1, k2);
            PG8_WAIT_V(8); PG8_WAIT_L(0); PG8_BAR; PG8_MMA(0, 0, At, B0); PG8_MMA(0, 1, At, B1); PG8_BAR; PG8_SCHED;
            PG8_LDA(At, 1, 1); PG8_STAGE(PG8_SB(1, 0), b3, voffB); PG8_STAGE(PG8_SB(1, 1), b3 + hstep, voffB); PG8_STAGEA(PG8_SA(1, 0), a2, tp2, 0, k3);
            PG8_WAIT_V(8); PG8_WAIT_L(0); PG8_BAR; PG8_MMA(1, 0, At, B0); PG8_MMA(1, 1, At, B1); PG8_BAR; PG8_SCHED;
        }
        if (wr == 0) PG8_BAR;
        asm volatile("" :: "v"(warm_));
        E(acc, cur, wr, wc, fr, fq);
        if (!has_next) break;
#pragma unroll
        for (int a = 0; a < 2; ++a)
#pragma unroll
            for (int b = 0; b < 2; ++b)
#pragma unroll
                for (int m = 0; m < 4; ++m)
#pragma unroll
                    for (int n = 0; n < 2; ++n) acc[a][b][m][n] = (f32x4){0.f, 0.f, 0.f, 0.f};
        cur = nxt; cA = nA; cB = nB; ++ui;
#pragma unroll
        for (int i = 0; i < 2; ++i) tpc[i] = tpn[i];
        if (wr == 1) PG8_BAR;
    }
    PG8_WAIT_V(0);
    PG8_BAR;
#undef PG8_SA
#undef PG8_SB
#undef PG8_STAGE
#undef PG8_STAGEA
#undef PG8_FRESH_R
#undef PG8_LDA
#undef PG8_LDB
#undef PG8_MMA
#undef PG8_WAIT_V
#undef PG8_WAIT_L
#undef PG8_BAR
#undef PG8_SCHED
}

DI u32x4 pack8(const f32x4& v0, const f32x4& v1) { u32x4 w; w.x = cvtpk(v0[0], v0[1]); w.y = cvtpk(v0[2], v0[3]); w.z = cvtpk(v1[0], v1[1]); w.w = cvtpk(v1[2], v1[3]); return w; }

struct EpiQKV { static constexpr bool PERM = true;
    DI u32x2 warm(const Unit&, int) const { return (u32x2){0u, 0u}; }
    bf16_t* O; float* SM;
    DI void operator()(const f32x4 (&acc)[2][2][4][2], const Unit& u, int wr, int wc, int fr, int fq) const {
        const int row0 = u.pm * BM + wr * 64 + fr, colt = u.pn * BM + wc * 32 + 8 * fq;
#pragma unroll
        for (int bj = 0; bj < 2; ++bj) { const int col = colt + bj * HALF;
            const bool isq = (col < C_AK) || (col >= C_BQ && col < C_BKC) || (col >= C_CQ && col < C_CK);
            const float sc = isq ? C2 : 1.f; const bool sm = (col >= C_SM && col < C_SM + 32);
#pragma unroll
            for (int ai = 0; ai < 2; ++ai)
#pragma unroll
                for (int m = 0; m < 4; ++m) { const int row = row0 + ai * HALF + m * 16;
                    const f32x4 v0 = acc[ai][bj][m][0] * sc, v1 = acc[ai][bj][m][1] * sc;
                    *(u32x4*)(O + (size_t)row * QKV_N + col) = pack8(v0, v1);
                    if (sm) { float* sp = SM + (size_t)row * 32 + (col - C_SM); *(f32x4*)sp = v0; *(f32x4*)(sp + 4) = v1; } } }
    }
};
struct EpiWO { static constexpr bool PERM = false;
    DI u32x2 warm(const Unit&, int) const { return (u32x2){0u, 0u}; }
    const float* xin; float* V; const float* g1;
    DI void operator()(const f32x4 (&acc)[2][2][4][2], const Unit& u, int wr, int wc, int fr, int fq) const {
        const int row0 = u.pm * BM + wr * 64 + fr, col0 = u.pn * BM + wc * 32 + 4 * fq; const int b = (u.pm * BM) >> 12;
#pragma unroll
        for (int bj = 0; bj < 2; ++bj)
#pragma unroll
            for (int n = 0; n < 2; ++n) { const int col = col0 + bj * HALF + n * 16; const f32x4 gg = *(const f32x4*)(g1 + (size_t)b * 6144 + col) + 1.f;
#pragma unroll
                for (int ai = 0; ai < 2; ++ai)
#pragma unroll
                    for (int m = 0; m < 4; ++m) { const size_t off = (size_t)(row0 + ai * HALF + m * 16) * DM + col;
                        const f32x4 xv = *(const f32x4*)(xin + off); *(f32x4*)(V + off) = xv * ALPHA + gg * acc[ai][bj][m][n]; } }
    }
};
DI f32x4 swiglu4(const f32x4& g, const f32x4& u) { f32x4 r; r[0] = siluf_(g[0]) * u[0]; r[1] = siluf_(g[1]) * u[1]; r[2] = siluf_(g[2]) * u[2]; r[3] = siluf_(g[3]) * u[3]; return r; }
struct EpiSH { static constexpr bool PERM = true;
    DI u32x2 warm(const Unit&, int) const { return (u32x2){0u, 0u}; }
    float* LOG; bf16_t* ACT;
    DI void operator()(const f32x4 (&acc)[2][2][4][2], const Unit& u, int wr, int wc, int fr, int fq) const {
        const int row0 = u.pm * BM + wr * 64 + fr, c8 = wc * 32 + 8 * fq;
        if (u.pn == 0) {
#pragma unroll
            for (int bj = 0; bj < 2; ++bj)
#pragma unroll
                for (int ai = 0; ai < 2; ++ai)
#pragma unroll
                    for (int m = 0; m < 4; ++m) { float* p = LOG + (size_t)(row0 + ai * HALF + m * 16) * 256 + bj * HALF + c8; *(f32x4*)p = acc[ai][bj][m][0]; *(f32x4*)(p + 4) = acc[ai][bj][m][1]; }
        } else {
            const int cb = (u.pn - 1) * HALF + c8;
#pragma unroll
            for (int ai = 0; ai < 2; ++ai)
#pragma unroll
                for (int m = 0; m < 4; ++m) { const f32x4 a0 = swiglu4(acc[ai][0][m][0], acc[ai][1][m][0]), a1 = swiglu4(acc[ai][0][m][1], acc[ai][1][m][1]);
                    *(u32x4*)(ACT + (size_t)(row0 + ai * HALF + m * 16) * 256 + cb) = pack8(a0, a1); }
        }
    }
};
struct EpiGU { static constexpr bool PERM = true;
    DI u32x2 warm(const Unit&, int) const { return (u32x2){0u, 0u}; }
    bf16_t* ACT;
    DI void operator()(const f32x4 (&acc)[2][2][4][2], const Unit& u, int wr, int wc, int fr, int fq) const {
        const int rin0 = wr * 64 + fr, cb = (u.pn & 1) * HALF + wc * 32 + 8 * fq;
#pragma unroll
        for (int ai = 0; ai < 2; ++ai)
#pragma unroll
            for (int m = 0; m < 4; ++m) { const int rin = rin0 + ai * HALF + m * 16;
                if (u.lrow0 + rin < u.cnt) { const f32x4 a0 = swiglu4(acc[ai][0][m][0], acc[ai][1][m][0]), a1 = swiglu4(acc[ai][0][m][1], acc[ai][1][m][1]);
                    *(u32x4*)(ACT + (size_t)(u.pm * BM + rin) * 256 + cb) = pack8(a0, a1); } }
    }
};
struct EpiDown { static constexpr bool PERM = true;
    bf16_t* YB; const int* DST; const float* WL;
    DI u32x2 warm(const Unit& u, int lane) const { const int o = 16 * (lane & 15); const int* p = DST + (size_t)u.e * NTOK + u.lrow0 + o; const float* q = WL + (size_t)u.e * NTOK + u.lrow0 + o; unsigned t0, t1;
        asm volatile("global_load_dword %0, %2, off\n\tglobal_load_dword %1, %3, off" : "=&v"(t0), "=&v"(t1) : "v"(p), "v"(q) : "memory"); return (u32x2){t0, t1}; }
    DI void operator()(const f32x4 (&acc)[2][2][4][2], const Unit& u, int wr, int wc, int fr, int fq) const {
        const int rin0 = wr * 64 + fr, cb = (u.pn & 3) * BM + wc * 32 + 8 * fq;
#pragma unroll
        for (int ai = 0; ai < 2; ++ai)
#pragma unroll
            for (int m = 0; m < 4; ++m) { const int local = u.lrow0 + rin0 + ai * HALF + m * 16;
                if (local < u.cnt) { const int dst = DST[(size_t)u.e * NTOK + local]; const float w = WL[(size_t)u.e * NTOK + local];
#pragma unroll
                    for (int bj = 0; bj < 2; ++bj) *(u32x4*)(YB + (size_t)dst * DM + cb + bj * HALF) = pack8(acc[ai][bj][m][0] * w, acc[ai][bj][m][1] * w); } }
    }
};
struct EpiShDown { static constexpr bool PERM = true;
    DI u32x2 warm(const Unit&, int) const { return (u32x2){0u, 0u}; }
    bf16_t* Y;
    DI void operator()(const f32x4 (&acc)[2][2][4][2], const Unit& u, int wr, int wc, int fr, int fq) const {
        const int row0 = u.pm * BM + wr * 64 + fr, cb = u.pn * BM + wc * 32 + 8 * fq;
#pragma unroll
        for (int ai = 0; ai < 2; ++ai)
#pragma unroll
            for (int m = 0; m < 4; ++m)
#pragma unroll
                for (int bj = 0; bj < 2; ++bj) *(u32x4*)(Y + (size_t)(row0 + ai * HALF + m * 16) * DM + cb + bj * HALF) = pack8(acc[ai][bj][m][0], acc[ai][bj][m][1]);
    }
};
}

namespace att {
#define MFMA32(a, b, c) __builtin_amdgcn_mfma_f32_32x32x16_bf16((a), (b), (c), 0, 0, 0)
constexpr int A_KB = 0, A_VB = 24576, A_IMP = 49152, A_SEL = A_IMP + 4 * 64 * 65 * 4  , A_DK = A_SEL + 512, A_NEED = A_DK + 768, A_KM = A_NEED + 64, A_END = A_KM + 512;
static_assert(A_END <= RING_BYTES, "attention LDS");
constexpr float NEGINF = -__builtin_inff();
enum { M_BAND = 0, M_SLC = 1, M_FOX = 2, M_CMP1 = 3, M_CMP2 = 4 };
typedef short v4i16_t __attribute__((ext_vector_type(4)));
DI s16x4 vtr(LAS const char* p) { return __builtin_bit_cast(s16x4, __builtin_amdgcn_ds_read_tr16_b64_v4i16((LAS v4i16_t*)p)); }
DI int cofs(int i) { return (i & 3) + 8 * (i >> 2); }

struct Acc { f32x16 o0, o1; float m, l; };
struct PassArgs {
    const bf16_t* Kg; const bf16_t* Vg; int pitch;
    int jfirst, ntiles, step;
    int tq0;
    const LAS float* lut;
    unsigned long long sel;
    float dq; const float* dkg;
    float qn; const float* km;
    float fm, frl;
    LAS float* imp;
};

DI void qk_tile(f32x16& p0, f32x16& p1, LAS const char* kb, const bf16x8 (&qr)[4], int r, int h) {
#pragma unroll
    for (int i = 0; i < 16; ++i) { p0[i] = 0.f; p1[i] = 0.f; }
    LAS const char* rp = kb + r * 128;
#pragma unroll
    for (int s = 0; s < 4; ++s) { const int o = 16 * ((2 * s + h) ^ (r & 7));
        const bf16x8 a0 = *(const LAS bf16x8*)(rp + o), a1 = *(const LAS bf16x8*)(rp + 4096 + o);
        p0 = MFMA32(a0, qr[s], p0); p1 = MFMA32(a1, qr[s], p1); }
}
DI bf16x8 pack_step(const f32x16& x, int s) { u32x4 p; p.x = cvtpk(x[8 * s], x[8 * s + 1]); p.y = cvtpk(x[8 * s + 2], x[8 * s + 3]); p.z = cvtpk(x[8 * s + 4], x[8 * s + 5]); p.w = cvtpk(x[8 * s + 6], x[8 * s + 7]); return __builtin_bit_cast(bf16x8, p); }
DI void pv_tile(f32x16& o0, f32x16& o1, const f32x16& p0, const f32x16& p1, LAS const char* va0, LAS const char* va1) {
#pragma unroll
    for (int blk = 0; blk < 2; ++blk)
#pragma unroll
        for (int s = 0; s < 2; ++s) { const bf16x8 xs = pack_step(blk ? p1 : p0, s); const int ro = (32 * blk + 16 * s) * 128;
            { const s16x4 lo = vtr(va0 + ro), hi = vtr(va0 + ro + 1024); const bf16x8 vf = __builtin_shufflevector(lo, hi, 0, 1, 2, 3, 4, 5, 6, 7); o0 = MFMA32(vf, xs, o0); }
            { const s16x4 lo = vtr(va1 + ro), hi = vtr(va1 + ro + 1024); const bf16x8 vf = __builtin_shufflevector(lo, hi, 0, 1, 2, 3, 4, 5, 6, 7); o1 = MFMA32(vf, xs, o1); } }
}

template <int MODE, int W>
DI void attn_pass(LAS char* lds, const PassArgs& P, const bf16x8 (&qr)[4], Acc& a, int tid_, int lane_) {
    int lane; asm volatile("v_mbcnt_lo_u32_b32 %0, -1, 0\n\tv_mbcnt_hi_u32_b32 %0, -1, %0" : "=v"(lane)); const int tid = (tid_ & ~63) | lane; (void)lane_;
    const int r = lane & 31, h = lane >> 5;
    const int lrow = tid >> 3, lch = tid & 7;
    const size_t goff = (size_t)lrow * P.pitch + lch * 8;
    const int kdst = lrow * 128 + 16 * (lch ^ (lrow & 7)), vdst = lrow * 128 + 16 * (lch ^ (((lrow >> 1) & 1) << 2));
    const int q4 = (lane & 15) >> 2, p4 = lane & 3, g1 = (lane >> 4) & 1, swb = (q4 >> 1) & 1;
    const int vofs0 = (4 * h + q4) * 128 + 16 * (4 * (0 ^ swb) + 2 * g1 + (p4 >> 1)) + 8 * (p4 & 1);
    const int vofs1 = (4 * h + q4) * 128 + 16 * (4 * (1 ^ swb) + 2 * g1 + (p4 >> 1)) + 8 * (p4 & 1);
    const int tq = P.tq0 + r;
    const int wid_ = __builtin_amdgcn_readfirstlane(tid >> 6);
    const size_t goffK = (size_t)lrow * P.pitch + (size_t)((lch ^ (lrow & 7)) * 8), goffV = (size_t)lrow * P.pitch + (size_t)((lch ^ (((lrow >> 1) & 1) << 2)) * 8);
    (void)goff; (void)kdst; (void)vdst;
#define ATT_DMA(jj, slot) do { const size_t t0_ = (size_t)(jj) * 64 * P.pitch; \
        __builtin_amdgcn_global_load_lds((const unsigned*)(P.Kg + t0_ + goffK), (LAS unsigned*)(lds + A_KB + (slot) * 8192 + wid_ * 1024), 16, 0, 0); \
        __builtin_amdgcn_global_load_lds((const unsigned*)(P.Vg + t0_ + goffV), (LAS unsigned*)(lds + A_VB + (slot) * 8192 + wid_ * 1024), 16, 0, 0); \
        if (MODE == M_FOX) __builtin_amdgcn_global_load_lds((const unsigned*)(P.dkg + 64 * (jj) + lane), (LAS unsigned*)(lds + A_DK + (slot) * 256), 4, 0, 0); } while (0)
    if (MODE == M_FOX) { if (tid == 0) { unsigned z_ = 0u; asm volatile("" : "+v"(z_)); *(LAS unsigned*)(lds + A_NEED) = z_; *(LAS unsigned*)(lds + A_NEED + 4) = z_; *(LAS unsigned*)(lds + A_NEED + 8) = z_; }
        if (tid < 64) { *(LAS float*)(lds + A_KM + 4 * tid) = P.km[tid]; *(LAS float*)(lds + A_KM + 256 + 4 * tid) = P.dkg[64 * tid + 63]; } }
    bool wdone = false;
    ATT_DMA(P.jfirst, 0);
    if (P.ntiles > 1) { ATT_DMA(P.jfirst + P.step, 1);
        if (MODE == M_FOX) asm volatile("s_waitcnt vmcnt(3) lgkmcnt(0)\n\ts_barrier" ::: "memory"); else asm volatile("s_waitcnt vmcnt(2) lgkmcnt(0)\n\ts_barrier" ::: "memory");
    } else asm volatile("s_waitcnt vmcnt(0) lgkmcnt(0)\n\ts_barrier" ::: "memory");
    float carry = 0.f;
    int sl = 0;
    for (int it = 0; it < P.ntiles; ++it) {
        const int j = P.jfirst + it * P.step, buf = sl;
        const bool more = (it + 1 < P.ntiles), more2 = (it + 2 < P.ntiles);
        if (more2) { const int s2 = (sl >= 1) ? sl - 1 : 2; ATT_DMA(j + 2 * P.step, s2); }
        const int kv0 = 64 * j;
        bool skip;
        if (MODE == M_BAND) skip = (kv0 > P.tq0 + 31) || (kv0 + 63 < P.tq0 - (W - 1));
        else if (MODE == M_SLC) skip = (kv0 > P.tq0 + 31) || (__ballot((P.sel >> j) & 1ull) == 0ull);
        else if (MODE == M_FOX) skip = (kv0 > P.tq0 + 31) || wdone;
        else skip = (1024 * j > P.tq0);
        if (!skip) {
            LAS const char* kb = lds + A_KB + buf * 8192; LAS const char* vb = lds + A_VB + buf * 8192;
            f32x16 p0, p1;
            bf16x8 kf[8];
            { LAS const char* rp = kb + r * 128;
#pragma unroll
                for (int s = 0; s < 4; ++s) { const int o = 16 * ((2 * s + h) ^ (r & 7)); kf[2 * s] = *(const LAS bf16x8*)(rp + o); kf[2 * s + 1] = *(const LAS bf16x8*)(rp + 4096 + o); } }
            if (MODE == M_FOX) {
#pragma unroll
                for (int k = 0; k < 4; ++k) { const f32x4 d0 = *(const LAS f32x4*)(lds + A_DK + buf * 256 + (8 * k + 4 * h) * 4), d1 = *(const LAS f32x4*)(lds + A_DK + buf * 256 + (32 + 8 * k + 4 * h) * 4);
#pragma unroll
                    for (int e = 0; e < 4; ++e) { p0[4 * k + e] = d0[e]; p1[4 * k + e] = d1[e]; } }
            } else {
#pragma unroll
                for (int i = 0; i < 16; ++i) { p0[i] = 0.f; p1[i] = 0.f; }
            }
            s16x4 vlo[8], vhi[8];
            if (MODE != M_CMP1) {
#pragma unroll
                for (int f = 0; f < 4; ++f) { const int ro = (32 * (f >> 1) + 16 * (f & 1)) * 128;
                    vlo[2 * f] = vtr(vb + vofs0 + ro); vhi[2 * f] = vtr(vb + vofs0 + ro + 1024); vlo[2 * f + 1] = vtr(vb + vofs1 + ro); vhi[2 * f + 1] = vtr(vb + vofs1 + ro + 1024); } }
#pragma unroll
            for (int f = 0; f < 8; ++f) asm volatile("" : "+v"(kf[f]));
#pragma unroll
            for (int s = 0; s < 4; ++s) { p0 = MFMA32(kf[2 * s], qr[s], p0); p1 = MFMA32(kf[2 * s + 1], qr[s], p1); }
            if (MODE != M_CMP1) {
#pragma unroll
                for (int f = 0; f < 8; ++f) asm volatile("" : "+v"(vlo[f]), "+v"(vhi[f])); }
#define ATT_PV(P0_, P1_, KEEP_) do { _Pragma("unroll") for (int f = 0; f < 4; ++f) { u32x4 xp = __builtin_bit_cast(u32x4, pack_step((f >> 1) ? P1_ : P0_, f & 1)); \
                if (MODE == M_SLC) { xp.x = (KEEP_) ? xp.x : 0u; xp.y = (KEEP_) ? xp.y : 0u; xp.z = (KEEP_) ? xp.z : 0u; xp.w = (KEEP_) ? xp.w : 0u; } \
                const bf16x8 xs = __builtin_bit_cast(bf16x8, xp); \
                a.o0 = MFMA32(__builtin_shufflevector(vlo[2 * f], vhi[2 * f], 0, 1, 2, 3, 4, 5, 6, 7), xs, a.o0); \
                a.o1 = MFMA32(__builtin_shufflevector(vlo[2 * f + 1], vhi[2 * f + 1], 0, 1, 2, 3, 4, 5, 6, 7), xs, a.o1); } } while (0)
            bool selb = true;
            if (MODE == M_BAND || MODE == M_SLC) {
                const bool far = (P.tq0 - (kv0 + 63) >= 127) && (MODE == M_SLC || (P.tq0 + 31 - kv0 < W));
                if (!far) { const int base = tq - kv0 - 4 * h; float l0v[16], l1v[16];
#pragma unroll
                    for (int i = 0; i < 16; ++i) { int ix = base - cofs(i); ix = ix < 127 ? ix : 127; ix = ix > 0 ? ix : 0; l0v[i] = P.lut[ix]; int iy = base - 32 - cofs(i); iy = iy < 127 ? iy : 127; iy = iy > 0 ? iy : 0; l1v[i] = P.lut[iy]; }
#pragma unroll
                    for (int i = 0; i < 16; ++i) asm volatile("" : "+v"(l0v[i]), "+v"(l1v[i]));
#pragma unroll
                    for (int i = 0; i < 16; ++i) {
                        { const int rel = base - cofs(i); const bool ok = (MODE == M_SLC) ? (rel >= 0) : ((unsigned)rel < (unsigned)W); p0[i] = ok ? p0[i] + l0v[i] : NEGINF; }
                        { const int rel = base - 32 - cofs(i); const bool ok = (MODE == M_SLC) ? (rel >= 0) : ((unsigned)rel < (unsigned)W); p1[i] = ok ? p1[i] + l1v[i] : NEGINF; } }
                }
                if (MODE == M_SLC) selb = ((P.sel >> j) & 1ull) != 0ull;
            } else if (MODE == M_FOX) {
                const bool full = (kv0 + 63 <= P.tq0);
                if (!full) { const int base = tq - kv0 - 4 * h;
#pragma unroll
                    for (int i = 0; i < 16; ++i) { const int rel = base - cofs(i); p0[i] = (rel >= 0) ? p0[i] : NEGINF; p1[i] = (rel - 32 >= 0) ? p1[i] : NEGINF; } }
            } else {
                const int base = tq - 31 - 16 * (64 * j + 4 * h); float l0v[16], l1v[16];
#pragma unroll
                for (int i = 0; i < 16; ++i) { int ix = base - 16 * cofs(i); ix = ix < 127 ? ix : 127; ix = ix > 0 ? ix : 0; l0v[i] = P.lut[ix]; int iy = base - 512 - 16 * cofs(i); iy = iy < 127 ? iy : 127; iy = iy > 0 ? iy : 0; l1v[i] = P.lut[iy]; }
#pragma unroll
                for (int i = 0; i < 16; ++i) asm volatile("" : "+v"(l0v[i]), "+v"(l1v[i]));
#pragma unroll
                for (int i = 0; i < 16; ++i) { p0[i] = (base - 16 * cofs(i) >= 0) ? p0[i] + l0v[i] : NEGINF; p1[i] = (base - 512 - 16 * cofs(i) >= 0) ? p1[i] + l1v[i] : NEGINF; }
            }
            if (MODE != M_CMP2) {
                float ta = __builtin_fmaxf(__builtin_fmaxf(p0[0], p0[1]), p1[0]), tb = __builtin_fmaxf(__builtin_fmaxf(p0[2], p0[3]), p1[1]);
                ta = __builtin_fmaxf(__builtin_fmaxf(ta, p1[2]), p1[3]);
#pragma unroll
                for (int i = 4; i < 16; i += 4) { ta = __builtin_fmaxf(__builtin_fmaxf(ta, p0[i]), p0[i + 1]); tb = __builtin_fmaxf(__builtin_fmaxf(tb, p0[i + 2]), p0[i + 3]);
                    ta = __builtin_fmaxf(__builtin_fmaxf(ta, p1[i]), p1[i + 1]); tb = __builtin_fmaxf(__builtin_fmaxf(tb, p1[i + 2]), p1[i + 3]); }
                float tm = __builtin_fmaxf(ta, tb);
                tm = __builtin_fmaxf(tm, __shfl_xor(tm, 32));
                if (MODE == M_SLC) tm = selb ? tm : NEGINF;
                if (__any(tm > a.m + 8.f)) {
                    const float mn = __builtin_fmaxf(a.m, tm); const float alpha = fast_exp2(a.m - mn); a.m = mn; a.l *= alpha;
                    if (MODE != M_CMP1) {
#pragma unroll
                        for (int i = 0; i < 16; ++i) { a.o0[i] *= alpha; a.o1[i] *= alpha; } } }
                const float mref = a.m; float s0 = 0.f, s1 = 0.f;
#pragma unroll
                for (int i = 0; i < 16; ++i) { p0[i] = fast_exp2(p0[i] - mref); p1[i] = fast_exp2(p1[i] - mref); s0 += p0[i]; s1 += p1[i]; }
                const float st = s0 + s1;
                a.l += (MODE == M_SLC) ? (selb ? st : 0.f) : st;
                if (MODE != M_CMP1) ATT_PV(p0, p1, selb);
            } else {
#pragma unroll
                for (int i = 0; i < 16; ++i) { p0[i] = fast_exp2(p0[i] - P.fm) * P.frl; p1[i] = fast_exp2(p1[i] - P.fm) * P.frl; }
                float a8[8], b8[8];
#pragma unroll
                for (int k = 0; k < 4; ++k) { a8[k] = p0[4 * k] + p0[4 * k + 1] + p0[4 * k + 2] + 0.5f * p0[4 * k + 3]; b8[k] = 0.5f * p0[4 * k + 3];
                    a8[4 + k] = p1[4 * k] + p1[4 * k + 1] + p1[4 * k + 2] + 0.5f * p1[4 * k + 3]; b8[4 + k] = 0.5f * p1[4 * k + 3]; }
                float bs[8];
#pragma unroll
                for (int k = 0; k < 8; ++k) bs[k] = __shfl_xor(b8[k], 32);
#pragma unroll
                for (int k = 0; k < 8; ++k) { const float prev = (k == 0) ? carry : bs[k > 0 ? k - 1 : 0]; P.imp[16 * j + 2 * k + h] = a8[k] + (h ? bs[k] : prev); }
                carry = bs[7];
                ATT_PV(p0, p1, true);
            }
        } else if (MODE == M_CMP2) {
            if (h == 0) P.imp[16 * j] = carry;
            carry = 0.f;
        }
        if (MODE == M_FOX) {
            const int slot = it % 3, nslot = (it + 1) % 3;
            if (more) { const int jn = j + P.step;
                if (!wdone) { const float bound = P.qn * *(LAS float*)(lds + A_KM + 4 * jn) * 1.001f + *(LAS float*)(lds + A_KM + 256 + 4 * jn);
                    const bool need = (bound >= a.m - 40.f);
                    if (__any(need)) { if (lane == 0) *(LAS unsigned*)(lds + A_NEED + 4 * slot) = 1u; } else wdone = true; } }
            if (tid == 0) *(LAS unsigned*)(lds + A_NEED + 4 * nslot) = 0u;
            if (more2) asm volatile("s_waitcnt vmcnt(3) lgkmcnt(0)\n\ts_barrier" ::: "memory"); else asm volatile("s_waitcnt vmcnt(0) lgkmcnt(0)\n\ts_barrier" ::: "memory");
            if (more && *(LAS unsigned*)(lds + A_NEED + 4 * slot) == 0u) { asm volatile("s_waitcnt vmcnt(0)" ::: "memory"); break; }
        } else {
            if (more2) asm volatile("s_waitcnt vmcnt(2) lgkmcnt(0)\n\ts_barrier" ::: "memory"); else asm volatile("s_waitcnt vmcnt(0) lgkmcnt(0)\n\ts_barrier" ::: "memory");
        }
        sl = (sl == 2) ? 0 : sl + 1;
    }
#undef ATT_DMA
#undef ATT_PV
}
DI void acc_init(Acc& a, float m0, float l0) {
#pragma unroll
    for (int i = 0; i < 16; ++i) { a.o0[i] = 0.f; a.o1[i] = 0.f; }
    a.m = m0; a.l = l0;
}
DI void load_q(bf16x8 (&qr)[4], const bf16_t* Qrow  , int lane) {
    const bf16_t* p = Qrow + (size_t)(lane & 31) * QKV_N + 8 * (lane >> 5);
#pragma unroll
    for (int s = 0; s < 4; ++s) qr[s] = *(const GAS bf16x8*)(p + 16 * s);
}
DI void store_ot(bf16_t* O, const f32x16& y0, const f32x16& y1, float sc, int lane) {
    bf16_t* rowp = O + (size_t)(lane & 31) * DM + 4 * (lane >> 5);
#pragma unroll
    for (int g = 0; g < 4; ++g) {
        u32x2 a; a.x = cvtpk(y0[4 * g] * sc, y0[4 * g + 1] * sc); a.y = cvtpk(y0[4 * g + 2] * sc, y0[4 * g + 3] * sc); *(u32x2*)(rowp + 8 * g) = a;
        u32x2 b; b.x = cvtpk(y1[4 * g] * sc, y1[4 * g + 1] * sc); b.y = cvtpk(y1[4 * g + 2] * sc, y1[4 * g + 3] * sc); *(u32x2*)(rowp + 32 + 8 * g) = b; }
}
}

#ifndef PH_MASK
#define PH_MASK 0xFFFF
#endif
#define PH(k) ((PH_MASK >> (k)) & 1)
#ifndef REP_PHASE
#define REP_PHASE -1
#endif
#ifndef REP_N
#define REP_N 1
#endif
#define NREP(k) (((k) == REP_PHASE) ? REP_N : 1)
struct Args { const float* in[25]; float* out; unsigned char* ws; };

DI float wave_sum(float v) {
#pragma unroll
    for (int o = 1; o < 64; o <<= 1) v += __shfl_xor(v, o);
    return v;
}
DI unsigned f2bf(float f) { unsigned u = __builtin_bit_cast(unsigned, f); return (u + 0x7fffu + ((u >> 16) & 1u)) >> 16; }
DI unsigned pk2(float lo, float hi) { return f2bf(lo) | (f2bf(hi) << 16); }

enum { MAP_ID = 0, MAP_WIN = 1, MAP_GU_G = 2, MAP_GU_U = 3 };
DI int map_row(int kind, int c) {
    if (kind == MAP_WIN) { if (c < 1280) return c; if (c < 1292) return C_SM + (c - 1280); if (c < 2444) return c - 12; return c; }
    if (kind == MAP_GU_G) return (c >> 7) * 256 + (c & 127);
    if (kind == MAP_GU_U) return (c >> 7) * 256 + 128 + (c & 127);
    return c;
}
DI void cvt_item(const float* W, int K, int N, bf16_t* WT, int kind, int row_off, LAS float* scr, int item, int lane) {
    const int nblk = (N + 31) / 32, kb = item / nblk, nb = item % nblk, k0 = 64 * kb, n0 = 32 * nb;
    const int cn = n0 + (lane & 31); const bool cok = cn < N;
    float vv[32];
#pragma unroll
    for (int i = 0; i < 32; ++i) { const int kk = 2 * i + (lane >> 5); vv[i] = cok ? __builtin_nontemporal_load(W + (size_t)(k0 + kk) * N + cn) : 0.f; }
#pragma unroll
    for (int i = 0; i < 32; ++i) { const int kk = 2 * i + (lane >> 5); scr[kk * 33 + (lane & 31)] = vv[i]; }
    asm volatile("s_waitcnt lgkmcnt(0)" ::: "memory");
    const int c = lane & 7;
#pragma unroll
    for (int j = 0; j < 4; ++j) { const int n = (lane >> 3) + 8 * j; const LAS float* s = scr + (8 * c) * 33 + n;
        u32x4 o; o.x = pk2(s[0 * 33], s[1 * 33]); o.y = pk2(s[2 * 33], s[3 * 33]); o.z = pk2(s[4 * 33], s[5 * 33]); o.w = pk2(s[6 * 33], s[7 * 33]);
        if (n0 + n < N) *(u32x4*)(WT + (size_t)(row_off + map_row(kind, n0 + n)) * K + k0 + 8 * c) = o; }
    asm volatile("s_waitcnt lgkmcnt(0)" ::: "memory");
}

DI unsigned long long ldp(volatile LAS unsigned long long* PT, int k) { int ko = k; asm volatile("" : "+v"(ko)); const unsigned long long v = PT[ko];
    const unsigned lo = __builtin_amdgcn_readfirstlane((unsigned)v), hi = __builtin_amdgcn_readfirstlane((unsigned)(v >> 32)); return ((unsigned long long)hi << 32) | lo; }
#define INP(k) ((const float*)ldp(PT, (k)))
#define WSP(off) ((unsigned char*)ldp(PT, 26) + (off))
#define OUTP ((float*)ldp(PT, 25))

__global__ void __launch_bounds__(512, 2) mega_fwd(Args args) {
    extern __shared__ __attribute__((aligned(16))) unsigned char lds_raw[];
    LAS unsigned char* lds = (LAS unsigned char*)lds_raw;
    volatile LAS unsigned* MISC = (volatile LAS unsigned*)(lds + L_MISC);
    LAS float* LUT = (LAS float*)(lds + L_LUT);
    LAS int* TP = (LAS int*)(lds + L_TP);
    LAS int* CNTL = (LAS int*)(lds + L_CNT);
    LAS int* TPX = (LAS int*)(lds + L_TPX);
    const int wid0 = __builtin_amdgcn_readfirstlane((int)threadIdx.x >> 6);
#define LAUNDER_TID int lane; asm volatile("v_mbcnt_lo_u32_b32 %0, -1, 0\n\tv_mbcnt_hi_u32_b32 %0, -1, %0" : "=v"(lane)); int wid = wid0; asm volatile("" : "+s"(wid)); const int tid = wid * 64 + lane; (void)tid;
    const int G = gridDim.x, bx = blockIdx.x;
    volatile LAS unsigned long long* PT = (volatile LAS unsigned long long*)(lds + L_PT);
    { LAUNDER_TID
    if (tid == 0) {
        PT[0] = (unsigned long long)args.in[0]; PT[1] = (unsigned long long)args.in[1]; PT[2] = (unsigned long long)args.in[2]; PT[3] = (unsigned long long)args.in[3];
        PT[4] = (unsigned long long)args.in[4]; PT[5] = (unsigned long long)args.in[5]; PT[6] = (unsigned long long)args.in[6]; PT[7] = (unsigned long long)args.in[7];
        PT[8] = (unsigned long long)args.in[8]; PT[9] = (unsigned long long)args.in[9]; PT[10] = (unsigned long long)args.in[10]; PT[11] = (unsigned long long)args.in[11];
        PT[12] = (unsigned long long)args.in[12]; PT[13] = (unsigned long long)args.in[13]; PT[14] = (unsigned long long)args.in[14]; PT[15] = (unsigned long long)args.in[15];
        PT[16] = (unsigned long long)args.in[16]; PT[17] = (unsigned long long)args.in[17]; PT[18] = (unsigned long long)args.in[18]; PT[19] = (unsigned long long)args.in[19];
        PT[20] = (unsigned long long)args.in[20]; PT[21] = (unsigned long long)args.in[21]; PT[22] = (unsigned long long)args.in[22]; PT[23] = (unsigned long long)args.in[23];
        PT[24] = (unsigned long long)args.in[24]; PT[25] = (unsigned long long)args.out; PT[26] = (unsigned long long)args.ws;
    }
    for (int u = tid; u < 64; u += 512) MISC[u] = 0u;
    for (int u = tid; u < 1280; u += 512) { const int hh = u >> 7, rel = u & 127; int bk = rel;
        if (rel >= 16) { bk = 16; const int th[15] = {19, 21, 24, 27, 31, 35, 40, 46, 52, 59, 67, 77, 87, 99, 113};
#pragma unroll
            for (int q = 0; q < 15; ++q) bk += (rel >= th[q]) ? 1 : 0; }
        LUT[u] = (args.in[10][bk * 10 + hh] - args.in[10][31 * 10 + hh]) * LOG2E; }
    }
    __syncthreads();
    XcdBarrier bar = xcd_barrier_post((unsigned*)WSP(WS_CTL) + CW_BAR, MISC);
#define GRID_BAR() do { XcdBarrier b2_ = bar; b2_.bar = (unsigned*)WSP(WS_CTL) + CW_BAR; asm volatile("" : "+s"(b2_.x)); int ln_; asm volatile("v_mbcnt_lo_u32_b32 %0, -1, 0\n\tv_mbcnt_hi_u32_b32 %0, -1, %0" : "=v"(ln_)); xcd_barrier(b2_, (wid0 == 0) && (ln_ == 0)); } while (0)
#define QNEXT(ctr, dstvar) do { if (tid == 0) MISC[8] = atomicAdd((ctr), 1u); __syncthreads(); dstvar = (int)__builtin_amdgcn_readfirstlane(MISC[8]); __syncthreads(); } while (0)

    for (int rep = 0; rep < NREP(0); ++rep) if (PH(0)) { LAUNDER_TID
            float* ADA = (float*)WSP(WS_ADA); float* CPOS = (float*)WSP(WS_CPOS); bf16_t* WIN = (bf16_t*)WSP(WS_WIN); bf16_t* WO = (bf16_t*)WSP(WS_WO); bf16_t* WSH = (bf16_t*)WSP(WS_WSH); bf16_t* WSD = (bf16_t*)WSP(WS_WSD); bf16_t* WCT = (bf16_t*)WSP(WS_WCT); bf16_t* WGU = (bf16_t*)WSP(WS_WGU); bf16_t* WD = (bf16_t*)WSP(WS_WD);
        if (bx < 192) {
            LAS float* cond = (LAS float*)lds;
            LAS float* red = (LAS float*)(lds + 32768);
            for (int u = tid; u < 8192; u += 512) cond[u] = siluf_(INP(1)[u]);
            __syncthreads();
            const int l = bx / 96, j0 = (bx % 96) * 64;
            const float* wa = INP(11) + (size_t)l * DM * 6144 + j0 + lane;
            float accb[8];
#pragma unroll
            for (int b = 0; b < 8; ++b) accb[b] = 0.f;
#pragma unroll 8
            for (int kk = 0; kk < 128; ++kk) { const int k = wid * 128 + kk; const float w = wa[(size_t)k * 6144];
#pragma unroll
                for (int b = 0; b < 8; ++b) accb[b] += cond[b * 1024 + k] * w; }
#pragma unroll
            for (int b = 0; b < 8; ++b) red[(wid * 8 + b) * 64 + lane] = accb[b];
            __syncthreads();
            { const int b = tid >> 6; float s = INP(12)[l * 6144 + j0 + lane];
#pragma unroll
                for (int w = 0; w < 8; ++w) s += red[(w * 8 + b) * 64 + lane];
                ADA[((size_t)l * 8 + b) * 6144 + j0 + lane] = s; }
            __syncthreads();
        } else if (bx < 196) {
            const int l = (bx - 192) >> 1, which = (bx - 192) & 1;
            const float* pos = INP(which ? 7 : 5) + (size_t)l * 2048 + wid * 256; const float* w = INP(which ? 8 : 6) + (size_t)l * 2048 * 64 + (size_t)wid * 256 * 64;
            LAS float* red = (LAS float*)lds;
            float s = 0.f;
#pragma unroll 16
            for (int k = 0; k < 256; ++k) s += pos[k] * w[(size_t)k * 64 + lane];
            red[wid * 64 + lane] = s;
            __syncthreads();
            if (wid == 0) { float t = 0.f;
#pragma unroll
                for (int w8 = 0; w8 < 8; ++w8) t += red[w8 * 64 + lane];
                CPOS[(l * 2 + which) * 64 + lane] = t; }
            __syncthreads();
        }
        { const int gt = bx * 512 + tid; const int per = (QKV_N - D_IN) * DM / 8;
            for (int u = gt; u < 2 * per; u += G * 512) { const int l = u / per, r = u % per; *(u32x4*)(WIN + ((size_t)l * QKV_N + D_IN) * DM + (size_t)r * 8) = (u32x4){0u, 0u, 0u, 0u}; } }
        LAS float* scr = (LAS float*)(lds + wid * 16384);
        const int gw = bx * 8 + wid, NGW = G * 8;
        constexpr int I_SMALL = 2384, I_EXP = 384;
        const int NITEMS = DEPTH * I_SMALL + DEPTH * NEXP * I_EXP;
        for (int it = gw; it < NITEMS; it += NGW) {
            if (it < DEPTH * I_SMALL) { const int l = it / I_SMALL; int r = it % I_SMALL;
                if (r < 1232) { cvt_item(INP(2) + (size_t)l * DM * D_IN, DM, D_IN, WIN + (size_t)l * QKV_N * DM, MAP_WIN, 0, scr, r, lane); continue; } r -= 1232;
                if (r < 512) { cvt_item(INP(3) + (size_t)l * DM * DM, DM, DM, WO + (size_t)l * DM * DM, MAP_ID, 0, scr, r, lane); continue; } r -= 512;
                if (r < 128) { cvt_item(INP(17) + (size_t)l * DM * 256, DM, 256, WSH + (size_t)l * 768 * DM, MAP_ID, 0, scr, r, lane); continue; } r -= 128;
                if (r < 128) { cvt_item(INP(22) + (size_t)l * DM * 256, DM, 256, WSH + (size_t)l * 768 * DM, MAP_GU_G, 256, scr, r, lane); continue; } r -= 128;
                if (r < 128) { cvt_item(INP(23) + (size_t)l * DM * 256, DM, 256, WSH + (size_t)l * 768 * DM, MAP_GU_U, 256, scr, r, lane); continue; } r -= 128;
                if (r < 128) { cvt_item(INP(24) + (size_t)l * 256 * DM, 256, DM, WSD + (size_t)l * DM * 256, MAP_ID, 0, scr, r, lane); continue; } r -= 128;
                if (r < 64) { cvt_item(INP(6) + (size_t)l * 2048 * 64, 2048, 64, WCT + (size_t)(l * 2 + 0) * 64 * 2048, MAP_ID, 0, scr, r, lane); continue; } r -= 64;
                cvt_item(INP(8) + (size_t)l * 2048 * 64, 2048, 64, WCT + (size_t)(l * 2 + 1) * 64 * 2048, MAP_ID, 0, scr, r, lane);
            } else { const int r0 = it - DEPTH * I_SMALL; const int le = r0 / I_EXP, r = r0 % I_EXP;
                if (r < 128) cvt_item(INP(19) + (size_t)le * DM * EDIM, DM, EDIM, WGU + (size_t)le * 512 * DM, MAP_GU_G, 0, scr, r, lane);
                else if (r < 256) cvt_item(INP(20) + (size_t)le * DM * EDIM, DM, EDIM, WGU + (size_t)le * 512 * DM, MAP_GU_U, 0, scr, r - 128, lane);
                else cvt_item(INP(21) + (size_t)le * EDIM * DM, EDIM, DM, WD + (size_t)le * DM * EDIM, MAP_ID, 0, scr, r - 256, lane);
            }
        }
    }
    GRID_BAR();
    if (PH(1)) { LAUNDER_TID
            float* ADA = (float*)WSP(WS_ADA); bf16_t* H = (bf16_t*)WSP(WS_H);
        const int gw = bx * 8 + wid, NGW = G * 8;
        for (int m = gw; m < NTOK; m += NGW) { const int b = m >> 12; const float* ad = ADA + (size_t)b * 6144;
            const f32x4* xr = (const f32x4*)(INP(0) + (size_t)m * DM) + lane; unsigned long long* o8 = (unsigned long long*)(H + (size_t)m * DM) + lane;
#pragma unroll
            for (int j = 0; j < 4; ++j) { const f32x4 v = xr[64 * j]; const f32x4 sh = *((const f32x4*)(ad) + 64 * j + lane), sc = *((const f32x4*)(ad + 1024) + 64 * j + lane);
                const f32x4 hv = v * (sc + 1.f) + sh; o8[64 * j] = (unsigned long long)cvtpk(hv[0], hv[1]) | ((unsigned long long)cvtpk(hv[2], hv[3]) << 32); } }
    }
    GRID_BAR();

    for (int l = 0; l < DEPTH; ++l) {
        for (int rep = 0; rep < NREP(2); ++rep) if (PH(2)) { LAUNDER_TID
            bf16_t* H = (bf16_t*)WSP(WS_H); bf16_t* WIN = (bf16_t*)WSP(WS_WIN); bf16_t* QKV = (bf16_t*)WSP(WS_QKV); float* SMALL = (float*)WSP(WS_SMALL);
            pg8::Gemm g{H, WIN + (size_t)l * QKV_N * DM, DM}; pg8::StaticOrder S; S.init(NTOK, QKV_N, G, bx);
            pg8::EpiQKV E{QKV, SMALL};
            pg8::gemm_phase<pg8::EpiQKV, pg8::StaticOrder>(lds, g, S, E, wid);
        }
        GRID_BAR();
        for (int rep = 0; rep < NREP(3); ++rep) if (PH(3)) { LAUNDER_TID
            unsigned* ctl = (unsigned*)WSP(WS_CTL); bf16_t* QKV = (bf16_t*)WSP(WS_QKV); bf16_t* WCT = (bf16_t*)WSP(WS_WCT); float* CPOS = (float*)WSP(WS_CPOS); bf16_t* KCMP = (bf16_t*)WSP(WS_KCMP); bf16_t* VCMP = (bf16_t*)WSP(WS_VCMP); float* SMALL = (float*)WSP(WS_SMALL); float* DC = (float*)WSP(WS_DC); bf16_t* OB = (bf16_t*)WSP(WS_O); float* KMW = (float*)WSP(WS_KM);
            unsigned* qctr = ctl + CW_Q + 64 * (l * 4 + 0 + 8 * rep);
            for (;;) {
                int u; QNEXT(qctr, u);
                if (u >= 128 + 48 + 768) break;
                if (u < 128) {
                    const int b = u >> 4, which = (u >> 3) & 1, cblk = (u >> 2) & 1, nblk = 2 * (u & 3) + (wid >> 2), kc = wid & 3, r = lane & 31, h = lane >> 5;
                    int n = 32 * nblk + r; n = n < 254 ? n : 254;
                    const bf16_t* arow = QKV + ((size_t)b * SEQ + 16 * n + 8 * kc) * QKV_N + (which ? C_BVC : C_BKC) + 8 * h;
                    const bf16_t* brow = WCT + ((size_t)(l * 2 + which) * 64 + 32 * cblk + r) * 2048 + 512 * kc + 8 * h;
                    f32x16 acc;
#pragma unroll
                    for (int i = 0; i < 16; ++i) acc[i] = 0.f;
#pragma unroll 8
                    for (int s = 0; s < 32; ++s) { const int k = 16 * s; const bf16x8 af = *(const GAS bf16x8*)(arow + (size_t)(k >> 6) * QKV_N + (k & 63)); const bf16x8 bf = *(const GAS bf16x8*)(brow + k);
                        acc = MFMA32(af, bf, acc); }
                    LAS float* red = (LAS float*)lds;
                    if (kc) {
#pragma unroll
                        for (int i = 0; i < 16; ++i) red[(wid * 16 + i) * 64 + lane] = acc[i]; }
                    __syncthreads();
                    if (kc == 0) {
                        const float cp = CPOS[(l * 2 + which) * 64 + 32 * cblk + r]; bf16_t* dst = (which ? VCMP : KCMP) + (size_t)b * 256 * 64 + 32 * cblk + r;
#pragma unroll
                        for (int i = 0; i < 16; ++i) { const float t = acc[i] + red[((wid + 1) * 16 + i) * 64 + lane] + red[((wid + 2) * 16 + i) * 64 + lane] + red[((wid + 3) * 16 + i) * 64 + lane];
                            const int nn = 32 * nblk + (i & 3) + 8 * (i >> 2) + 4 * h; dst[(size_t)nn * 64] = (bf16_t)(nn < 255 ? f2bf(t + cp) : 0u); } }
                    __syncthreads();
                } else if (u < 176) {
                    const int b = (u - 128) / 6, hh = (u - 128) % 6; const float fb = INP(9)[l * 6 + hh];
                    LAS float* wsum = (LAS float*)lds;
                    float v[8]; float run = 0.f;
#pragma unroll
                    for (int i = 0; i < 8; ++i) { const float x = SMALL[((size_t)b * SEQ + 8 * tid + i) * 32 + 12 + hh] + fb; const float lf = fminf(x, 0.f) - log1pf(__expf(-fabsf(x))); run += lf; v[i] = run; }
                    float incl = run;
#pragma unroll
                    for (int o = 1; o < 64; o <<= 1) { const float t = __shfl_up(incl, o); if (lane >= o) incl += t; }
                    if (lane == 63) wsum[wid] = incl;
                    __syncthreads();
                    float base = incl - run;
                    for (int w = 0; w < wid; ++w) base += wsum[w];
                    float* dst = DC + ((size_t)b * 6 + hh) * SEQ + 8 * tid;
#pragma unroll
                    for (int i = 0; i < 8; ++i) dst[i] = -(base + v[i]) * LOG2E;
                    LAS float* tmx = (LAS float*)(lds + 1024);
                    { const bf16_t* kp = QKV + ((size_t)b * SEQ + (tid >> 3)) * QKV_N + C_CK + 64 * hh + 8 * (tid & 7);
#pragma unroll 8
                        for (int T = 0; T < 64; ++T) { const bf16x8 kv = *(const GAS bf16x8*)(kp + (size_t)T * 64 * QKV_N); float ss = 0.f;
#pragma unroll
                            for (int e = 0; e < 8; ++e) { const float x = __uint_as_float(((unsigned)(unsigned short)kv[e]) << 16); ss += x * x; }
                            ss += __shfl_xor(ss, 1); ss += __shfl_xor(ss, 2); ss += __shfl_xor(ss, 4);
                            ss = fmaxf(ss, __shfl_xor(ss, 8)); ss = fmaxf(ss, __shfl_xor(ss, 16)); ss = fmaxf(ss, __shfl_xor(ss, 32));
                            if (lane == 0) tmx[wid * 64 + T] = ss; } }
                    __syncthreads();
                    if (tid < 64) { float mx = tmx[tid];
#pragma unroll
                        for (int w = 1; w < 8; ++w) mx = fmaxf(mx, tmx[w * 64 + tid]);
#pragma unroll
                        for (int o = 1; o < 64; o <<= 1) { const float t = __shfl_up(mx, o); if (lane >= o) mx = fmaxf(mx, t); }
                        KMW[((size_t)b * 6 + hh) * 64 + tid] = sqrtf(mx); }
                    __syncthreads();
                } else {
                    const int ua = u - 176, qt = ua & 15, hq = (ua >> 4) % 6, b = ua / 96, kvh = hq / 3;
                    const size_t tok0 = (size_t)b * SEQ + 256 * qt + 32 * wid;
                    bf16x8 qr[4]; att::load_q(qr, QKV + tok0 * QKV_N + C_AQ + 64 * hq, lane);
                    att::Acc a; att::acc_init(a, (INP(4)[l * 6 + hq] - INP(10)[31 * 10 + hq]) * LOG2E, (lane < 32) ? 1.f : 0.f);
                    att::PassArgs P; P.Kg = QKV + (size_t)b * SEQ * QKV_N + C_AK + 64 * kvh; P.Vg = QKV + (size_t)b * SEQ * QKV_N + C_AV + 64 * kvh; P.pitch = QKV_N;
                    P.jfirst = (4 * qt - 2) > 0 ? (4 * qt - 2) : 0; P.ntiles = 4 * qt + 3 - P.jfirst + 1; P.step = 1; P.tq0 = 256 * qt + 32 * wid;
                    P.lut = LUT + 128 * hq; P.sel = 0ull; P.dq = 0.f; P.dkg = nullptr; P.fm = 0.f; P.frl = 0.f; P.imp = nullptr; P.qn = 0.f; P.km = nullptr;
                    att::attn_pass<att::M_BAND, 128>((LAS char*)lds, P, qr, a, tid, lane);
                    const float lt = a.l + __shfl_xor(a.l, 32);
                    att::store_ot(OB + tok0 * DM + O_A + 64 * hq, a.o0, a.o1, 1.f / lt, lane);
                }
            }
        }
        GRID_BAR();
        for (int rep = 0; rep < NREP(4); ++rep) if (PH(4)) { LAUNDER_TID
            unsigned* ctl = (unsigned*)WSP(WS_CTL); bf16_t* QKV = (bf16_t*)WSP(WS_QKV); float* DC = (float*)WSP(WS_DC); bf16_t* KCMP = (bf16_t*)WSP(WS_KCMP); bf16_t* VCMP = (bf16_t*)WSP(WS_VCMP); float* SMALL = (float*)WSP(WS_SMALL); bf16_t* OB = (bf16_t*)WSP(WS_O); const float* KM = (const float*)WSP(WS_KM);
            unsigned* qctr = ctl + CW_Q + 64 * (l * 4 + 1 + 8 * rep);
            for (;;) {
                int u; QNEXT(qctr, u);
                if (u >= 1280) break;
                const int grp = u / 80, rr = u % 80, L = 15 - grp;
                if (rr < 48) { if (PH(14)) {
                    const int b = rr / 6, hh = rr % 6, qt = L;
                    const size_t tok0 = (size_t)b * SEQ + 256 * qt + 32 * wid;
                    bf16x8 qr[4]; att::load_q(qr, QKV + tok0 * QKV_N + C_CQ + 64 * hh, lane);
                    att::Acc a; att::acc_init(a, -1e30f, 0.f);
                    att::PassArgs P; P.Kg = QKV + (size_t)b * SEQ * QKV_N + C_CK + 64 * hh; P.Vg = QKV + (size_t)b * SEQ * QKV_N + C_CV + 64 * hh; P.pitch = QKV_N;
                    P.jfirst = 4 * qt + 3; P.ntiles = 4 * qt + 4; P.step = -1; P.tq0 = 256 * qt + 32 * wid;
                    P.lut = LUT; P.sel = 0ull; P.dkg = DC + ((size_t)b * 6 + hh) * SEQ; P.dq = 0.f; P.fm = 0.f; P.frl = 0.f; P.imp = nullptr;
                    { float qs = 0.f;
#pragma unroll
                        for (int s4 = 0; s4 < 4; ++s4)
#pragma unroll
                            for (int e = 0; e < 8; ++e) { const float qv = __uint_as_float(((unsigned)(unsigned short)qr[s4][e]) << 16); qs += qv * qv; }
                        qs += __shfl_xor(qs, 32); P.qn = sqrtf(qs); P.km = KM + ((size_t)b * 6 + hh) * 64; }
                    att::attn_pass<att::M_FOX, 0>((LAS char*)lds, P, qr, a, tid, lane);
                    const float lt = a.l + __shfl_xor(a.l, 32);
                    att::store_ot(OB + tok0 * DM + O_C + 64 * hh, a.o0, a.o1, 1.f / lt, lane);
                } } else if (PH(15)) {
                    const int r2 = rr - 48, qt = 4 * L + 3 - (r2 >> 3), b = r2 & 7, head = wid >> 1, qh = wid & 1;
                    const size_t tok0 = (size_t)b * SEQ + 64 * qt + 32 * qh; const int tq0 = 64 * qt + 32 * qh;
                    const int r = lane & 31, h = lane >> 5;
                    LAS float* IMP = (LAS float*)(lds + att::A_IMP);
                    LAS unsigned long long* SELM = (LAS unsigned long long*)(lds + att::A_SEL);
                    for (int q = tid; q < 4 * 64 * 65; q += 512) IMP[q] = 0.f;
                    bf16x8 qr[4]; att::load_q(qr, QKV + tok0 * QKV_N + C_BQ + 64 * head, lane);
                    const float* gl = SMALL + (tok0 + r) * 32 + head;
                    const float g0 = sigmoidf_(gl[0]), g1 = sigmoidf_(gl[4]), g2 = sigmoidf_(gl[8]);
                    att::PassArgs P; P.pitch = 64; P.Kg = KCMP + (size_t)b * 256 * 64; P.Vg = VCMP + (size_t)b * 256 * 64;
                    P.jfirst = 0; P.ntiles = (qt >> 4) + 1; P.step = 1; P.tq0 = tq0; P.lut = LUT + 128 * (6 + head); P.sel = 0ull; P.dq = 0.f; P.dkg = nullptr; P.qn = 0.f; P.km = nullptr;
                    P.fm = 0.f; P.frl = 0.f; P.imp = IMP + (head * 64 + 32 * qh + r) * 65;
                    att::Acc a; att::acc_init(a, -1e30f, 0.f);
                    att::attn_pass<att::M_CMP1, 0>((LAS char*)lds, P, qr, a, tid, lane);
                    { const float lt = a.l + __shfl_xor(a.l, 32); P.fm = a.m; P.frl = lt > 0.f ? 1.f / lt : 0.f; }
                    att::acc_init(a, 0.f, 0.f);
                    att::attn_pass<att::M_CMP2, 0>((LAS char*)lds, P, qr, a, tid, lane);
#pragma unroll
                    for (int i = 0; i < 16; ++i) { a.o0[i] *= g0; a.o1[i] *= g0; }
                    for (int qi = 0; qi < 8; ++qi) { const int q = 8 * wid + qi;
                        float v = IMP[(0 * 64 + q) * 65 + lane] + IMP[(1 * 64 + q) * 65 + lane] + IMP[(2 * 64 + q) * 65 + lane] + IMP[(3 * 64 + q) * 65 + lane];
                        if (lane == 0 || lane == qt || lane == qt - 1) v = 1e4f; else if (lane > qt) v = -1.f;
                        int rank = 0;
#pragma unroll
                        for (int jj = 0; jj < 64; ++jj) { const float vj = __uint_as_float(__builtin_amdgcn_readlane(__float_as_uint(v), jj)); rank += ((vj > v) || (vj == v && jj < lane)) ? 1 : 0; }
                        const unsigned long long mk = __ballot(rank < 16);
                        if (lane == 0) SELM[q] = mk; }
                    __syncthreads();
                    P.sel = SELM[32 * qh + r];
                    LAS float* FR = IMP + tid;
#pragma unroll
                    for (int i = 0; i < 16; ++i) { FR[512 * i] = a.o0[i]; FR[512 * (16 + i)] = a.o1[i]; }
                    P.pitch = QKV_N; P.Kg = QKV + (size_t)b * SEQ * QKV_N + C_BKS; P.Vg = QKV + (size_t)b * SEQ * QKV_N + C_BVS; P.jfirst = 0; P.ntiles = qt + 1; P.step = 1;
                    att::acc_init(a, -1e30f, 0.f);
                    att::attn_pass<att::M_SLC, 0>((LAS char*)lds, P, qr, a, tid, lane);
                    { const float lt = a.l + __shfl_xor(a.l, 32); const float sc = g1 / lt;
#pragma unroll
                        for (int i = 0; i < 16; ++i) { FR[512 * i] += sc * a.o0[i]; FR[512 * (16 + i)] += sc * a.o1[i]; } }
                    P.Kg = QKV + (size_t)b * SEQ * QKV_N + C_BKW; P.Vg = QKV + (size_t)b * SEQ * QKV_N + C_BVW; P.jfirst = (qt - 8) > 0 ? (qt - 8) : 0; P.ntiles = qt - P.jfirst + 1;
                    att::acc_init(a, -1e30f, 0.f);
                    att::attn_pass<att::M_BAND, 512>((LAS char*)lds, P, qr, a, tid, lane);
                    { const float lt = a.l + __shfl_xor(a.l, 32); const float sc = g2 / lt;
#pragma unroll
                        for (int i = 0; i < 16; ++i) { a.o0[i] = FR[512 * i] + sc * a.o0[i]; a.o1[i] = FR[512 * (16 + i)] + sc * a.o1[i]; } }
                    att::store_ot(OB + tok0 * DM + O_B + 64 * head, a.o0, a.o1, 1.f, lane);
                }
            }
        }
        GRID_BAR();
        for (int rep = 0; rep < NREP(5); ++rep) if (PH(5)) { LAUNDER_TID
            bf16_t* OB = (bf16_t*)WSP(WS_O); bf16_t* WO = (bf16_t*)WSP(WS_WO); const float* xin = (l == 0) ? INP(0) : (const float*)OUTP; float* VB = (float*)WSP(WS_V); const float* ada_l = (const float*)WSP(WS_ADA) + (size_t)l * 8 * 6144;
            pg8::Gemm g{OB, WO + (size_t)l * DM * DM, DM}; pg8::StaticOrder S; S.init(NTOK, DM, G, bx);
            pg8::EpiWO E{xin, VB, ada_l + 2 * 1024};
            pg8::gemm_phase<pg8::EpiWO, pg8::StaticOrder>(lds, g, S, E, wid);
        }
        GRID_BAR();
        for (int rep = 0; rep < NREP(6); ++rep) if (PH(6)) { LAUNDER_TID
            float* VB = (float*)WSP(WS_V); float* X1 = (float*)WSP(WS_X1); bf16_t* H = (bf16_t*)WSP(WS_H); const float* ada_l = (const float*)WSP(WS_ADA) + (size_t)l * 8 * 6144;
            const int gw = bx * 8 + wid, NGW = G * 8; const float* lg = INP(13) + l * DM; const float* lb = INP(14) + l * DM;
            for (int m = 2 * gw; m < NTOK; m += 2 * NGW) { const int b = m >> 12; const float* ad = ada_l + (size_t)b * 6144;
                f32x4 v[2][4]; float s[2] = {0.f, 0.f};
#pragma unroll
                for (int rr = 0; rr < 2; ++rr)
#pragma unroll
                    for (int j = 0; j < 4; ++j) v[rr][j] = *((const GAS f32x4*)(VB + (size_t)(m + rr) * DM) + 64 * j + lane);
#pragma unroll
                for (int rr = 0; rr < 2; ++rr)
#pragma unroll
                    for (int j = 0; j < 4; ++j) s[rr] += (v[rr][j][0] + v[rr][j][1]) + (v[rr][j][2] + v[rr][j][3]);
                const float mean0 = wave_sum(s[0]) * (1.f / DM), mean1 = wave_sum(s[1]) * (1.f / DM); float q[2] = {0.f, 0.f};
#pragma unroll
                for (int rr = 0; rr < 2; ++rr)
#pragma unroll
                    for (int j = 0; j < 4; ++j) { v[rr][j] = v[rr][j] - (rr ? mean1 : mean0); q[rr] += (v[rr][j][0] * v[rr][j][0] + v[rr][j][1] * v[rr][j][1]) + (v[rr][j][2] * v[rr][j][2] + v[rr][j][3] * v[rr][j][3]); }
                const float rstd0 = 1.f / sqrtf(wave_sum(q[0]) * (1.f / DM) + LN_EPS), rstd1 = 1.f / sqrtf(wave_sum(q[1]) * (1.f / DM) + LN_EPS);
#pragma unroll
                for (int j = 0; j < 4; ++j) { const f32x4 gg = *((const f32x4*)lg + 64 * j + lane), bb = *((const f32x4*)lb + 64 * j + lane);
                    const f32x4 sh = *((const f32x4*)(ad + 3 * 1024) + 64 * j + lane), sc = *((const f32x4*)(ad + 4 * 1024) + 64 * j + lane) + 1.f;
#pragma unroll
                    for (int rr = 0; rr < 2; ++rr) { const f32x4 x1 = v[rr][j] * (rr ? rstd1 : rstd0) * gg + bb; *((f32x4*)(X1 + (size_t)(m + rr) * DM) + 64 * j + lane) = x1;
                        const f32x4 hv = x1 * sc + sh; *((unsigned long long*)(H + (size_t)(m + rr) * DM) + 64 * j + lane) = (unsigned long long)cvtpk(hv[0], hv[1]) | ((unsigned long long)cvtpk(hv[2], hv[3]) << 32); } } }
        }
        GRID_BAR();
        for (int rep = 0; rep < NREP(7); ++rep) if (PH(7)) { LAUNDER_TID
            bf16_t* H = (bf16_t*)WSP(WS_H); bf16_t* WSH = (bf16_t*)WSP(WS_WSH); float* LOG = (float*)WSP(WS_LOG); bf16_t* ACTSH = (bf16_t*)WSP(WS_ACTSH);
            pg8::Gemm g{H, WSH + (size_t)l * 768 * DM, DM}; pg8::StaticOrder S; S.init(NTOK, 768, G, bx);
            pg8::EpiSH E{LOG, ACTSH};
            pg8::gemm_phase<pg8::EpiSH, pg8::StaticOrder>(lds, g, S, E, wid);
        }
        GRID_BAR();
        if (PH(8)) { LAUNDER_TID
            unsigned* ctl = (unsigned*)WSP(WS_CTL); float* LOG = (float*)WSP(WS_LOG); int* DST = (int*)WSP(WS_DST); float* WL = (float*)WSP(WS_WL);
            unsigned* CNT = ctl + CW_CNT + l * 256;
            LAS int* hist = (LAS int*)lds;
            LAS int* basel = (LAS int*)(lds + 1024);
            LAS int* asg_e = (LAS int*)(lds + 2048);
            LAS int* asg_r = (LAS int*)(lds + 2048 + 4096);
            LAS float* asg_w = (LAS float*)(lds + 2048 + 8192);
            const float* rb = INP(18) + l * 256;
            for (int chunk = bx; chunk < NTOK / 128; chunk += G) {
                for (int u = tid; u < 256; u += 512) hist[u] = 0;
                __syncthreads();
                for (int ti = 0; ti < 16; ++ti) { const int tl = wid * 16 + ti, n = chunk * 128 + tl;
                    const f32x4 lg = *((const f32x4*)(LOG + (size_t)n * 256) + lane); const f32x4 rbv = *((const f32x4*)rb + lane);
                    float sc[4], ch[4];
#pragma unroll
                    for (int i = 0; i < 4; ++i) { sc[i] = sigmoidf_(lg[i]); ch[i] = sc[i] + rbv[i]; }
                    float m1 = fmaxf(ch[0], ch[1]), m2 = fminf(ch[0], ch[1]);
                    { const float a1 = fmaxf(ch[2], ch[3]), a2 = fminf(ch[2], ch[3]); const float n1 = fmaxf(m1, a1), n2 = fmaxf(fminf(m1, a1), fmaxf(m2, a2)); m1 = n1; m2 = n2; }
#pragma unroll
                    for (int o = 1; o < 8; o <<= 1) { const float b1 = __shfl_xor(m1, o), b2 = __shfl_xor(m2, o); const float n1 = fmaxf(m1, b1), n2 = fmaxf(fminf(m1, b1), fmaxf(m2, b2)); m1 = n1; m2 = n2; }
                    const float gs = m1 + m2; const int grp = lane >> 3; int grank = 0;
#pragma unroll
                    for (int jg = 0; jg < 8; ++jg) { const float o = __shfl(gs, 8 * jg); grank += ((o > gs) || (o == gs && jg < grp)) ? 1 : 0; }
                    const bool gsel = grank < 4;
                    float val[4];
#pragma unroll
                    for (int i = 0; i < 4; ++i) val[i] = gsel ? ch[i] : -1e30f;
                    float wsum_ = 0.f; int my_e = 0; float my_s = 0.f;
#pragma unroll
                    for (int k = 0; k < 8; ++k) {
                        float bv = val[0]; int bi = 4 * lane; float bsc = sc[0];
#pragma unroll
                        for (int i = 1; i < 4; ++i) if (val[i] > bv) { bv = val[i]; bi = 4 * lane + i; bsc = sc[i]; }
#pragma unroll
                        for (int o = 1; o < 64; o <<= 1) { const float ov = __shfl_xor(bv, o); const int oi = __shfl_xor(bi, o); const float os = __shfl_xor(bsc, o);
                            if (ov > bv || (ov == bv && oi < bi)) { bv = ov; bi = oi; bsc = os; } }
                        if ((bi >> 2) == lane) {
#pragma unroll
                            for (int i = 0; i < 4; ++i) if ((bi & 3) == i) val[i] = -3e38f; }
                        wsum_ += bsc; if (lane == k) { my_e = bi; my_s = bsc; }
                    }
                    if (lane < 8) { const int rk = __hip_atomic_fetch_add(&hist[my_e], 1, __ATOMIC_RELAXED, __HIP_MEMORY_SCOPE_WORKGROUP); asg_e[tl * 8 + lane] = my_e; asg_r[tl * 8 + lane] = rk; asg_w[tl * 8 + lane] = my_s / wsum_ * 2.5f; }
                }
                __syncthreads();
                if (tid < 256) { const int c = hist[tid]; basel[tid] = c ? (int)atomicAdd(&CNT[tid], (unsigned)c) : 0; }
                __syncthreads();
                for (int u = tid; u < 1024; u += 512) { const int e = asg_e[u]; const int pos = basel[e] + asg_r[u]; DST[(size_t)e * NTOK + pos] = (chunk * 128) * 8 + u; WL[(size_t)e * NTOK + pos] = asg_w[u]; }
                __syncthreads();
            }
        }
        GRID_BAR();
        for (int rep = 0; rep < NREP(9); ++rep) if (PH(9)) { LAUNDER_TID
            unsigned* ctl = (unsigned*)WSP(WS_CTL); bf16_t* H = (bf16_t*)WSP(WS_H); bf16_t* WGU = (bf16_t*)WSP(WS_WGU); int* DST = (int*)WSP(WS_DST); bf16_t* ACT = (bf16_t*)WSP(WS_ACT);
            const unsigned* CNT = ctl + CW_CNT + l * 256;
            if (tid < 256) CNTL[tid] = (int)__hip_atomic_load(CNT + tid, __ATOMIC_RELAXED, __HIP_MEMORY_SCOPE_AGENT);
            __syncthreads();
            if (tid == 0) { int s = 0; for (int e = 0; e < 256; ++e) { TP[e] = s; s += (CNTL[e] + 255) >> 8; } TP[256] = s; }
            if (tid == 64) { int s = 0; const int x = bx & 7; for (int i = 0; i < 32; ++i) { TPX[i] = s; s += (CNTL[8 * i + x] + 255) >> 8; } TPX[32] = s; }
            __syncthreads();
            pg8::Gemm g{H, WGU + (size_t)l * NEXP * 512 * DM, DM};
            pg8::GroupedOrder<true> S{TP, TPX, CNTL, 2, (G - (bx & 7) + 7) >> 3, bx >> 3, bx & 7, DST};
            pg8::EpiGU E{ACT};
            pg8::gemm_phase<pg8::EpiGU, pg8::GroupedOrder<true>>(lds, g, S, E, wid);
        }
        GRID_BAR();
        for (int rep = 0; rep < NREP(10); ++rep) if (PH(10)) { LAUNDER_TID
            bf16_t* ACTSH = (bf16_t*)WSP(WS_ACTSH); bf16_t* WSD = (bf16_t*)WSP(WS_WSD); bf16_t* YSH = (bf16_t*)WSP(WS_YSH); bf16_t* ACT = (bf16_t*)WSP(WS_ACT); bf16_t* WD = (bf16_t*)WSP(WS_WD); bf16_t* YB = (bf16_t*)WSP(WS_YB); int* DST = (int*)WSP(WS_DST); float* WL = (float*)WSP(WS_WL);
            if (PH(12)) { pg8::Gemm g{ACTSH, WSD + (size_t)l * DM * 256, 256}; pg8::StaticOrder S; S.init(NTOK, DM, G, bx);
              pg8::EpiShDown E{YSH};
              pg8::gemm_phase<pg8::EpiShDown, pg8::StaticOrder>(lds, g, S, E, wid); }
            if (PH(13)) { pg8::Gemm g{ACT, WD + (size_t)l * NEXP * DM * 256, 256};
              pg8::GroupedOrder<false> S{TP, TPX, CNTL, 4, (G - (bx & 7) + 7) >> 3, bx >> 3, bx & 7, nullptr};
              pg8::EpiDown E{YB, DST, WL};
              pg8::gemm_phase<pg8::EpiDown, pg8::GroupedOrder<false>>(lds, g, S, E, wid); }
        }
        GRID_BAR();
        for (int rep = 0; rep < NREP(11); ++rep) if (PH(11)) { LAUNDER_TID
            bf16_t* YSH = (bf16_t*)WSP(WS_YSH); bf16_t* YB = (bf16_t*)WSP(WS_YB); float* X1 = (float*)WSP(WS_X1); float* OUT = OUTP; bf16_t* H = (bf16_t*)WSP(WS_H); float* ADA = (float*)WSP(WS_ADA); const float* ada_l = (const float*)WSP(WS_ADA) + (size_t)l * 8 * 6144;
            const int gw = bx * 8 + wid, NGW = G * 8; const float* lg = INP(15) + l * DM; const float* lb = INP(16) + l * DM;
            for (int m = gw; m < NTOK; m += NGW) { const int b = m >> 12; const float* ad = ada_l + (size_t)b * 6144;
                float y[2][8]; u32x4 t[2][9];
#pragma unroll
                for (int j = 0; j < 2; ++j) { const int c0 = 512 * j + 8 * lane;
                    t[j][8] = *(const GAS u32x4*)(YSH + (size_t)m * DM + c0);
#pragma unroll
                    for (int k = 0; k < 8; ++k) t[j][k] = *(const GAS u32x4*)(YB + ((size_t)m * 8 + k) * DM + c0); }
                f32x4 xa[2][2];
#pragma unroll
                for (int j = 0; j < 2; ++j) { const float* xp = X1 + (size_t)m * DM + 512 * j + 8 * lane; xa[j][0] = *(const GAS f32x4*)xp; xa[j][1] = *(const GAS f32x4*)(xp + 4); }
#pragma unroll
                for (int j = 0; j < 2; ++j) {
#pragma unroll
                    for (int e = 0; e < 4; ++e) { y[j][2 * e] = __uint_as_float(t[j][8][e] << 16); y[j][2 * e + 1] = __uint_as_float(t[j][8][e] & 0xffff0000u); }
#pragma unroll
                    for (int k = 0; k < 8; ++k)
#pragma unroll
                        for (int e = 0; e < 4; ++e) { y[j][2 * e] += __uint_as_float(t[j][k][e] << 16); y[j][2 * e + 1] += __uint_as_float(t[j][k][e] & 0xffff0000u); } }
                float v[2][8]; float s1 = 0.f;
#pragma unroll
                for (int j = 0; j < 2; ++j) { const float* gp = ad + 5 * 1024 + 512 * j + 8 * lane; const f32x4 ga = *(const f32x4*)gp, gb = *(const f32x4*)(gp + 4);
#pragma unroll
                    for (int e = 0; e < 8; ++e) { const float g2 = (e < 4 ? ga[e & 3] : gb[e & 3]) + 1.f; const float xv = (e < 4 ? xa[j][0][e & 3] : xa[j][1][e & 3]); v[j][e] = xv * ALPHA + g2 * y[j][e]; s1 += v[j][e]; } }
                const float mean = wave_sum(s1) * (1.f / DM); float s2 = 0.f;
#pragma unroll
                for (int j = 0; j < 2; ++j)
#pragma unroll
                    for (int e = 0; e < 8; ++e) { v[j][e] -= mean; s2 += v[j][e] * v[j][e]; }
                const float rstd = 1.f / sqrtf(wave_sum(s2) * (1.f / DM) + LN_EPS);
                const float* adn = ADA + ((size_t)(l + 1) * 8 + b) * 6144;
#pragma unroll
                for (int j = 0; j < 2; ++j) { const int c0 = 512 * j + 8 * lane; const f32x4 ga = *(const f32x4*)(lg + c0), gb = *(const f32x4*)(lg + c0 + 4), ba = *(const f32x4*)(lb + c0), bb = *(const f32x4*)(lb + c0 + 4);
                    f32x4 xo0, xo1;
#pragma unroll
                    for (int e = 0; e < 4; ++e) { xo0[e] = v[j][e] * rstd * ga[e] + ba[e]; xo1[e] = v[j][4 + e] * rstd * gb[e] + bb[e]; }
                    *(f32x4*)(OUT + (size_t)m * DM + c0) = xo0; *(f32x4*)(OUT + (size_t)m * DM + c0 + 4) = xo1;
                    if (l + 1 < DEPTH) { const f32x4 sha = *(const f32x4*)(adn + c0), shb = *(const f32x4*)(adn + c0 + 4), sca = *(const f32x4*)(adn + 1024 + c0) + 1.f, scb = *(const f32x4*)(adn + 1024 + c0 + 4) + 1.f;
                        const f32x4 h0 = xo0 * sca + sha, h1 = xo1 * scb + shb;
                        u32x4 hw; hw.x = cvtpk(h0[0], h0[1]); hw.y = cvtpk(h0[2], h0[3]); hw.z = cvtpk(h1[0], h1[1]); hw.w = cvtpk(h1[2], h1[3]); *(u32x4*)(H + (size_t)m * DM + c0) = hw; } } }
        }
        if (l + 1 < DEPTH) GRID_BAR();
    }
}

extern "C" void kernel_launch(void* const* d_in, const int* in_sizes, int n_in, void* d_out, int out_size, void* d_ws, size_t ws_size, hipStream_t stream) {
    static int grid = 0;
    if (grid == 0) {
        if (n_in != 25 || out_size != NTOK * DM || ws_size < WS_END) { fprintf(stderr, "kernel_launch: unexpected shapes (n_in %d, out %d, ws %zu)\n", n_in, out_size, ws_size); grid = -1; return; }
        int dev = 0, cus = 0;
        if (hipGetDevice(&dev) != hipSuccess || hipDeviceGetAttribute(&cus, hipDeviceAttributeMultiprocessorCount, dev) != hipSuccess) { grid = -1; return; }
        if (hipFuncSetAttribute((const void*)mega_fwd, hipFuncAttributeMaxDynamicSharedMemorySize, LDS_BYTES) != hipSuccess) { fprintf(stderr, "kernel_launch: hipFuncSetAttribute failed\n"); grid = -1; return; }
        int per_cu = 0;
        if (hipOccupancyMaxActiveBlocksPerMultiprocessor(&per_cu, (const void*)mega_fwd, 512, LDS_BYTES) != hipSuccess || per_cu < 1) fprintf(stderr, "kernel_launch: occupancy query says %d\n", per_cu);
        (void)hipGetLastError();
        grid = cus;
    }
    if (grid < 0) return;
    if (hipMemsetAsync((char*)d_ws + WS_CTL, 0, CTL_BYTES, stream) != hipSuccess) return;
    Args a{};
    for (int i = 0; i < 25; ++i) a.in[i] = (const float*)d_in[i];
    a.out = (float*)d_out; a.ws = (unsigned char*)d_ws;
    hipLaunchKernelGGL(mega_fwd, dim3(grid), dim3(512), LDS_BYTES, stream, a);
}
```

```cpp
#include <hip/hip_runtime.h>
#include <cstdio>
#include <cstdint>

#define DI __device__ __forceinline__
#define LAS __attribute__((address_space(3)))
#define GAS __attribute__((address_space(1)))
typedef unsigned short bf16_t;
typedef short bf16x8 __attribute__((ext_vector_type(8)));
typedef short s16x4 __attribute__((ext_vector_type(4)));
typedef float f32x2 __attribute__((ext_vector_type(2)));
typedef float f32x4 __attribute__((ext_vector_type(4)));
typedef float f32x16 __attribute__((ext_vector_type(16)));
typedef unsigned u32x2 __attribute__((ext_vector_type(2)));
typedef unsigned u32x4 __attribute__((ext_vector_type(4)));

constexpr int DM = 1024, NB = 8, SEQ = 4096, NTOK = NB * SEQ, DEPTH = 2;
constexpr int D_IN = 2450, QKV_N = 2560;
constexpr int NEXP = 256, TOPK = 8, EDIM = 256;
constexpr float LOG2E = 1.4426950408889634f;
constexpr float C2 = 0.125f * LOG2E;
constexpr float ALPHA = 1.4142135623730951f;
constexpr float LN_EPS = 1e-5f;
constexpr int C_AQ = 0, C_AK = 384, C_AV = 512, C_BQ = 640, C_BKC = 896, C_BVC = 960, C_BKS = 1024, C_BVS = 1088, C_BKW = 1152, C_BVW = 1216,
              C_CQ = 1280, C_CK = 1664, C_CV = 2048, C_SM = 2432;
constexpr int O_A = 0, O_B = 384, O_C = 640;

constexpr size_t MiB = 1u << 20;
constexpr size_t WS_CTL = 0, CTL_BYTES = 1 * MiB;
constexpr size_t WS_ADA = 1 * MiB;
constexpr size_t WS_CPOS = WS_ADA + 512 * 1024;
constexpr size_t WS_KCMP = 2 * MiB;
constexpr size_t WS_VCMP = WS_KCMP + 256 * 1024;
constexpr size_t WS_DC = 3 * MiB;
constexpr size_t WS_KM = 3 * MiB + 832 * 1024;
constexpr size_t WS_WCT = 4 * MiB;
constexpr size_t WS_WIN = 8 * MiB;
constexpr size_t WS_WO = 18 * MiB;
constexpr size_t WS_WSH = 22 * MiB;
constexpr size_t WS_WSD = 25 * MiB;
constexpr size_t WS_WGU = 32 * MiB;
constexpr size_t WS_WD = 544 * MiB;
constexpr size_t WS_H = 800 * MiB;
constexpr size_t WS_X1 = 864 * MiB;
constexpr size_t WS_LOG = 992 * MiB;
constexpr size_t WS_ACTSH = 1024 * MiB;
constexpr size_t WS_YSH = 1040 * MiB;
constexpr size_t WS_DST = 1104 * MiB;
constexpr size_t WS_WL = 1136 * MiB;
constexpr size_t WS_SMALL = 1168 * MiB;
constexpr size_t WS_ACT = 1172 * MiB;
constexpr size_t WS_R1 = 1332 * MiB;
constexpr size_t WS_QKV = WS_R1;
constexpr size_t WS_O = WS_R1 + 160 * MiB;
constexpr size_t WS_V = WS_R1 + 224 * MiB;
constexpr size_t WS_YB = WS_R1;
constexpr size_t WS_END = 1844 * MiB;

constexpr int CW_BAR = 4096;
constexpr int CW_Q = 16384;
constexpr int CW_CNT = 32768;

constexpr int RING_BYTES = 131072;
constexpr int L_MISC = RING_BYTES;
constexpr int L_LUT = L_MISC + 256;
constexpr int L_TP = L_LUT + 5120;
constexpr int L_CNT = L_TP + 1040;
constexpr int L_PT = L_CNT + 1024;
constexpr int L_TPX = L_PT + 256;
constexpr int LDS_BYTES = 147456;
static_assert(L_TPX + 144 <= LDS_BYTES, "LDS map");

DI unsigned cvtpk(float lo, float hi) { typedef __bf16 b2 __attribute__((ext_vector_type(2))); f32x2 v = {lo, hi}; b2 b = __builtin_convertvector(v, b2); return __builtin_bit_cast(unsigned, b); }
DI float bf2f(bf16_t v) { return __uint_as_float((unsigned)v << 16); }
DI float fast_exp2(float x) { return __builtin_amdgcn_exp2f(x); }
DI float sigmoidf_(float x) { return 1.f / (1.f + __expf(-x)); }
DI float siluf_(float x) { return x / (1.f + __expf(-x)); }

#define XB_TMO      128
#define XB_XCNT(j)  (256  + 64 * (j))
#define XB_XSUB(j)  (1280 + 64 * (j))
#define XB_XGEN(j)  (2304 + 64 * (j))
#define XB_TOP      3328
#define XB_TOPGEN   3392
#define XCD_BAR_WORDS 3456
#define XB_SPIN_CAP (1u << 22)

__device__ __forceinline__ unsigned xb_ld(unsigned* p)              { return __hip_atomic_load(p, __ATOMIC_RELAXED, __HIP_MEMORY_SCOPE_AGENT); }
__device__ __forceinline__ unsigned xb_add(unsigned* p, unsigned v) { return __hip_atomic_fetch_add(p, v, __ATOMIC_RELAXED, __HIP_MEMORY_SCOPE_AGENT); }
__device__ __forceinline__ unsigned xb_xcc_id() { return (unsigned)__builtin_amdgcn_s_getreg((3 << 11) | 20) & 0xFu; }
#define XB_SPIN(cond, bar) do { unsigned _sp = 0; while (cond) { __builtin_amdgcn_s_sleep(1); \
    if ((++_sp & 255u) == 0u) { if (xb_ld(&(bar)[XB_TMO])) break; if (_sp > XB_SPIN_CAP) { atomicAdd(&(bar)[XB_TMO], 1u); break; } } } } while (0)

struct XcdBarrier { unsigned* bar; unsigned x; volatile LAS unsigned* st; };

__device__ __forceinline__ XcdBarrier xcd_barrier_post(unsigned* bar, volatile LAS unsigned* st) {
    XcdBarrier b; b.bar = bar; b.x = xb_xcc_id(); b.st = st;
    if (threadIdx.x == 0) (void)xb_add(&bar[XB_XCNT(b.x)], 1u);
    return b;
}
__device__ __forceinline__ void xcd_barrier_complete(unsigned* bar, unsigned x, unsigned& nloc, unsigned& nx) {
    const unsigned G = gridDim.x * gridDim.y * gridDim.z;
    unsigned sum, cnt, mine, sp = 0u;
    for (;;) {
        sum = 0u; cnt = 0u; mine = 0u;
#pragma unroll
        for (unsigned j = 0; j < 16; ++j) { const unsigned c = xb_ld(&bar[XB_XCNT(j)]); sum += c; cnt += (c > 0u) ? 1u : 0u; mine = (j == x) ? c : mine; }
        if (sum == G) break;
        __builtin_amdgcn_s_sleep(1);
        if ((++sp & 255u) == 0u) { if (xb_ld(&bar[XB_TMO])) break; if (sp > XB_SPIN_CAP) { atomicAdd(&bar[XB_TMO], 1u); break; } }
    }
    nloc = mine > 0u ? mine : 1u; nx = cnt > 0u ? cnt : 1u;
}
__device__ __forceinline__ void xcd_barrier(const XcdBarrier& b, bool leader_thread) {
    asm volatile("s_waitcnt vmcnt(0)" ::: "memory");
    __syncthreads();
    if (leader_thread) {
        unsigned* bar = b.bar;
        __builtin_amdgcn_s_waitcnt(0);
        unsigned nloc = b.st[0], nx = b.st[1];
        if (nloc == 0u) { xcd_barrier_complete(bar, b.x, nloc, nx); b.st[0] = nloc; b.st[1] = nx; }
        const unsigned old = xb_add(&bar[XB_XSUB(b.x)], 1u);
        const unsigned gen = old / nloc;
        if (old + 1u == (gen + 1u) * nloc) {
            __builtin_amdgcn_fence(__ATOMIC_RELEASE, "agent");
            asm volatile("s_waitcnt vmcnt(0)" ::: "memory");
            const unsigned og = xb_add(&bar[XB_TOP], 1u);
            const unsigned tg = og / nx;
            if (og + 1u == (tg + 1u) * nx) xb_add(&bar[XB_TOPGEN], 1u);
            else XB_SPIN(xb_ld(&bar[XB_TOPGEN]) == tg, bar);
            __builtin_amdgcn_fence(__ATOMIC_ACQUIRE, "agent");
            xb_add(&bar[XB_XGEN(b.x)], 1u);
            asm volatile("s_waitcnt vmcnt(0)" ::: "memory");
        } else {
            XB_SPIN(xb_ld(&bar[XB_XGEN(b.x)]) == gen, bar);
            __builtin_amdgcn_fence(__ATOMIC_ACQUIRE, "agent");
            asm volatile("s_waitcnt vmcnt(0)" ::: "memory");
        }
    }
    __syncthreads();
}

namespace pg8 {
constexpr int BM = 256, BK = 64, HALF = 128, HTB = HALF * BK * 2, STAGE_BYTES = 8 * HTB, NXCD = 8, WGM = 8;
__host__ __device__ __forceinline__ int lds_byte(int r, int c) { const int st = (r >> 4) * 2 + (c >> 5), rr = r & 15, cc = c & 31, ob = rr * 64 + cc * 2; return st * 1024 + (ob ^ (((ob >> 9) & 1) << 5)); }
__host__ __device__ __forceinline__ void stage_rc(int b, int& R, int& C) { const int st = b / 1024, sb = b % 1024, swz = sb ^ (((sb >> 9) & 1) << 5); R = (st >> 1) * 16 + swz / 64; C = (st & 1) * 32 + (swz % 64) / 2; }
__host__ __device__ __forceinline__ int perm32(int rho) { const int n = rho >> 4, i = rho & 15; return 8 * (i >> 2) + 4 * n + (i & 3); }

struct Unit { int pm, pn, e, lrow0, cnt; };
struct Gemm { const bf16_t* A; const bf16_t* Bt; int K; };

struct StaticOrder {
    int nM, nN, nwg, G, c;
    DI void init(int M, int N, int G_, int c_) { nM = M / BM; nN = N / BM; nwg = nM * nN; G = G_; c = c_; }
    DI bool next(int i, Unit& u) const {
        const long L = (long)i * G + c; if (L >= nwg) return false;
        int wgid = (int)L; { const int q = nwg / NXCD, r = nwg % NXCD, xcd = wgid % NXCD, off = wgid / NXCD; wgid = (xcd < r ? xcd * (q + 1) : r * (q + 1) + (xcd - r) * q) + off; }
        const int nig = WGM * nN, gid = wgid / nig, fm = gid * WGM, gsz = (nM - fm) < WGM ? (nM - fm) : WGM;
        u.pm = fm + ((wgid % nig) % gsz); u.pn = (wgid % nig) / gsz; u.e = 0; u.lrow0 = 0; u.cnt = 0; return true;
    }
    static constexpr bool GATHER = false;
    DI unsigned tokpair(const Unit&, int, int) const { return 0u; }
};
template <bool GATHER_> struct GroupedOrder {
    static constexpr bool GATHER = GATHER_;
    const LAS int* TP; const LAS int* TPX; const LAS int* CNT; int NT, nwx, rk, x; const int* list;
    DI bool next(int i, Unit& u) const {
        const int total = TPX[32] * NT; const int L = i * nwx + rk; if (L >= total) return false;
        const int mt = L / NT, nt = L - mt * NT;
        int lo = 0, hi = 31;
        while (lo < hi) { const int mid = (lo + hi + 1) >> 1; if (TPX[mid] <= mt) lo = mid; else hi = mid - 1; }
        const int e = 8 * lo + x, ml = mt - TPX[lo];
        u.pm = __builtin_amdgcn_readfirstlane(TP[e] + ml); u.pn = __builtin_amdgcn_readfirstlane(e * NT + nt); u.e = __builtin_amdgcn_readfirstlane(e);
        u.lrow0 = __builtin_amdgcn_readfirstlane(ml * BM); u.cnt = __builtin_amdgcn_readfirstlane(CNT[e]); return true;
    }
    DI unsigned tokpair(const Unit& u, int R0, int) const {
        int l0 = u.lrow0 + R0, l1 = l0 + HALF; l0 = l0 < u.cnt ? l0 : u.cnt - 1; l1 = l1 < u.cnt ? l1 : u.cnt - 1;
        const unsigned t0 = (unsigned)(list[u.e * NTOK + l0] >> 3), t1 = (unsigned)(list[u.e * NTOK + l1] >> 3); return t0 | (t1 << 16);
    }
};

template <class Epi, class Sched>
__device__ __forceinline__ void gemm_phase(LAS unsigned char* lds, const Gemm g, const Sched& S, const Epi& E, int wid_) {
    int lane; asm volatile("v_mbcnt_lo_u32_b32 %0, -1, 0\n\tv_mbcnt_hi_u32_b32 %0, -1, %0" : "=v"(lane));
    int wid = wid_; asm volatile("" : "+s"(wid)); const int tid = wid * 64 + lane, wr = wid >> 2, wc = wid & 3, fr = lane & 15, fq = lane >> 4;
    const int K = g.K, nt = K / BK;
    constexpr bool GA = Sched::GATHER;
    unsigned voffA[2], voffB[2]; int RA[2];
#pragma unroll
    for (int i = 0; i < 2; ++i) { int R, C; stage_rc(tid * 16 + i * 8192, R, C); const int Rb = Epi::PERM ? ((R & ~31) + perm32(R & 31)) : R;
        RA[i] = R; voffA[i] = GA ? (unsigned)(C * 2) : (unsigned)(R * K + C) * 2u; voffB[i] = (unsigned)(Rb * K + C) * 2u; }
    const size_t kstep = (size_t)(BK * 2);
    const size_t hstep = (size_t)HALF * K * 2;
    const size_t tstep = 2 * hstep;
    const unsigned ldsw = (unsigned)wid * 1024u;
    const int aoff = lds_byte(wr * 64 + fr, fq * 8), boff = lds_byte(wc * 32 + fr, fq * 8);
#define PG8_SA(b, h) (((b) * 2 + (h)) * HTB)
#define PG8_SB(b, h) ((4 + (b) * 2 + (h)) * HTB)
#define PG8_STAGE(bufoff, gbase, voff) do { _Pragma("unroll") for (int _i = 0; _i < 2; ++_i) \
        __builtin_amdgcn_global_load_lds((const unsigned*)((const char*)(gbase) + (voff)[_i]), (LAS unsigned*)(lds + (bufoff) + ldsw + _i * 8192), 16, 0, 0); } while (0)
#define PG8_STAGEA(bufoff, ubase, tp, hh, kb) do { _Pragma("unroll") for (int _i = 0; _i < 2; ++_i) { \
        const char* _p = GA ? ((const char*)g.A + (size_t)(kb) + (size_t)((((tp)[_i] >> (16 * (hh))) & 0xffffu) * (unsigned)(K * 2)) + voffA[_i]) : ((ubase) + (size_t)(hh) * hstep + (size_t)(kb) + voffA[_i]); \
        __builtin_amdgcn_global_load_lds((const unsigned*)_p, (LAS unsigned*)(lds + (bufoff) + ldsw + _i * 8192), 16, 0, 0); } } while (0)
#define PG8_LDA(dst, b, h) do { _Pragma("unroll") for (int m = 0; m < 4; ++m) _Pragma("unroll") for (int k = 0; k < 2; ++k) dst[m][k] = *(const LAS bf16x8*)(lds + PG8_SA(b, h) + aoff + m * 2048 + k * 1024); } while (0)
#define PG8_LDB(dst, b, h) do { _Pragma("unroll") for (int n = 0; n < 2; ++n) _Pragma("unroll") for (int k = 0; k < 2; ++k) dst[n][k] = *(const LAS bf16x8*)(lds + PG8_SB(b, h) + boff + n * 2048 + k * 1024); } while (0)
#define PG8_MMA(ai, bj, At, Bt) do { __builtin_amdgcn_s_setprio(1); _Pragma("unroll") for (int m = 0; m < 4; ++m) _Pragma("unroll") for (int n = 0; n < 2; ++n) _Pragma("unroll") for (int k = 0; k < 2; ++k) \
        acc[ai][bj][m][n] = __builtin_amdgcn_mfma_f32_16x16x32_bf16(Bt[n][k], At[m][k], acc[ai][bj][m][n], 0, 0, 0); __builtin_amdgcn_s_setprio(0); } while (0)
#define PG8_WAIT_V(n) asm volatile("s_waitcnt vmcnt(" #n ")" ::: "memory")
#define PG8_WAIT_L(n) asm volatile("s_waitcnt lgkmcnt(" #n ")" ::: "memory")
#define PG8_BAR __builtin_amdgcn_s_barrier()
#define PG8_SCHED __builtin_amdgcn_sched_barrier(0)
    Unit cur, nxt; int ui = 0;
    if (!S.next(0, cur)) return;
    f32x4 acc[2][2][4][2];
#pragma unroll
    for (int a = 0; a < 2; ++a)
#pragma unroll
        for (int b = 0; b < 2; ++b)
#pragma unroll
            for (int m = 0; m < 4; ++m)
#pragma unroll
                for (int n = 0; n < 2; ++n) acc[a][b][m][n] = (f32x4){0.f, 0.f, 0.f, 0.f};
    bf16x8 At[4][2], B0[2][2], B1[2][2];
    unsigned tpc[2] = {0u, 0u}, tpn[2] = {0u, 0u};
    if (GA) {
#pragma unroll
        for (int i = 0; i < 2; ++i) tpc[i] = S.tokpair(cur, RA[i], 0); }
#define PG8_FRESH_R(i, Rv) int Rv; { int l2_; asm volatile("v_mbcnt_lo_u32_b32 %0, -1, 0\n\tv_mbcnt_hi_u32_b32 %0, -1, %0" : "=v"(l2_)); int C2_; stage_rc((wid * 64 + l2_) * 16 + (i) * 8192, Rv, C2_); }
    const char* cA = GA ? (const char*)g.A : (const char*)g.A + (size_t)cur.pm * tstep; const char* cB = (const char*)g.Bt + (size_t)cur.pn * tstep;
    {
        PG8_STAGE(PG8_SB(0, 0), cB, voffB); PG8_STAGE(PG8_SB(0, 1), cB + hstep, voffB); PG8_STAGEA(PG8_SA(0, 0), cA, tpc, 0, 0); PG8_STAGEA(PG8_SA(0, 1), cA, tpc, 1, 0);
        if (wr == 1) PG8_BAR;
        PG8_WAIT_V(2); PG8_BAR;
        PG8_STAGE(PG8_SB(1, 0), cB + kstep, voffB); PG8_STAGEA(PG8_SA(1, 0), cA, tpc, 0, kstep); PG8_STAGE(PG8_SB(1, 1), cB + hstep + kstep, voffB);
        PG8_WAIT_V(6); PG8_BAR;
    }
    for (;;) {
        u32x2 warm_ = E.warm(cur, lane);
        const bool has_next = S.next(ui + 1, nxt);
        const char* nA = GA ? cA : (has_next ? (const char*)g.A + (size_t)nxt.pm * tstep : cA); const char* nB = has_next ? (const char*)g.Bt + (size_t)nxt.pn * tstep : cB;
        if (GA) {
#pragma unroll
            for (int i = 0; i < 2; ++i) { if (has_next) { PG8_FRESH_R(i, Rn_); tpn[i] = S.tokpair(nxt, Rn_, 0); } else tpn[i] = tpc[i]; } }
#pragma unroll 1
        for (int t = 0; t < nt; t += 2) {
            const bool last = (t == nt - 2);
            const size_t k1 = (size_t)(t + 1) * kstep;
            const size_t k2 = last ? 0 : (size_t)(t + 2) * kstep; const size_t k3 = k2 + kstep;
            const char* a2 = last ? nA : cA;
            unsigned tp2[2];
#pragma unroll
            for (int i = 0; i < 2; ++i) tp2[i] = last ? tpn[i] : tpc[i];
            const char* b2 = last ? nB : cB + (size_t)(t + 2) * kstep;
            const char* b3 = b2 + kstep;
            PG8_LDB(B0, 0, 0); PG8_LDB(B1, 0, 1); PG8_SCHED; PG8_LDA(At, 0, 0); PG8_STAGEA(PG8_SA(1, 1), cA, tpc, 1, k1);
            PG8_WAIT_V(8); PG8_WAIT_L(0); PG8_BAR; PG8_MMA(0, 0, At, B0); PG8_MMA(0, 1, At, B1); PG8_BAR; PG8_SCHED;
            PG8_LDA(At, 0, 1); PG8_STAGE(PG8_SB(0, 0), b2, voffB); PG8_STAGE(PG8_SB(0, 1), b2 + hstep, voffB); PG8_STAGEA(PG8_SA(0, 0), a2, tp2, 0, k2);
            PG8_WAIT_V(8); PG8_WAIT_L(0); PG8_BAR; PG8_MMA(1, 0, At, B0); PG8_MMA(1, 1, At, B1); PG8_BAR; PG8_SCHED;
            PG8_LDB(B0, 1, 0); PG8_LDB(B1, 1, 1); PG8_SCHED; PG8_LDA(At, 1, 0); PG8_STAGEA(PG8_SA(0, 1), a2, tp2, 1, k2);
            PG8_WAIT_V(8); PG8_WAIT_L(0); PG8_BAR; PG8_MMA(0, 0, At, B0); PG8_MMA(0, 1, At, B1); PG8_BAR; PG8_SCHED;
            PG8_LDA(At, 1, 1); PG8_STAGE(PG8_SB(1, 0), b3, voffB); PG8_STAGE(PG8_SB(1, 1), b3 + hstep, voffB); PG8_STAGEA(PG8_SA(1, 0), a2, tp2, 0, k3);
            PG8_WAIT_V(8); PG8_WAIT_L(0); PG8_BAR; PG8_MMA(1, 0, At, B0); PG8_MMA(1, 1, At, B1); PG8_BAR; PG8_SCHED;
        }
        if (wr == 0) PG8_BAR;
        asm volatile("" :: "v"(warm_));
        E(acc, cur, wr, wc, fr, fq);
        if (!has_next) break;
#pragma unroll
        for (int a = 0; a < 2; ++a)
#pragma unroll
            for (int b = 0; b < 2; ++b)
#pragma unroll
                for (int m = 0; m < 4; ++m)
#pragma unroll
                    for (int n = 0; n < 2; ++n) acc[a][b][m][n] = (f32x4){0.f, 0.f, 0.f, 0.f};
        cur = nxt; cA = nA; cB = nB; ++ui;
#pragma unroll
        for (int i = 0; i < 2; ++i) tpc[i] = tpn[i];
        if (wr == 1) PG8_BAR;
    }
    PG8_WAIT_V(0);
    PG8_BAR;
#undef PG8_SA
#undef PG8_SB
#undef PG8_STAGE
#undef PG8_STAGEA
#undef PG8_FRESH_R
#undef PG8_LDA
#undef PG8_LDB
#undef PG8_MMA
#undef PG8_WAIT_V
#undef PG8_WAIT_L
#undef PG8_BAR
#undef PG8_SCHED
}

DI u32x4 pack8(const f32x4& v0, const f32x4& v1) { u32x4 w; w.x = cvtpk(v0[0], v0[1]); w.y = cvtpk(v0[2], v0[3]); w.z = cvtpk(v1[0], v1[1]); w.w = cvtpk(v1[2], v1[3]); return w; }

struct EpiQKV { static constexpr bool PERM = true;
    DI u32x2 warm(const Unit&, int) const { return (u32x2){0u, 0u}; }
    bf16_t* O; float* SM;
    DI void operator()(const f32x4 (&acc)[2][2][4][2], const Unit& u, int wr, int wc, int fr, int fq) const {
        const int row0 = u.pm * BM + wr * 64 + fr, colt = u.pn * BM + wc * 32 + 8 * fq;
#pragma unroll
        for (int bj = 0; bj < 2; ++bj) { const int col = colt + bj * HALF;
            const bool isq = (col < C_AK) || (col >= C_BQ && col < C_BKC) || (col >= C_CQ && col < C_CK);
            const float sc = isq ? C2 : 1.f; const bool sm = (col >= C_SM && col < C_SM + 32);
#pragma unroll
            for (int ai = 0; ai < 2; ++ai)
#pragma unroll
                for (int m = 0; m < 4; ++m) { const int row = row0 + ai * HALF + m * 16;
                    const f32x4 v0 = acc[ai][bj][m][0] * sc, v1 = acc[ai][bj][m][1] * sc;
                    *(u32x4*)(O + (size_t)row * QKV_N + col) = pack8(v0, v1);
                    if (sm) { float* sp = SM + (size_t)row * 32 + (col - C_SM); *(f32x4*)sp = v0; *(f32x4*)(sp + 4) = v1; } } }
    }
};
struct EpiWO { static constexpr bool PERM = false;
    DI u32x2 warm(const Unit&, int) const { return (u32x2){0u, 0u}; }
    const float* xin; float* V; const float* g1;
    DI void operator()(const f32x4 (&acc)[2][2][4][2], const Unit& u, int wr, int wc, int fr, int fq) const {
        const int row0 = u.pm * BM + wr * 64 + fr, col0 = u.pn * BM + wc * 32 + 4 * fq; const int b = (u.pm * BM) >> 12;
#pragma unroll
        for (int bj = 0; bj < 2; ++bj)
#pragma unroll
            for (int n = 0; n < 2; ++n) { const int col = col0 + bj * HALF + n * 16; const f32x4 gg = *(const f32x4*)(g1 + (size_t)b * 6144 + col) + 1.f;
#pragma unroll
                for (int ai = 0; ai < 2; ++ai)
#pragma unroll
                    for (int m = 0; m < 4; ++m) { const size_t off = (size_t)(row0 + ai * HALF + m * 16) * DM + col;
                        const f32x4 xv = *(const f32x4*)(xin + off); *(f32x4*)(V + off) = xv * ALPHA + gg * acc[ai][bj][m][n]; } }
    }
};
DI f32x4 swiglu4(const f32x4& g, const f32x4& u) { f32x4 r; r[0] = siluf_(g[0]) * u[0]; r[1] = siluf_(g[1]) * u[1]; r[2] = siluf_(g[2]) * u[2]; r[3] = siluf_(g[3]) * u[3]; return r; }
struct EpiSH { static constexpr bool PERM = true;
    DI u32x2 warm(const Unit&, int) const { return (u32x2){0u, 0u}; }
    float* LOG; bf16_t* ACT;
    DI void operator()(const f32x4 (&acc)[2][2][4][2], const Unit& u, int wr, int wc, int fr, int fq) const {
        const int row0 = u.pm * BM + wr * 64 + fr, c8 = wc * 32 + 8 * fq;
        if (u.pn == 0) {
#pragma unroll
            for (int bj = 0; bj < 2; ++bj)
#pragma unroll
                for (int ai = 0; ai < 2; ++ai)
#pragma unroll
                    for (int m = 0; m < 4; ++m) { float* p = LOG + (size_t)(row0 + ai * HALF + m * 16) * 256 + bj * HALF + c8; *(f32x4*)p = acc[ai][bj][m][0]; *(f32x4*)(p + 4) = acc[ai][bj][m][1]; }
        } else {
            const int cb = (u.pn - 1) * HALF + c8;
#pragma unroll
            for (int ai = 0; ai < 2; ++ai)
#pragma unroll
                for (int m = 0; m < 4; ++m) { const f32x4 a0 = swiglu4(acc[ai][0][m][0], acc[ai][1][m][0]), a1 = swiglu4(acc[ai][0][m][1], acc[ai][1][m][1]);
                    *(u32x4*)(ACT + (size_t)(row0 + ai * HALF + m * 16) * 256 + cb) = pack8(a0, a1); }
        }
    }
};
struct EpiGU { static constexpr bool PERM = true;
    DI u32x2 warm(const Unit&, int) const { return (u32x2){0u, 0u}; }
    bf16_t* ACT;
    DI void operator()(const f32x4 (&acc)[2][2][4][2], const Unit& u, int wr, int wc, int fr, int fq) const {
        const int rin0 = wr * 64 + fr, cb = (u.pn & 1) * HALF + wc * 32 + 8 * fq;
#pragma unroll
        for (int ai = 0; ai < 2; ++ai)
#pragma unroll
            for (int m = 0; m < 4; ++m) { const int rin = rin0 + ai * HALF + m * 16;
                if (u.lrow0 + rin < u.cnt) { const f32x4 a0 = swiglu4(acc[ai][0][m][0], acc[ai][1][m][0]), a1 = swiglu4(acc[ai][0][m][1], acc[ai][1][m][1]);
                    *(u32x4*)(ACT + (size_t)(u.pm * BM + rin) * 256 + cb) = pack8(a0, a1); } }
    }
};
struct EpiDown { static constexpr bool PERM = true;
    bf16_t* YB; const int* DST; const float* WL;
    DI u32x2 warm(const Unit& u, int lane) const { const int o = 16 * (lane & 15); const int* p = DST + (size_t)u.e * NTOK + u.lrow0 + o; const float* q = WL + (size_t)u.e * NTOK + u.lrow0 + o; unsigned t0, t1;
        asm volatile("global_load_dword %0, %2, off\n\tglobal_load_dword %1, %3, off" : "=&v"(t0), "=&v"(t1) : "v"(p), "v"(q) : "memory"); return (u32x2){t0, t1}; }
    DI void operator()(const f32x4 (&acc)[2][2][4][2], const Unit& u, int wr, int wc, int fr, int fq) const {
        const int rin0 = wr * 64 + fr, cb = (u.pn & 3) * BM + wc * 32 + 8 * fq;
#pragma unroll
        for (int ai = 0; ai < 2; ++ai)
#pragma unroll
            for (int m = 0; m < 4; ++m) { const int local = u.lrow0 + rin0 + ai * HALF + m * 16;
                if (local < u.cnt) { const int dst = DST[(size_t)u.e * NTOK + local]; const float w = WL[(size_t)u.e * NTOK + local];
#pragma unroll
                    for (int bj = 0; bj < 2; ++bj) *(u32x4*)(YB + (size_t)dst * DM + cb + bj * HALF) = pack8(acc[ai][bj][m][0] * w, acc[ai][bj][m][1] * w); } }
    }
};
struct EpiShDown { static constexpr bool PERM = true;
    DI u32x2 warm(const Unit&, int) const { return (u32x2){0u, 0u}; }
    bf16_t* Y;
    DI void operator()(const f32x4 (&acc)[2][2][4][2], const Unit& u, int wr, int wc, int fr, int fq) const {
        const int row0 = u.pm * BM + wr * 64 + fr, cb = u.pn * BM + wc * 32 + 8 * fq;
#pragma unroll
        for (int ai = 0; ai < 2; ++ai)
#pragma unroll
            for (int m = 0; m < 4; ++m)
#pragma unroll
                for (int bj = 0; bj < 2; ++bj) *(u32x4*)(Y + (size_t)(row0 + ai * HALF + m * 16) * DM + cb + bj * HALF) = pack8(acc[ai][bj][m][0], acc[ai][bj][m][1]);
    }
};
}

namespace att {
#define MFMA32(a, b, c) __builtin_amdgcn_mfma_f32_32x32x16_bf16((a), (b), (c), 0, 0, 0)
constexpr int A_KB = 0, A_VB = 24576, A_IMP = 49152, A_SEL = A_IMP + 4 * 64 * 65 * 4  , A_DK = A_SEL + 512, A_NEED = A_DK + 768, A_KM = A_NEED + 64, A_END = A_KM + 512;
static_assert(A_END <= RING_BYTES, "attention LDS");
constexpr float NEGINF = -__builtin_inff();
enum { M_BAND = 0, M_SLC = 1, M_FOX = 2, M_CMP1 = 3, M_CMP2 = 4 };
typedef short v4i16_t __attribute__((ext_vector_type(4)));
DI s16x4 vtr(LAS const char* p) { return __builtin_bit_cast(s16x4, __builtin_amdgcn_ds_read_tr16_b64_v4i16((LAS v4i16_t*)p)); }
DI int cofs(int i) { return (i & 3) + 8 * (i >> 2); }

struct Acc { f32x16 o0, o1; float m, l; };
struct PassArgs {
    const bf16_t* Kg; const bf16_t* Vg; int pitch;
    int jfirst, ntiles, step;
    int tq0;
    const LAS float* lut;
    unsigned long long sel;
    float dq; const float* dkg;
    float qn; const float* km;
    float fm, frl;
    LAS float* imp;
};

DI void qk_tile(f32x16& p0, f32x16& p1, LAS const char* kb, const bf16x8 (&qr)[4], int r, int h) {
#pragma unroll
    for (int i = 0; i < 16; ++i) { p0[i] = 0.f; p1[i] = 0.f; }
    LAS const char* rp = kb + r * 128;
#pragma unroll
    for (int s = 0; s < 4; ++s) { const int o = 16 * ((2 * s + h) ^ (r & 7));
        const bf16x8 a0 = *(const LAS bf16x8*)(rp + o), a1 = *(const LAS bf16x8*)(rp + 4096 + o);
        p0 = MFMA32(a0, qr[s], p0); p1 = MFMA32(a1, qr[s], p1); }
}
DI bf16x8 pack_step(const f32x16& x, int s) { u32x4 p; p.x = cvtpk(x[8 * s], x[8 * s + 1]); p.y = cvtpk(x[8 * s + 2], x[8 * s + 3]); p.z = cvtpk(x[8 * s + 4], x[8 * s + 5]); p.w = cvtpk(x[8 * s + 6], x[8 * s + 7]); return __builtin_bit_cast(bf16x8, p); }
DI void pv_tile(f32x16& o0, f32x16& o1, const f32x16& p0, const f32x16& p1, LAS const char* va0, LAS const char* va1) {
#pragma unroll
    for (int blk = 0; blk < 2; ++blk)
#pragma unroll
        for (int s = 0; s < 2; ++s) { const bf16x8 xs = pack_step(blk ? p1 : p0, s); const int ro = (32 * blk + 16 * s) * 128;
            { const s16x4 lo = vtr(va0 + ro), hi = vtr(va0 + ro + 1024); const bf16x8 vf = __builtin_shufflevector(lo, hi, 0, 1, 2, 3, 4, 5, 6, 7); o0 = MFMA32(vf, xs, o0); }
            { const s16x4 lo = vtr(va1 + ro), hi = vtr(va1 + ro + 1024); const bf16x8 vf = __builtin_shufflevector(lo, hi, 0, 1, 2, 3, 4, 5, 6, 7); o1 = MFMA32(vf, xs, o1); } }
}

template <int MODE, int W>
DI void attn_pass(LAS char* lds, const PassArgs& P, const bf16x8 (&qr)[4], Acc& a, int tid_, int lane_) {
    int lane; asm volatile("v_mbcnt_lo_u32_b32 %0, -1, 0\n\tv_mbcnt_hi_u32_b32 %0, -1, %0" : "=v"(lane)); const int tid = (tid_ & ~63) | lane; (void)lane_;
    const int r = lane & 31, h = lane >> 5;
    const int lrow = tid >> 3, lch = tid & 7;
    const size_t goff = (size_t)lrow * P.pitch + lch * 8;
    const int kdst = lrow * 128 + 16 * (lch ^ (lrow & 7)), vdst = lrow * 128 + 16 * (lch ^ (((lrow >> 1) & 1) << 2));
    const int q4 = (lane & 15) >> 2, p4 = lane & 3, g1 = (lane >> 4) & 1, swb = (q4 >> 1) & 1;
    const int vofs0 = (4 * h + q4) * 128 + 16 * (4 * (0 ^ swb) + 2 * g1 + (p4 >> 1)) + 8 * (p4 & 1);
    const int vofs1 = (4 * h + q4) * 128 + 16 * (4 * (1 ^ swb) + 2 * g1 + (p4 >> 1)) + 8 * (p4 & 1);
    const int tq = P.tq0 + r;
    const int wid_ = __builtin_amdgcn_readfirstlane(tid >> 6);
    const size_t goffK = (size_t)lrow * P.pitch + (size_t)((lch ^ (lrow & 7)) * 8), goffV = (size_t)lrow * P.pitch + (size_t)((lch ^ (((lrow >> 1) & 1) << 2)) * 8);
    (void)goff; (void)kdst; (void)vdst;
#define ATT_DMA(jj, slot) do { const size_t t0_ = (size_t)(jj) * 64 * P.pitch; \
        __builtin_amdgcn_global_load_lds((const unsigned*)(P.Kg + t0_ + goffK), (LAS unsigned*)(lds + A_KB + (slot) * 8192 + wid_ * 1024), 16, 0, 0); \
        __builtin_amdgcn_global_load_lds((const unsigned*)(P.Vg + t0_ + goffV), (LAS unsigned*)(lds + A_VB + (slot) * 8192 + wid_ * 1024), 16, 0, 0); \
        if (MODE == M_FOX) __builtin_amdgcn_global_load_lds((const unsigned*)(P.dkg + 64 * (jj) + lane), (LAS unsigned*)(lds + A_DK + (slot) * 256), 4, 0, 0); } while (0)
    if (MODE == M_FOX) { if (tid == 0) { unsigned z_ = 0u; asm volatile("" : "+v"(z_)); *(LAS unsigned*)(lds + A_NEED) = z_; *(LAS unsigned*)(lds + A_NEED + 4) = z_; *(LAS unsigned*)(lds + A_NEED + 8) = z_; }
        if (tid < 64) { *(LAS float*)(lds + A_KM + 4 * tid) = P.km[tid]; *(LAS float*)(lds + A_KM + 256 + 4 * tid) = P.dkg[64 * tid + 63]; } }
    bool wdone = false;
    ATT_DMA(P.jfirst, 0);
    if (P.ntiles > 1) { ATT_DMA(P.jfirst + P.step, 1);
        if (MODE == M_FOX) asm volatile("s_waitcnt vmcnt(3) lgkmcnt(0)\n\ts_barrier" ::: "memory"); else asm volatile("s_waitcnt vmcnt(2) lgkmcnt(0)\n\ts_barrier" ::: "memory");
    } else asm volatile("s_waitcnt vmcnt(0) lgkmcnt(0)\n\ts_barrier" ::: "memory");
    float carry = 0.f;
    int sl = 0;
    for (int it = 0; it < P.ntiles; ++it) {
        const int j = P.jfirst + it * P.step, buf = sl;
        const bool more = (it + 1 < P.ntiles), more2 = (it + 2 < P.ntiles);
        if (more2) { const int s2 = (sl >= 1) ? sl - 1 : 2; ATT_DMA(j + 2 * P.step, s2); }
        const int kv0 = 64 * j;
        bool skip;
        if (MODE == M_BAND) skip = (kv0 > P.tq0 + 31) || (kv0 + 63 < P.tq0 - (W - 1));
        else if (MODE == M_SLC) skip = (kv0 > P.tq0 + 31) || (__ballot((P.sel >> j) & 1ull) == 0ull);
        else if (MODE == M_FOX) skip = (kv0 > P.tq0 + 31) || wdone;
        else skip = (1024 * j > P.tq0);
        if (!skip) {
            LAS const char* kb = lds + A_KB + buf * 8192; LAS const char* vb = lds + A_VB + buf * 8192;
            f32x16 p0, p1;
            bf16x8 kf[8];
            { LAS const char* rp = kb + r * 128;
#pragma unroll
                for (int s = 0; s < 4; ++s) { const int o = 16 * ((2 * s + h) ^ (r & 7)); kf[2 * s] = *(const LAS bf16x8*)(rp + o); kf[2 * s + 1] = *(const LAS bf16x8*)(rp + 4096 + o); } }
            if (MODE == M_FOX) {
#pragma unroll
                for (int k = 0; k < 4; ++k) { const f32x4 d0 = *(const LAS f32x4*)(lds + A_DK + buf * 256 + (8 * k + 4 * h) * 4), d1 = *(const LAS f32x4*)(lds + A_DK + buf * 256 + (32 + 8 * k + 4 * h) * 4);
#pragma unroll
                    for (int e = 0; e < 4; ++e) { p0[4 * k + e] = d0[e]; p1[4 * k + e] = d1[e]; } }
            } else {
#pragma unroll
                for (int i = 0; i < 16; ++i) { p0[i] = 0.f; p1[i] = 0.f; }
            }
            s16x4 vlo[8], vhi[8];
            if (MODE != M_CMP1) {
#pragma unroll
                for (int f = 0; f < 4; ++f) { const int ro = (32 * (f >> 1) + 16 * (f & 1)) * 128;
                    vlo[2 * f] = vtr(vb + vofs0 + ro); vhi[2 * f] = vtr(vb + vofs0 + ro + 1024); vlo[2 * f + 1] = vtr(vb + vofs1 + ro); vhi[2 * f + 1] = vtr(vb + vofs1 + ro + 1024); } }
#pragma unroll
            for (int f = 0; f < 8; ++f) asm volatile("" : "+v"(kf[f]));
#pragma unroll
            for (int s = 0; s < 4; ++s) { p0 = MFMA32(kf[2 * s], qr[s], p0); p1 = MFMA32(kf[2 * s + 1], qr[s], p1); }
            if (MODE != M_CMP1) {
#pragma unroll
                for (int f = 0; f < 8; ++f) asm volatile("" : "+v"(vlo[f]), "+v"(vhi[f])); }
#define ATT_PV(P0_, P1_, KEEP_) do { _Pragma("unroll") for (int f = 0; f < 4; ++f) { u32x4 xp = __builtin_bit_cast(u32x4, pack_step((f >> 1) ? P1_ : P0_, f & 1)); \
                if (MODE == M_SLC) { xp.x = (KEEP_) ? xp.x : 0u; xp.y = (KEEP_) ? xp.y : 0u; xp.z = (KEEP_) ? xp.z : 0u; xp.w = (KEEP_) ? xp.w : 0u; } \
                const bf16x8 xs = __builtin_bit_cast(bf16x8, xp); \
                a.o0 = MFMA32(__builtin_shufflevector(vlo[2 * f], vhi[2 * f], 0, 1, 2, 3, 4, 5, 6, 7), xs, a.o0); \
                a.o1 = MFMA32(__builtin_shufflevector(vlo[2 * f + 1], vhi[2 * f + 1], 0, 1, 2, 3, 4, 5, 6, 7), xs, a.o1); } } while (0)
            bool selb = true;
            if (MODE == M_BAND || MODE == M_SLC) {
                const bool far = (P.tq0 - (kv0 + 63) >= 127) && (MODE == M_SLC || (P.tq0 + 31 - kv0 < W));
                if (!far) { const int base = tq - kv0 - 4 * h; float l0v[16], l1v[16];
#pragma unroll
                    for (int i = 0; i < 16; ++i) { int ix = base - cofs(i); ix = ix < 127 ? ix : 127; ix = ix > 0 ? ix : 0; l0v[i] = P.lut[ix]; int iy = base - 32 - cofs(i); iy = iy < 127 ? iy : 127; iy = iy > 0 ? iy : 0; l1v[i] = P.lut[iy]; }
#pragma unroll
                    for (int i = 0; i < 16; ++i) asm volatile("" : "+v"(l0v[i]), "+v"(l1v[i]));
#pragma unroll
                    for (int i = 0; i < 16; ++i) {
                        { const int rel = base - cofs(i); const bool ok = (MODE == M_SLC) ? (rel >= 0) : ((unsigned)rel < (unsigned)W); p0[i] = ok ? p0[i] + l0v[i] : NEGINF; }
                        { const int rel = base - 32 - cofs(i); const bool ok = (MODE == M_SLC) ? (rel >= 0) : ((unsigned)rel < (unsigned)W); p1[i] = ok ? p1[i] + l1v[i] : NEGINF; } }
                }
                if (MODE == M_SLC) selb = ((P.sel >> j) & 1ull) != 0ull;
            } else if (MODE == M_FOX) {
                const bool full = (kv0 + 63 <= P.tq0);
                if (!full) { const int base = tq - kv0 - 4 * h;
#pragma unroll
                    for (int i = 0; i < 16; ++i) { const int rel = base - cofs(i); p0[i] = (rel >= 0) ? p0[i] : NEGINF; p1[i] = (rel - 32 >= 0) ? p1[i] : NEGINF; } }
            } else {
                const int base = tq - 31 - 16 * (64 * j + 4 * h); float l0v[16], l1v[16];
#pragma unroll
                for (int i = 0; i < 16; ++i) { int ix = base - 16 * cofs(i); ix = ix < 127 ? ix : 127; ix = ix > 0 ? ix : 0; l0v[i] = P.lut[ix]; int iy = base - 512 - 16 * cofs(i); iy = iy < 127 ? iy : 127; iy = iy > 0 ? iy : 0; l1v[i] = P.lut[iy]; }
#pragma unroll
                for (int i = 0; i < 16; ++i) asm volatile("" : "+v"(l0v[i]), "+v"(l1v[i]));
#pragma unroll
                for (int i = 0; i < 16; ++i) { p0[i] = (base - 16 * cofs(i) >= 0) ? p0[i] + l0v[i] : NEGINF; p1[i] = (base - 512 - 16 * cofs(i) >= 0) ? p1[i] + l1v[i] : NEGINF; }
            }
            if (MODE != M_CMP2) {
                float ta = __builtin_fmaxf(__builtin_fmaxf(p0[0], p0[1]), p1[0]), tb = __builtin_fmaxf(__builtin_fmaxf(p0[2], p0[3]), p1[1]);
                ta = __builtin_fmaxf(__builtin_fmaxf(ta, p1[2]), p1[3]);
#pragma unroll
                for (int i = 4; i < 16; i += 4) { ta = __builtin_fmaxf(__builtin_fmaxf(ta, p0[i]), p0[i + 1]); tb = __builtin_fmaxf(__builtin_fmaxf(tb, p0[i + 2]), p0[i + 3]);
                    ta = __builtin_fmaxf(__builtin_fmaxf(ta, p1[i]), p1[i + 1]); tb = __builtin_fmaxf(__builtin_fmaxf(tb, p1[i + 2]), p1[i + 3]); }
                float tm = __builtin_fmaxf(ta, tb);
                tm = __builtin_fmaxf(tm, __shfl_xor(tm, 32));
                if (MODE == M_SLC) tm = selb ? tm : NEGINF;
                if (__any(tm > a.m + 8.f)) {
                    const float mn = __builtin_fmaxf(a.m, tm); const float alpha = fast_exp2(a.m - mn); a.m = mn; a.l *= alpha;
                    if (MODE != M_CMP1) {
#pragma unroll
                        for (int i = 0; i < 16; ++i) { a.o0[i] *= alpha; a.o1[i] *= alpha; } } }
                const float mref = a.m; float s0 = 0.f, s1 = 0.f;
#pragma unroll
                for (int i = 0; i < 16; ++i) { p0[i] = fast_exp2(p0[i] - mref); p1[i] = fast_exp2(p1[i] - mref); s0 += p0[i]; s1 += p1[i]; }
                const float st = s0 + s1;
                a.l += (MODE == M_SLC) ? (selb ? st : 0.f) : st;
                if (MODE != M_CMP1) ATT_PV(p0, p1, selb);
            } else {
#pragma unroll
                for (int i = 0; i < 16; ++i) { p0[i] = fast_exp2(p0[i] - P.fm) * P.frl; p1[i] = fast_exp2(p1[i] - P.fm) * P.frl; }
                float a8[8], b8[8];
#pragma unroll
                for (int k = 0; k < 4; ++k) { a8[k] = p0[4 * k] + p0[4 * k + 1] + p0[4 * k + 2] + 0.5f * p0[4 * k + 3]; b8[k] = 0.5f * p0[4 * k + 3];
                    a8[4 + k] = p1[4 * k] + p1[4 * k + 1] + p1[4 * k + 2] + 0.5f * p1[4 * k + 3]; b8[4 + k] = 0.5f * p1[4 * k + 3]; }
                float bs[8];
#pragma unroll
                for (int k = 0; k < 8; ++k) bs[k] = __shfl_xor(b8[k], 32);
#pragma unroll
                for (int k = 0; k < 8; ++k) { const float prev = (k == 0) ? carry : bs[k > 0 ? k - 1 : 0]; P.imp[16 * j + 2 * k + h] = a8[k] + (h ? bs[k] : prev); }
                carry = bs[7];
                ATT_PV(p0, p1, true);
            }
        } else if (MODE == M_CMP2) {
            if (h == 0) P.imp[16 * j] = carry;
            carry = 0.f;
        }
        if (MODE == M_FOX) {
            const int slot = it % 3, nslot = (it + 1) % 3;
            if (more) { const int jn = j + P.step;
                if (!wdone) { const float bound = P.qn * *(LAS float*)(lds + A_KM + 4 * jn) * 1.001f + *(LAS float*)(lds + A_KM + 256 + 4 * jn);
                    const bool need = (bound >= a.m - 40.f);
                    if (__any(need)) { if (lane == 0) *(LAS unsigned*)(lds + A_NEED + 4 * slot) = 1u; } else wdone = true; } }
            if (tid == 0) *(LAS unsigned*)(lds + A_NEED + 4 * nslot) = 0u;
            if (more2) asm volatile("s_waitcnt vmcnt(3) lgkmcnt(0)\n\ts_barrier" ::: "memory"); else asm volatile("s_waitcnt vmcnt(0) lgkmcnt(0)\n\ts_barrier" ::: "memory");
            if (more && *(LAS unsigned*)(lds + A_NEED + 4 * slot) == 0u) { asm volatile("s_waitcnt vmcnt(0)" ::: "memory"); break; }
        } else {
            if (more2) asm volatile("s_waitcnt vmcnt(2) lgkmcnt(0)\n\ts_barrier" ::: "memory"); else asm volatile("s_waitcnt vmcnt(0) lgkmcnt(0)\n\ts_barrier" ::: "memory");
        }
        sl = (sl == 2) ? 0 : sl + 1;
    }
#undef ATT_DMA
#undef ATT_PV
}
DI void acc_init(Acc& a, float m0, float l0) {
#pragma unroll
    for (int i = 0; i < 16; ++i) { a.o0[i] = 0.f; a.o1[i] = 0.f; }
    a.m = m0; a.l = l0;
}
DI void load_q(bf16x8 (&qr)[4], const bf16_t* Qrow  , int lane) {
    const bf16_t* p = Qrow + (size_t)(lane & 31) * QKV_N + 8 * (lane >> 5);
#pragma unroll
    for (int s = 0; s < 4; ++s) qr[s] = *(const GAS bf16x8*)(p + 16 * s);
}
DI void store_ot(bf16_t* O, const f32x16& y0, const f32x16& y1, float sc, int lane) {
    bf16_t* rowp = O + (size_t)(lane & 31) * DM + 4 * (lane >> 5);
#pragma unroll
    for (int g = 0; g < 4; ++g) {
        u32x2 a; a.x = cvtpk(y0[4 * g] * sc, y0[4 * g + 1] * sc); a.y = cvtpk(y0[4 * g + 2] * sc, y0[4 * g + 3] * sc); *(u32x2*)(rowp + 8 * g) = a;
        u32x2 b; b.x = cvtpk(y1[4 * g] * sc, y1[4 * g + 1] * sc); b.y = cvtpk(y1[4 * g + 2] * sc, y1[4 * g + 3] * sc); *(u32x2*)(rowp + 32 + 8 * g) = b; }
}
}

#ifndef PH_MASK
#define PH_MASK 0xFFFF
#endif
#define PH(k) ((PH_MASK >> (k)) & 1)
#ifndef REP_PHASE
#define REP_PHASE -1
#endif
#ifndef REP_N
#define REP_N 1
#endif
#define NREP(k) (((k) == REP_PHASE) ? REP_N : 1)
struct Args { const float* in[25]; float* out; unsigned char* ws; };

template <int CTRL> DI float dppf(float v) { return __uint_as_float((unsigned)__builtin_amdgcn_update_dpp(0, (int)__float_as_uint(v), CTRL, 0xf, 0xf, false)); }
DI float wave_max_u(float v) {
    v = fmaxf(v, dppf<0xB1>(v)); v = fmaxf(v, dppf<0x4E>(v)); v = fmaxf(v, dppf<0x141>(v)); v = fmaxf(v, dppf<0x140>(v));
    const float r0 = __uint_as_float(__builtin_amdgcn_readlane(__float_as_uint(v), 0)), r1 = __uint_as_float(__builtin_amdgcn_readlane(__float_as_uint(v), 16)),
                r2 = __uint_as_float(__builtin_amdgcn_readlane(__float_as_uint(v), 32)), r3 = __uint_as_float(__builtin_amdgcn_readlane(__float_as_uint(v), 48));
    return fmaxf(fmaxf(r0, r1), fmaxf(r2, r3));
}
DI float wave_sum(float v) {
#pragma unroll
    for (int o = 1; o < 64; o <<= 1) v += __shfl_xor(v, o);
    return v;
}
DI unsigned f2bf(float f) { unsigned u = __builtin_bit_cast(unsigned, f); return (u + 0x7fffu + ((u >> 16) & 1u)) >> 16; }
DI unsigned pk2(float lo, float hi) { return f2bf(lo) | (f2bf(hi) << 16); }

enum { MAP_ID = 0, MAP_WIN = 1, MAP_GU_G = 2, MAP_GU_U = 3 };
DI int map_row(int kind, int c) {
    if (kind == MAP_WIN) { if (c < 1280) return c; if (c < 1292) return C_SM + (c - 1280); if (c < 2444) return c - 12; return c; }
    if (kind == MAP_GU_G) return (c >> 7) * 256 + (c & 127);
    if (kind == MAP_GU_U) return (c >> 7) * 256 + 128 + (c & 127);
    return c;
}
DI void cvt_item(const float* W, int K, int N, bf16_t* WT, int kind, int row_off, LAS float* scr, int item, int lane) {
    const int nblk = (N + 31) / 32, kb = item / nblk, nb = item % nblk, k0 = 64 * kb, n0 = 32 * nb;
    const int cn = n0 + (lane & 31); const bool cok = cn < N;
    float vv[32];
#pragma unroll
    for (int i = 0; i < 32; ++i) { const int kk = 2 * i + (lane >> 5); vv[i] = cok ? __builtin_nontemporal_load(W + (size_t)(k0 + kk) * N + cn) : 0.f; }
#pragma unroll
    for (int i = 0; i < 32; ++i) { const int kk = 2 * i + (lane >> 5); scr[kk * 33 + (lane & 31)] = vv[i]; }
    asm volatile("s_waitcnt lgkmcnt(0)" ::: "memory");
    const int c = lane & 7;
#pragma unroll
    for (int j = 0; j < 4; ++j) { const int n = (lane >> 3) + 8 * j; const LAS float* s = scr + (8 * c) * 33 + n;
        u32x4 o; o.x = pk2(s[0 * 33], s[1 * 33]); o.y = pk2(s[2 * 33], s[3 * 33]); o.z = pk2(s[4 * 33], s[5 * 33]); o.w = pk2(s[6 * 33], s[7 * 33]);
        if (n0 + n < N) *(u32x4*)(WT + (size_t)(row_off + map_row(kind, n0 + n)) * K + k0 + 8 * c) = o; }
    asm volatile("s_waitcnt lgkmcnt(0)" ::: "memory");
}

DI unsigned long long ldp(volatile LAS unsigned long long* PT, int k) { int ko = k; asm volatile("" : "+v"(ko)); const unsigned long long v = PT[ko];
    const unsigned lo = __builtin_amdgcn_readfirstlane((unsigned)v), hi = __builtin_amdgcn_readfirstlane((unsigned)(v >> 32)); return ((unsigned long long)hi << 32) | lo; }
#define INP(k) ((const float*)ldp(PT, (k)))
#define WSP(off) ((unsigned char*)ldp(PT, 26) + (off))
#define OUTP ((float*)ldp(PT, 25))

__global__ void __launch_bounds__(512, 2) mega_fwd(Args args) {
    extern __shared__ __attribute__((aligned(16))) unsigned char lds_raw[];
    LAS unsigned char* lds = (LAS unsigned char*)lds_raw;
    volatile LAS unsigned* MISC = (volatile LAS unsigned*)(lds + L_MISC);
    LAS float* LUT = (LAS float*)(lds + L_LUT);
    LAS int* TP = (LAS int*)(lds + L_TP);
    LAS int* CNTL = (LAS int*)(lds + L_CNT);
    LAS int* TPX = (LAS int*)(lds + L_TPX);
    const int wid0 = __builtin_amdgcn_readfirstlane((int)threadIdx.x >> 6);
#define LAUNDER_TID int lane; asm volatile("v_mbcnt_lo_u32_b32 %0, -1, 0\n\tv_mbcnt_hi_u32_b32 %0, -1, %0" : "=v"(lane)); int wid = wid0; asm volatile("" : "+s"(wid)); const int tid = wid * 64 + lane; (void)tid;
    const int G = gridDim.x, bx = blockIdx.x;
    volatile LAS unsigned long long* PT = (volatile LAS unsigned long long*)(lds + L_PT);
    { LAUNDER_TID
    if (tid == 0) {
        PT[0] = (unsigned long long)args.in[0]; PT[1] = (unsigned long long)args.in[1]; PT[2] = (unsigned long long)args.in[2]; PT[3] = (unsigned long long)args.in[3];
        PT[4] = (unsigned long long)args.in[4]; PT[5] = (unsigned long long)args.in[5]; PT[6] = (unsigned long long)args.in[6]; PT[7] = (unsigned long long)args.in[7];
        PT[8] = (unsigned long long)args.in[8]; PT[9] = (unsigned long long)args.in[9]; PT[10] = (unsigned long long)args.in[10]; PT[11] = (unsigned long long)args.in[11];
        PT[12] = (unsigned long long)args.in[12]; PT[13] = (unsigned long long)args.in[13]; PT[14] = (unsigned long long)args.in[14]; PT[15] = (unsigned long long)args.in[15];
        PT[16] = (unsigned long long)args.in[16]; PT[17] = (unsigned long long)args.in[17]; PT[18] = (unsigned long long)args.in[18]; PT[19] = (unsigned long long)args.in[19];
        PT[20] = (unsigned long long)args.in[20]; PT[21] = (unsigned long long)args.in[21]; PT[22] = (unsigned long long)args.in[22]; PT[23] = (unsigned long long)args.in[23];
        PT[24] = (unsigned long long)args.in[24]; PT[25] = (unsigned long long)args.out; PT[26] = (unsigned long long)args.ws;
    }
    for (int u = tid; u < 64; u += 512) MISC[u] = 0u;
    for (int u = tid; u < 1280; u += 512) { const int hh = u >> 7, rel = u & 127; int bk = rel;
        if (rel >= 16) { bk = 16; const int th[15] = {19, 21, 24, 27, 31, 35, 40, 46, 52, 59, 67, 77, 87, 99, 113};
#pragma unroll
            for (int q = 0; q < 15; ++q) bk += (rel >= th[q]) ? 1 : 0; }
        LUT[u] = (args.in[10][bk * 10 + hh] - args.in[10][31 * 10 + hh]) * LOG2E; }
    }
    __syncthreads();
    XcdBarrier bar = xcd_barrier_post((unsigned*)WSP(WS_CTL) + CW_BAR, MISC);
#define GRID_BAR() do { XcdBarrier b2_ = bar; b2_.bar = (unsigned*)WSP(WS_CTL) + CW_BAR; asm volatile("" : "+s"(b2_.x)); int ln_; asm volatile("v_mbcnt_lo_u32_b32 %0, -1, 0\n\tv_mbcnt_hi_u32_b32 %0, -1, %0" : "=v"(ln_)); xcd_barrier(b2_, (wid0 == 0) && (ln_ == 0)); } while (0)
#define QNEXT(ctr, dstvar) do { if (tid == 0) MISC[8] = atomicAdd((ctr), 1u); __syncthreads(); dstvar = (int)__builtin_amdgcn_readfirstlane(MISC[8]); __syncthreads(); } while (0)

    for (int rep = 0; rep < NREP(0); ++rep) if (PH(0)) { LAUNDER_TID
            float* ADA = (float*)WSP(WS_ADA); float* CPOS = (float*)WSP(WS_CPOS); bf16_t* WIN = (bf16_t*)WSP(WS_WIN); bf16_t* WO = (bf16_t*)WSP(WS_WO); bf16_t* WSH = (bf16_t*)WSP(WS_WSH); bf16_t* WSD = (bf16_t*)WSP(WS_WSD); bf16_t* WCT = (bf16_t*)WSP(WS_WCT); bf16_t* WGU = (bf16_t*)WSP(WS_WGU); bf16_t* WD = (bf16_t*)WSP(WS_WD);
        if (bx < 192) {
            LAS float* cond = (LAS float*)lds;
            LAS float* red = (LAS float*)(lds + 32768);
            for (int u = tid; u < 8192; u += 512) cond[u] = siluf_(INP(1)[u]);
            __syncthreads();
            const int l = bx / 96, j0 = (bx % 96) * 64;
            const float* wa = INP(11) + (size_t)l * DM * 6144 + j0 + lane;
            float accb[8];
#pragma unroll
            for (int b = 0; b < 8; ++b) accb[b] = 0.f;
#pragma unroll 8
            for (int kk = 0; kk < 128; ++kk) { const int k = wid * 128 + kk; const float w = wa[(size_t)k * 6144];
#pragma unroll
                for (int b = 0; b < 8; ++b) accb[b] += cond[b * 1024 + k] * w; }
#pragma unroll
            for (int b = 0; b < 8; ++b) red[(wid * 8 + b) * 64 + lane] = accb[b];
            __syncthreads();
            { const int b = tid >> 6; float s = INP(12)[l * 6144 + j0 + lane];
#pragma unroll
                for (int w = 0; w < 8; ++w) s += red[(w * 8 + b) * 64 + lane];
                ADA[((size_t)l * 8 + b) * 6144 + j0 + lane] = s; }
            __syncthreads();
        } else if (bx < 196) {
            const int l = (bx - 192) >> 1, which = (bx - 192) & 1;
            const float* pos = INP(which ? 7 : 5) + (size_t)l * 2048 + wid * 256; const float* w = INP(which ? 8 : 6) + (size_t)l * 2048 * 64 + (size_t)wid * 256 * 64;
            LAS float* red = (LAS float*)lds;
            float s = 0.f;
#pragma unroll 16
            for (int k = 0; k < 256; ++k) s += pos[k] * w[(size_t)k * 64 + lane];
            red[wid * 64 + lane] = s;
            __syncthreads();
            if (wid == 0) { float t = 0.f;
#pragma unroll
                for (int w8 = 0; w8 < 8; ++w8) t += red[w8 * 64 + lane];
                CPOS[(l * 2 + which) * 64 + lane] = t; }
            __syncthreads();
        }
        { const int gt = bx * 512 + tid; const int per = (QKV_N - D_IN) * DM / 8;
            for (int u = gt; u < 2 * per; u += G * 512) { const int l = u / per, r = u % per; *(u32x4*)(WIN + ((size_t)l * QKV_N + D_IN) * DM + (size_t)r * 8) = (u32x4){0u, 0u, 0u, 0u}; } }
        LAS float* scr = (LAS float*)(lds + wid * 16384);
        const int gw = bx * 8 + wid, NGW = G * 8;
        constexpr int I_SMALL = 2384, I_EXP = 384;
        const int NITEMS = DEPTH * I_SMALL + DEPTH * NEXP * I_EXP;
        for (int it = gw; it < NITEMS; it += NGW) {
            if (it < DEPTH * I_SMALL) { const int l = it / I_SMALL; int r = it % I_SMALL;
                if (r < 1232) { cvt_item(INP(2) + (size_t)l * DM * D_IN, DM, D_IN, WIN + (size_t)l * QKV_N * DM, MAP_WIN, 0, scr, r, lane); continue; } r -= 1232;
                if (r < 512) { cvt_item(INP(3) + (size_t)l * DM * DM, DM, DM, WO + (size_t)l * DM * DM, MAP_ID, 0, scr, r, lane); continue; } r -= 512;
                if (r < 128) { cvt_item(INP(17) + (size_t)l * DM * 256, DM, 256, WSH + (size_t)l * 768 * DM, MAP_ID, 0, scr, r, lane); continue; } r -= 128;
                if (r < 128) { cvt_item(INP(22) + (size_t)l * DM * 256, DM, 256, WSH + (size_t)l * 768 * DM, MAP_GU_G, 256, scr, r, lane); continue; } r -= 128;
                if (r < 128) { cvt_item(INP(23) + (size_t)l * DM * 256, DM, 256, WSH + (size_t)l * 768 * DM, MAP_GU_U, 256, scr, r, lane); continue; } r -= 128;
                if (r < 128) { cvt_item(INP(24) + (size_t)l * 256 * DM, 256, DM, WSD + (size_t)l * DM * 256, MAP_ID, 0, scr, r, lane); continue; } r -= 128;
                if (r < 64) { cvt_item(INP(6) + (size_t)l * 2048 * 64, 2048, 64, WCT + (size_t)(l * 2 + 0) * 64 * 2048, MAP_ID, 0, scr, r, lane); continue; } r -= 64;
                cvt_item(INP(8) + (size_t)l * 2048 * 64, 2048, 64, WCT + (size_t)(l * 2 + 1) * 64 * 2048, MAP_ID, 0, scr, r, lane);
            } else { const int r0 = it - DEPTH * I_SMALL; const int le = r0 / I_EXP, r = r0 % I_EXP;
                if (r < 128) cvt_item(INP(19) + (size_t)le * DM * EDIM, DM, EDIM, WGU + (size_t)le * 512 * DM, MAP_GU_G, 0, scr, r, lane);
                else if (r < 256) cvt_item(INP(20) + (size_t)le * DM * EDIM, DM, EDIM, WGU + (size_t)le * 512 * DM, MAP_GU_U, 0, scr, r - 128, lane);
                else cvt_item(INP(21) + (size_t)le * EDIM * DM, EDIM, DM, WD + (size_t)le * DM * EDIM, MAP_ID, 0, scr, r - 256, lane);
            }
        }
    }
    GRID_BAR();
    if (PH(1)) { LAUNDER_TID
            float* ADA = (float*)WSP(WS_ADA); bf16_t* H = (bf16_t*)WSP(WS_H);
        const int gw = bx * 8 + wid, NGW = G * 8;
        for (int m = gw; m < NTOK; m += NGW) { const int b = m >> 12; const float* ad = ADA + (size_t)b * 6144;
            const f32x4* xr = (const f32x4*)(INP(0) + (size_t)m * DM) + lane; unsigned long long* o8 = (unsigned long long*)(H + (size_t)m * DM) + lane;
#pragma unroll
            for (int j = 0; j < 4; ++j) { const f32x4 v = xr[64 * j]; const f32x4 sh = *((const f32x4*)(ad) + 64 * j + lane), sc = *((const f32x4*)(ad + 1024) + 64 * j + lane);
                const f32x4 hv = v * (sc + 1.f) + sh; o8[64 * j] = (unsigned long long)cvtpk(hv[0], hv[1]) | ((unsigned long long)cvtpk(hv[2], hv[3]) << 32); } }
    }
    GRID_BAR();

    for (int l = 0; l < DEPTH; ++l) {
        for (int rep = 0; rep < NREP(2); ++rep) if (PH(2)) { LAUNDER_TID
            bf16_t* H = (bf16_t*)WSP(WS_H); bf16_t* WIN = (bf16_t*)WSP(WS_WIN); bf16_t* QKV = (bf16_t*)WSP(WS_QKV); float* SMALL = (float*)WSP(WS_SMALL);
            pg8::Gemm g{H, WIN + (size_t)l * QKV_N * DM, DM}; pg8::StaticOrder S; S.init(NTOK, QKV_N, G, bx);
            pg8::EpiQKV E{QKV, SMALL};
            pg8::gemm_phase<pg8::EpiQKV, pg8::StaticOrder>(lds, g, S, E, wid);
        }
        GRID_BAR();
        for (int rep = 0; rep < NREP(3); ++rep) if (PH(3)) { LAUNDER_TID
            unsigned* ctl = (unsigned*)WSP(WS_CTL); bf16_t* QKV = (bf16_t*)WSP(WS_QKV); bf16_t* WCT = (bf16_t*)WSP(WS_WCT); float* CPOS = (float*)WSP(WS_CPOS); bf16_t* KCMP = (bf16_t*)WSP(WS_KCMP); bf16_t* VCMP = (bf16_t*)WSP(WS_VCMP); float* SMALL = (float*)WSP(WS_SMALL); float* DC = (float*)WSP(WS_DC); bf16_t* OB = (bf16_t*)WSP(WS_O); float* KMW = (float*)WSP(WS_KM);
            unsigned* qctr = ctl + CW_Q + 64 * (l * 4 + 0 + 8 * rep);
            for (;;) {
                int u; QNEXT(qctr, u);
                if (u >= 128 + 48 + 768) break;
                if (u < 128) {
                    const int b = u >> 4, which = (u >> 3) & 1, cblk = (u >> 2) & 1, nblk = 2 * (u & 3) + (wid >> 2), kc = wid & 3, r = lane & 31, h = lane >> 5;
                    int n = 32 * nblk + r; n = n < 254 ? n : 254;
                    const bf16_t* arow = QKV + ((size_t)b * SEQ + 16 * n + 8 * kc) * QKV_N + (which ? C_BVC : C_BKC) + 8 * h;
                    const bf16_t* brow = WCT + ((size_t)(l * 2 + which) * 64 + 32 * cblk + r) * 2048 + 512 * kc + 8 * h;
                    f32x16 acc;
#pragma unroll
                    for (int i = 0; i < 16; ++i) acc[i] = 0.f;
#pragma unroll 8
                    for (int s = 0; s < 32; ++s) { const int k = 16 * s; const bf16x8 af = *(const GAS bf16x8*)(arow + (size_t)(k >> 6) * QKV_N + (k & 63)); const bf16x8 bf = *(const GAS bf16x8*)(brow + k);
                        acc = MFMA32(af, bf, acc); }
                    LAS float* red = (LAS float*)lds;
                    if (kc) {
#pragma unroll
                        for (int i = 0; i < 16; ++i) red[(wid * 16 + i) * 64 + lane] = acc[i]; }
                    __syncthreads();
                    if (kc == 0) {
                        const float cp = CPOS[(l * 2 + which) * 64 + 32 * cblk + r]; bf16_t* dst = (which ? VCMP : KCMP) + (size_t)b * 256 * 64 + 32 * cblk + r;
#pragma unroll
                        for (int i = 0; i < 16; ++i) { const float t = acc[i] + red[((wid + 1) * 16 + i) * 64 + lane] + red[((wid + 2) * 16 + i) * 64 + lane] + red[((wid + 3) * 16 + i) * 64 + lane];
                            const int nn = 32 * nblk + (i & 3) + 8 * (i >> 2) + 4 * h; dst[(size_t)nn * 64] = (bf16_t)(nn < 255 ? f2bf(t + cp) : 0u); } }
                    __syncthreads();
                } else if (u < 176) {
                    const int b = (u - 128) / 6, hh = (u - 128) % 6; const float fb = INP(9)[l * 6 + hh];
                    LAS float* wsum = (LAS float*)lds;
                    float v[8]; float run = 0.f;
#pragma unroll
                    for (int i = 0; i < 8; ++i) { const float x = SMALL[((size_t)b * SEQ + 8 * tid + i) * 32 + 12 + hh] + fb; const float lf = fminf(x, 0.f) - log1pf(__expf(-fabsf(x))); run += lf; v[i] = run; }
                    float incl = run;
#pragma unroll
                    for (int o = 1; o < 64; o <<= 1) { const float t = __shfl_up(incl, o); if (lane >= o) incl += t; }
                    if (lane == 63) wsum[wid] = incl;
                    __syncthreads();
                    float base = incl - run;
                    for (int w = 0; w < wid; ++w) base += wsum[w];
                    float* dst = DC + ((size_t)b * 6 + hh) * SEQ + 8 * tid;
#pragma unroll
                    for (int i = 0; i < 8; ++i) dst[i] = -(base + v[i]) * LOG2E;
                    LAS float* tmx = (LAS float*)(lds + 1024);
                    { const bf16_t* kp = QKV + ((size_t)b * SEQ + (tid >> 3)) * QKV_N + C_CK + 64 * hh + 8 * (tid & 7);
#pragma unroll 8
                        for (int T = 0; T < 64; ++T) { const bf16x8 kv = *(const GAS bf16x8*)(kp + (size_t)T * 64 * QKV_N); float ss = 0.f;
#pragma unroll
                            for (int e = 0; e < 8; ++e) { const float x = __uint_as_float(((unsigned)(unsigned short)kv[e]) << 16); ss += x * x; }
                            ss += __shfl_xor(ss, 1); ss += __shfl_xor(ss, 2); ss += __shfl_xor(ss, 4);
                            ss = fmaxf(ss, __shfl_xor(ss, 8)); ss = fmaxf(ss, __shfl_xor(ss, 16)); ss = fmaxf(ss, __shfl_xor(ss, 32));
                            if (lane == 0) tmx[wid * 64 + T] = ss; } }
                    __syncthreads();
                    if (tid < 64) { float mx = tmx[tid];
#pragma unroll
                        for (int w = 1; w < 8; ++w) mx = fmaxf(mx, tmx[w * 64 + tid]);
#pragma unroll
                        for (int o = 1; o < 64; o <<= 1) { const float t = __shfl_up(mx, o); if (lane >= o) mx = fmaxf(mx, t); }
                        KMW[((size_t)b * 6 + hh) * 64 + tid] = sqrtf(mx); }
                    __syncthreads();
                } else {
                    const int ua = u - 176, qt = ua & 15, hq = (ua >> 4) % 6, b = ua / 96, kvh = hq / 3;
                    const size_t tok0 = (size_t)b * SEQ + 256 * qt + 32 * wid;
                    bf16x8 qr[4]; att::load_q(qr, QKV + tok0 * QKV_N + C_AQ + 64 * hq, lane);
                    att::Acc a; att::acc_init(a, (INP(4)[l * 6 + hq] - INP(10)[31 * 10 + hq]) * LOG2E, (lane < 32) ? 1.f : 0.f);
                    att::PassArgs P; P.Kg = QKV + (size_t)b * SEQ * QKV_N + C_AK + 64 * kvh; P.Vg = QKV + (size_t)b * SEQ * QKV_N + C_AV + 64 * kvh; P.pitch = QKV_N;
                    P.jfirst = (4 * qt - 2) > 0 ? (4 * qt - 2) : 0; P.ntiles = 4 * qt + 3 - P.jfirst + 1; P.step = 1; P.tq0 = 256 * qt + 32 * wid;
                    P.lut = LUT + 128 * hq; P.sel = 0ull; P.dq = 0.f; P.dkg = nullptr; P.fm = 0.f; P.frl = 0.f; P.imp = nullptr; P.qn = 0.f; P.km = nullptr;
                    att::attn_pass<att::M_BAND, 128>((LAS char*)lds, P, qr, a, tid, lane);
                    const float lt = a.l + __shfl_xor(a.l, 32);
                    att::store_ot(OB + tok0 * DM + O_A + 64 * hq, a.o0, a.o1, 1.f / lt, lane);
                }
            }
        }
        GRID_BAR();
        for (int rep = 0; rep < NREP(4); ++rep) if (PH(4)) { LAUNDER_TID
            unsigned* ctl = (unsigned*)WSP(WS_CTL); bf16_t* QKV = (bf16_t*)WSP(WS_QKV); float* DC = (float*)WSP(WS_DC); bf16_t* KCMP = (bf16_t*)WSP(WS_KCMP); bf16_t* VCMP = (bf16_t*)WSP(WS_VCMP); float* SMALL = (float*)WSP(WS_SMALL); bf16_t* OB = (bf16_t*)WSP(WS_O); const float* KM = (const float*)WSP(WS_KM);
            unsigned* qctr = ctl + CW_Q + 64 * (l * 4 + 1 + 8 * rep);
            for (;;) {
                int u; QNEXT(qctr, u);
                if (u >= 1280) break;
                const int grp = u / 80, rr = u % 80, L = 15 - grp;
                if (rr < 48) { if (PH(14)) {
                    const int b = rr / 6, hh = rr % 6, qt = L;
                    const size_t tok0 = (size_t)b * SEQ + 256 * qt + 32 * wid;
                    bf16x8 qr[4]; att::load_q(qr, QKV + tok0 * QKV_N + C_CQ + 64 * hh, lane);
                    att::Acc a; att::acc_init(a, -1e30f, 0.f);
                    att::PassArgs P; P.Kg = QKV + (size_t)b * SEQ * QKV_N + C_CK + 64 * hh; P.Vg = QKV + (size_t)b * SEQ * QKV_N + C_CV + 64 * hh; P.pitch = QKV_N;
                    P.jfirst = 4 * qt + 3; P.ntiles = 4 * qt + 4; P.step = -1; P.tq0 = 256 * qt + 32 * wid;
                    P.lut = LUT; P.sel = 0ull; P.dkg = DC + ((size_t)b * 6 + hh) * SEQ; P.dq = 0.f; P.fm = 0.f; P.frl = 0.f; P.imp = nullptr;
                    { float qs = 0.f;
#pragma unroll
                        for (int s4 = 0; s4 < 4; ++s4)
#pragma unroll
                            for (int e = 0; e < 8; ++e) { const float qv = __uint_as_float(((unsigned)(unsigned short)qr[s4][e]) << 16); qs += qv * qv; }
                        qs += __shfl_xor(qs, 32); P.qn = sqrtf(qs); P.km = KM + ((size_t)b * 6 + hh) * 64; }
                    att::attn_pass<att::M_FOX, 0>((LAS char*)lds, P, qr, a, tid, lane);
                    const float lt = a.l + __shfl_xor(a.l, 32);
                    att::store_ot(OB + tok0 * DM + O_C + 64 * hh, a.o0, a.o1, 1.f / lt, lane);
                } } else if (PH(15)) {
                    const int r2 = rr - 48, qt = 4 * L + 3 - (r2 >> 3), b = r2 & 7, head = wid >> 1, qh = wid & 1;
                    const size_t tok0 = (size_t)b * SEQ + 64 * qt + 32 * qh; const int tq0 = 64 * qt + 32 * qh;
                    const int r = lane & 31, h = lane >> 5;
                    LAS float* IMP = (LAS float*)(lds + att::A_IMP);
                    LAS unsigned long long* SELM = (LAS unsigned long long*)(lds + att::A_SEL);
                    for (int q = tid; q < 4 * 64 * 65; q += 512) IMP[q] = 0.f;
                    bf16x8 qr[4]; att::load_q(qr, QKV + tok0 * QKV_N + C_BQ + 64 * head, lane);
                    const float* gl = SMALL + (tok0 + r) * 32 + head;
                    const float g0 = sigmoidf_(gl[0]), g1 = sigmoidf_(gl[4]), g2 = sigmoidf_(gl[8]);
                    att::PassArgs P; P.pitch = 64; P.Kg = KCMP + (size_t)b * 256 * 64; P.Vg = VCMP + (size_t)b * 256 * 64;
                    P.jfirst = 0; P.ntiles = (qt >> 4) + 1; P.step = 1; P.tq0 = tq0; P.lut = LUT + 128 * (6 + head); P.sel = 0ull; P.dq = 0.f; P.dkg = nullptr; P.qn = 0.f; P.km = nullptr;
                    P.fm = 0.f; P.frl = 0.f; P.imp = IMP + (head * 64 + 32 * qh + r) * 65;
                    att::Acc a; att::acc_init(a, -1e30f, 0.f);
                    att::attn_pass<att::M_CMP1, 0>((LAS char*)lds, P, qr, a, tid, lane);
                    { const float lt = a.l + __shfl_xor(a.l, 32); P.fm = a.m; P.frl = lt > 0.f ? 1.f / lt : 0.f; }
                    att::acc_init(a, 0.f, 0.f);
                    att::attn_pass<att::M_CMP2, 0>((LAS char*)lds, P, qr, a, tid, lane);
#pragma unroll
                    for (int i = 0; i < 16; ++i) { a.o0[i] *= g0; a.o1[i] *= g0; }
                    for (int qi = 0; qi < 8; ++qi) { const int q = 8 * wid + qi;
                        float v = IMP[(0 * 64 + q) * 65 + lane] + IMP[(1 * 64 + q) * 65 + lane] + IMP[(2 * 64 + q) * 65 + lane] + IMP[(3 * 64 + q) * 65 + lane];
                        if (lane == 0 || lane == qt || lane == qt - 1) v = 1e4f; else if (lane > qt) v = -1.f;
                        int rank = 0;
#pragma unroll
                        for (int jj = 0; jj < 64; ++jj) { const float vj = __uint_as_float(__builtin_amdgcn_readlane(__float_as_uint(v), jj)); rank += ((vj > v) || (vj == v && jj < lane)) ? 1 : 0; }
                        const unsigned long long mk = __ballot(rank < 16);
                        if (lane == 0) SELM[q] = mk; }
                    __syncthreads();
                    P.sel = SELM[32 * qh + r];
                    LAS float* FR = IMP + tid;
#pragma unroll
                    for (int i = 0; i < 16; ++i) { FR[512 * i] = a.o0[i]; FR[512 * (16 + i)] = a.o1[i]; }
                    P.pitch = QKV_N; P.Kg = QKV + (size_t)b * SEQ * QKV_N + C_BKS; P.Vg = QKV + (size_t)b * SEQ * QKV_N + C_BVS; P.jfirst = 0; P.ntiles = qt + 1; P.step = 1;
                    att::acc_init(a, -1e30f, 0.f);
                    att::attn_pass<att::M_SLC, 0>((LAS char*)lds, P, qr, a, tid, lane);
                    { const float lt = a.l + __shfl_xor(a.l, 32); const float sc = g1 / lt;
#pragma unroll
                        for (int i = 0; i < 16; ++i) { FR[512 * i] += sc * a.o0[i]; FR[512 * (16 + i)] += sc * a.o1[i]; } }
                    P.Kg = QKV + (size_t)b * SEQ * QKV_N + C_BKW; P.Vg = QKV + (size_t)b * SEQ * QKV_N + C_BVW; P.jfirst = (qt - 8) > 0 ? (qt - 8) : 0; P.ntiles = qt - P.jfirst + 1;
                    att::acc_init(a, -1e30f, 0.f);
                    att::attn_pass<att::M_BAND, 512>((LAS char*)lds, P, qr, a, tid, lane);
                    { const float lt = a.l + __shfl_xor(a.l, 32); const float sc = g2 / lt;
#pragma unroll
                        for (int i = 0; i < 16; ++i) { a.o0[i] = FR[512 * i] + sc * a.o0[i]; a.o1[i] = FR[512 * (16 + i)] + sc * a.o1[i]; } }
                    att::store_ot(OB + tok0 * DM + O_B + 64 * head, a.o0, a.o1, 1.f, lane);
                }
            }
        }
        GRID_BAR();
        for (int rep = 0; rep < NREP(5); ++rep) if (PH(5)) { LAUNDER_TID
            bf16_t* OB = (bf16_t*)WSP(WS_O); bf16_t* WO = (bf16_t*)WSP(WS_WO); const float* xin = (l == 0) ? INP(0) : (const float*)OUTP; float* VB = (float*)WSP(WS_V); const float* ada_l = (const float*)WSP(WS_ADA) + (size_t)l * 8 * 6144;
            pg8::Gemm g{OB, WO + (size_t)l * DM * DM, DM}; pg8::StaticOrder S; S.init(NTOK, DM, G, bx);
            pg8::EpiWO E{xin, VB, ada_l + 2 * 1024};
            pg8::gemm_phase<pg8::EpiWO, pg8::StaticOrder>(lds, g, S, E, wid);
        }
        GRID_BAR();
        for (int rep = 0; rep < NREP(6); ++rep) if (PH(6)) { LAUNDER_TID
            float* VB = (float*)WSP(WS_V); float* X1 = (float*)WSP(WS_X1); bf16_t* H = (bf16_t*)WSP(WS_H); const float* ada_l = (const float*)WSP(WS_ADA) + (size_t)l * 8 * 6144;
            const int gw = bx * 8 + wid, NGW = G * 8; const float* lg = INP(13) + l * DM; const float* lb = INP(14) + l * DM;
            for (int m = 2 * gw; m < NTOK; m += 2 * NGW) { const int b = m >> 12; const float* ad = ada_l + (size_t)b * 6144;
                f32x4 v[2][4]; float s[2] = {0.f, 0.f};
#pragma unroll
                for (int rr = 0; rr < 2; ++rr)
#pragma unroll
                    for (int j = 0; j < 4; ++j) v[rr][j] = *((const GAS f32x4*)(VB + (size_t)(m + rr) * DM) + 64 * j + lane);
#pragma unroll
                for (int rr = 0; rr < 2; ++rr)
#pragma unroll
                    for (int j = 0; j < 4; ++j) s[rr] += (v[rr][j][0] + v[rr][j][1]) + (v[rr][j][2] + v[rr][j][3]);
                const float mean0 = wave_sum(s[0]) * (1.f / DM), mean1 = wave_sum(s[1]) * (1.f / DM); float q[2] = {0.f, 0.f};
#pragma unroll
                for (int rr = 0; rr < 2; ++rr)
#pragma unroll
                    for (int j = 0; j < 4; ++j) { v[rr][j] = v[rr][j] - (rr ? mean1 : mean0); q[rr] += (v[rr][j][0] * v[rr][j][0] + v[rr][j][1] * v[rr][j][1]) + (v[rr][j][2] * v[rr][j][2] + v[rr][j][3] * v[rr][j][3]); }
                const float rstd0 = 1.f / sqrtf(wave_sum(q[0]) * (1.f / DM) + LN_EPS), rstd1 = 1.f / sqrtf(wave_sum(q[1]) * (1.f / DM) + LN_EPS);
#pragma unroll
                for (int j = 0; j < 4; ++j) { const f32x4 gg = *((const f32x4*)lg + 64 * j + lane), bb = *((const f32x4*)lb + 64 * j + lane);
                    const f32x4 sh = *((const f32x4*)(ad + 3 * 1024) + 64 * j + lane), sc = *((const f32x4*)(ad + 4 * 1024) + 64 * j + lane) + 1.f;
#pragma unroll
                    for (int rr = 0; rr < 2; ++rr) { const f32x4 x1 = v[rr][j] * (rr ? rstd1 : rstd0) * gg + bb; *((f32x4*)(X1 + (size_t)(m + rr) * DM) + 64 * j + lane) = x1;
                        const f32x4 hv = x1 * sc + sh; *((unsigned long long*)(H + (size_t)(m + rr) * DM) + 64 * j + lane) = (unsigned long long)cvtpk(hv[0], hv[1]) | ((unsigned long long)cvtpk(hv[2], hv[3]) << 32); } } }
        }
        GRID_BAR();
        for (int rep = 0; rep < NREP(7); ++rep) if (PH(7)) { LAUNDER_TID
            bf16_t* H = (bf16_t*)WSP(WS_H); bf16_t* WSH = (bf16_t*)WSP(WS_WSH); float* LOG = (float*)WSP(WS_LOG); bf16_t* ACTSH = (bf16_t*)WSP(WS_ACTSH);
            pg8::Gemm g{H, WSH + (size_t)l * 768 * DM, DM}; pg8::StaticOrder S; S.init(NTOK, 768, G, bx);
            pg8::EpiSH E{LOG, ACTSH};
            pg8::gemm_phase<pg8::EpiSH, pg8::StaticOrder>(lds, g, S, E, wid);
        }
        GRID_BAR();
        if (PH(8)) { LAUNDER_TID
            unsigned* ctl = (unsigned*)WSP(WS_CTL); float* LOG = (float*)WSP(WS_LOG); int* DST = (int*)WSP(WS_DST); float* WL = (float*)WSP(WS_WL);
            unsigned* CNT = ctl + CW_CNT + l * 256;
            LAS int* hist = (LAS int*)lds;
            LAS int* basel = (LAS int*)(lds + 1024);
            LAS int* asg_e = (LAS int*)(lds + 2048);
            LAS int* asg_r = (LAS int*)(lds + 2048 + 4096);
            LAS float* asg_w = (LAS float*)(lds + 2048 + 8192);
            const float* rb = INP(18) + l * 256;
            for (int chunk = bx; chunk < NTOK / 128; chunk += G) {
                for (int u = tid; u < 256; u += 512) hist[u] = 0;
                __syncthreads();
                const f32x4 rbv = *((const f32x4*)rb + lane); const int grp = lane >> 3;
                for (int t0 = 0; t0 < 16; t0 += 4) {
                    float sc[4][4], val[4][4];
#pragma unroll
                    for (int t = 0; t < 4; ++t) { const int n = chunk * 128 + wid * 16 + t0 + t; const f32x4 lg = *((const GAS f32x4*)(LOG + (size_t)n * 256) + lane);
#pragma unroll
                        for (int i = 0; i < 4; ++i) { sc[t][i] = sigmoidf_(lg[i]); val[t][i] = sc[t][i] + rbv[i]; } }
                    float m1[4], m2[4];
#pragma unroll
                    for (int t = 0; t < 4; ++t) { m1[t] = fmaxf(val[t][0], val[t][1]); m2[t] = fminf(val[t][0], val[t][1]);
                        const float a1 = fmaxf(val[t][2], val[t][3]), a2 = fminf(val[t][2], val[t][3]); const float n1 = fmaxf(m1[t], a1), n2 = fmaxf(fminf(m1[t], a1), fmaxf(m2[t], a2)); m1[t] = n1; m2[t] = n2; }
#define RT_MERGE(CTRL) _Pragma("unroll") for (int t = 0; t < 4; ++t) { const float b1 = dppf<CTRL>(m1[t]), b2 = dppf<CTRL>(m2[t]); const float n1 = fmaxf(m1[t], b1), n2 = fmaxf(fminf(m1[t], b1), fmaxf(m2[t], b2)); m1[t] = n1; m2[t] = n2; }
                    RT_MERGE(0xB1) RT_MERGE(0x4E) RT_MERGE(0x141)
#undef RT_MERGE
#pragma unroll
                    for (int t = 0; t < 4; ++t) { const float gs = m1[t] + m2[t]; int grank = 0;
#pragma unroll
                        for (int jg = 0; jg < 8; ++jg) { const float o = __uint_as_float(__builtin_amdgcn_readlane(__float_as_uint(gs), 8 * jg)); grank += ((o > gs) || (o == gs && jg < grp)) ? 1 : 0; }
                        if (grank >= 4) {
#pragma unroll
                            for (int i = 0; i < 4; ++i) val[t][i] = -1e30f; } }
                    float wsum_[4] = {0.f, 0.f, 0.f, 0.f}; int my_e[4] = {0, 0, 0, 0}; float my_s[4] = {0.f, 0.f, 0.f, 0.f};
#pragma unroll
                    for (int k = 0; k < 8; ++k) {
                        float bv[4], mx[4];
#pragma unroll
                        for (int t = 0; t < 4; ++t) { bv[t] = fmaxf(fmaxf(val[t][0], val[t][1]), fmaxf(val[t][2], val[t][3])); mx[t] = bv[t]; }
#pragma unroll
                        for (int t = 0; t < 4; ++t) mx[t] = wave_max_u(bv[t]);
#pragma unroll
                        for (int t = 0; t < 4; ++t) {
                            const unsigned long long ball = __ballot(bv[t] == mx[t]); const int wl = __builtin_amdgcn_readfirstlane((int)__builtin_ctzll(ball));
                            const int li = (val[t][0] == bv[t]) ? 0 : (val[t][1] == bv[t]) ? 1 : (val[t][2] == bv[t]) ? 2 : 3;
                            const float ls = (li == 0) ? sc[t][0] : (li == 1) ? sc[t][1] : (li == 2) ? sc[t][2] : sc[t][3];
                            const int wi = __builtin_amdgcn_readlane(li, wl); const float ws1 = __uint_as_float(__builtin_amdgcn_readlane(__float_as_uint(ls), wl));
                            if (lane == wl) {
#pragma unroll
                                for (int i = 0; i < 4; ++i) if (li == i) val[t][i] = -3e38f; }
                            wsum_[t] += ws1; if (lane == k) { my_e[t] = 4 * wl + wi; my_s[t] = ws1; } }
                    }
#pragma unroll
                    for (int t = 0; t < 4; ++t) { const int tl = wid * 16 + t0 + t;
                        if (lane < 8) { const int rk = __hip_atomic_fetch_add(&hist[my_e[t]], 1, __ATOMIC_RELAXED, __HIP_MEMORY_SCOPE_WORKGROUP); asg_e[tl * 8 + lane] = my_e[t]; asg_r[tl * 8 + lane] = rk; asg_w[tl * 8 + lane] = my_s[t] / wsum_[t] * 2.5f; } }
                }
                __syncthreads();
                if (tid < 256) { const int c = hist[tid]; basel[tid] = c ? (int)atomicAdd(&CNT[tid], (unsigned)c) : 0; }
                __syncthreads();
                for (int u = tid; u < 1024; u += 512) { const int e = asg_e[u]; const int pos = basel[e] + asg_r[u]; DST[(size_t)e * NTOK + pos] = (chunk * 128) * 8 + u; WL[(size_t)e * NTOK + pos] = asg_w[u]; }
                __syncthreads();
            }
        }
        GRID_BAR();
        for (int rep = 0; rep < NREP(9); ++rep) if (PH(9)) { LAUNDER_TID
            unsigned* ctl = (unsigned*)WSP(WS_CTL); bf16_t* H = (bf16_t*)WSP(WS_H); bf16_t* WGU = (bf16_t*)WSP(WS_WGU); int* DST = (int*)WSP(WS_DST); bf16_t* ACT = (bf16_t*)WSP(WS_ACT);
            const unsigned* CNT = ctl + CW_CNT + l * 256;
            if (tid < 256) CNTL[tid] = (int)__hip_atomic_load(CNT + tid, __ATOMIC_RELAXED, __HIP_MEMORY_SCOPE_AGENT);
            __syncthreads();
            if (tid == 0) { int s = 0; for (int e = 0; e < 256; ++e) { TP[e] = s; s += (CNTL[e] + 255) >> 8; } TP[256] = s; }
            if (tid == 64) { int s = 0; const int x = bx & 7; for (int i = 0; i < 32; ++i) { TPX[i] = s; s += (CNTL[8 * i + x] + 255) >> 8; } TPX[32] = s; }
            __syncthreads();
            pg8::Gemm g{H, WGU + (size_t)l * NEXP * 512 * DM, DM};
            pg8::GroupedOrder<true> S{TP, TPX, CNTL, 2, (G - (bx & 7) + 7) >> 3, bx >> 3, bx & 7, DST};
            pg8::EpiGU E{ACT};
            pg8::gemm_phase<pg8::EpiGU, pg8::GroupedOrder<true>>(lds, g, S, E, wid);
        }
        GRID_BAR();
        for (int rep = 0; rep < NREP(10); ++rep) if (PH(10)) { LAUNDER_TID
            bf16_t* ACTSH = (bf16_t*)WSP(WS_ACTSH); bf16_t* WSD = (bf16_t*)WSP(WS_WSD); bf16_t* YSH = (bf16_t*)WSP(WS_YSH); bf16_t* ACT = (bf16_t*)WSP(WS_ACT); bf16_t* WD = (bf16_t*)WSP(WS_WD); bf16_t* YB = (bf16_t*)WSP(WS_YB); int* DST = (int*)WSP(WS_DST); float* WL = (float*)WSP(WS_WL);
            if (PH(12)) { pg8::Gemm g{ACTSH, WSD + (size_t)l * DM * 256, 256}; pg8::StaticOrder S; S.init(NTOK, DM, G, bx);
              pg8::EpiShDown E{YSH};
              pg8::gemm_phase<pg8::EpiShDown, pg8::StaticOrder>(lds, g, S, E, wid); }
            if (PH(13)) { pg8::Gemm g{ACT, WD + (size_t)l * NEXP * DM * 256, 256};
              pg8::GroupedOrder<false> S{TP, TPX, CNTL, 4, (G - (bx & 7) + 7) >> 3, bx >> 3, bx & 7, nullptr};
              pg8::EpiDown E{YB, DST, WL};
              pg8::gemm_phase<pg8::EpiDown, pg8::GroupedOrder<false>>(lds, g, S, E, wid); }
        }
        GRID_BAR();
        for (int rep = 0; rep < NREP(11); ++rep) if (PH(11)) { LAUNDER_TID
            bf16_t* YSH = (bf16_t*)WSP(WS_YSH); bf16_t* YB = (bf16_t*)WSP(WS_YB); float* X1 = (float*)WSP(WS_X1); float* OUT = OUTP; bf16_t* H = (bf16_t*)WSP(WS_H); float* ADA = (float*)WSP(WS_ADA); const float* ada_l = (const float*)WSP(WS_ADA) + (size_t)l * 8 * 6144;
            const int gw = bx * 8 + wid, NGW = G * 8; const float* lg = INP(15) + l * DM; const float* lb = INP(16) + l * DM;
            for (int m = gw; m < NTOK; m += NGW) { const int b = m >> 12; const float* ad = ada_l + (size_t)b * 6144;
                float y[2][8]; u32x4 t[2][9];
#pragma unroll
                for (int j = 0; j < 2; ++j) { const int c0 = 512 * j + 8 * lane;
                    t[j][8] = *(const GAS u32x4*)(YSH + (size_t)m * DM + c0);
#pragma unroll
                    for (int k = 0; k < 8; ++k) t[j][k] = *(const GAS u32x4*)(YB + ((size_t)m * 8 + k) * DM + c0); }
                f32x4 xa[2][2];
#pragma unroll
                for (int j = 0; j < 2; ++j) { const float* xp = X1 + (size_t)m * DM + 512 * j + 8 * lane; xa[j][0] = *(const GAS f32x4*)xp; xa[j][1] = *(const GAS f32x4*)(xp + 4); }
#pragma unroll
                for (int j = 0; j < 2; ++j) {
#pragma unroll
                    for (int e = 0; e < 4; ++e) { y[j][2 * e] = __uint_as_float(t[j][8][e] << 16); y[j][2 * e + 1] = __uint_as_float(t[j][8][e] & 0xffff0000u); }
#pragma unroll
                    for (int k = 0; k < 8; ++k)
#pragma unroll
                        for (int e = 0; e < 4; ++e) { y[j][2 * e] += __uint_as_float(t[j][k][e] << 16); y[j][2 * e + 1] += __uint_as_float(t[j][k][e] & 0xffff0000u); } }
                float v[2][8]; float s1 = 0.f;
#pragma unroll
                for (int j = 0; j < 2; ++j) { const float* gp = ad + 5 * 1024 + 512 * j + 8 * lane; const f32x4 ga = *(const f32x4*)gp, gb = *(const f32x4*)(gp + 4);
#pragma unroll
                    for (int e = 0; e < 8; ++e) { const float g2 = (e < 4 ? ga[e & 3] : gb[e & 3]) + 1.f; const float xv = (e < 4 ? xa[j][0][e & 3] : xa[j][1][e & 3]); v[j][e] = xv * ALPHA + g2 * y[j][e]; s1 += v[j][e]; } }
                const float mean = wave_sum(s1) * (1.f / DM); float s2 = 0.f;
#pragma unroll
                for (int j = 0; j < 2; ++j)
#pragma unroll
                    for (int e = 0; e < 8; ++e) { v[j][e] -= mean; s2 += v[j][e] * v[j][e]; }
                const float rstd = 1.f / sqrtf(wave_sum(s2) * (1.f / DM) + LN_EPS);
                const float* adn = ADA + ((size_t)(l + 1) * 8 + b) * 6144;
#pragma unroll
                for (int j = 0; j < 2; ++j) { const int c0 = 512 * j + 8 * lane; const f32x4 ga = *(const f32x4*)(lg + c0), gb = *(const f32x4*)(lg + c0 + 4), ba = *(const f32x4*)(lb + c0), bb = *(const f32x4*)(lb + c0 + 4);
                    f32x4 xo0, xo1;
#pragma unroll
                    for (int e = 0; e < 4; ++e) { xo0[e] = v[j][e] * rstd * ga[e] + ba[e]; xo1[e] = v[j][4 + e] * rstd * gb[e] + bb[e]; }
                    *(f32x4*)(OUT + (size_t)m * DM + c0) = xo0; *(f32x4*)(OUT + (size_t)m * DM + c0 + 4) = xo1;
                    if (l + 1 < DEPTH) { const f32x4 sha = *(const f32x4*)(adn + c0), shb = *(const f32x4*)(adn + c0 + 4), sca = *(const f32x4*)(adn + 1024 + c0) + 1.f, scb = *(const f32x4*)(adn + 1024 + c0 + 4) + 1.f;
                        const f32x4 h0 = xo0 * sca + sha, h1 = xo1 * scb + shb;
                        u32x4 hw; hw.x = cvtpk(h0[0], h0[1]); hw.y = cvtpk(h0[2], h0[3]); hw.z = cvtpk(h1[0], h1[1]); hw.w = cvtpk(h1[2], h1[3]); *(u32x4*)(H + (size_t)m * DM + c0) = hw; } } }
        }
        if (l + 1 < DEPTH) GRID_BAR();
    }
}

extern "C" void kernel_launch(void* const* d_in, const int* in_sizes, int n_in, void* d_out, int out_size, void* d_ws, size_t ws_size, hipStream_t stream) {
    static int grid = 0;
    if (grid == 0) {
        if (n_in != 25 || out_size != NTOK * DM || ws_size < WS_END) { fprintf(stderr, "kernel_launch: unexpected shapes (n_in %d, out %d, ws %zu)\n", n_in, out_size, ws_size); grid = -1; return; }
        int dev = 0, cus = 0;
        if (hipGetDevice(&dev) != hipSuccess || hipDeviceGetAttribute(&cus, hipDeviceAttributeMultiprocessorCount, dev) != hipSuccess) { grid = -1; return; }
        if (hipFuncSetAttribute((const void*)mega_fwd, hipFuncAttributeMaxDynamicSharedMemorySize, LDS_BYTES) != hipSuccess) { fprintf(stderr, "kernel_launch: hipFuncSetAttribute failed\n"); grid = -1; return; }
        int per_cu = 0;
        if (hipOccupancyMaxActiveBlocksPerMultiprocessor(&per_cu, (const void*)mega_fwd, 512, LDS_BYTES) != hipSuccess || per_cu < 1) fprintf(stderr, "kernel_launch: occupancy query says %d\n", per_cu);
        (void)hipGetLastError();
        grid = cus;
    }
    if (grid < 0) return;
    if (hipMemsetAsync((char*)d_ws + WS_CTL, 0, CTL_BYTES, stream) != hipSuccess) return;
    Args a{};
    for (int i = 0; i < 25; ++i) a.in[i] = (const float*)d_in[i];
    a.out = (float*)d_out; a.ws = (unsigned char*)d_ws;
    hipLaunchKernelGGL(mega_fwd, dim3(grid), dim3(512), LDS_BYTES, stream, a);
}
```
